# Optimizing an MI355X kernel written in HIP

```python
import jax, jax.numpy as jnp
from jax import lax
import numpy as np

D_MODEL = 1024
BATCH = 8
SEQ = 4096
DEPTH = 1

N_Q_HEADS = 8
N_KV_HEADS = 2
HEAD_DIM = 64
WINDOW = 128
GQA_GROUP = N_Q_HEADS // N_KV_HEADS
M_HEADS = 4
M_QK_DIM = 64
M_V_DIM = 128
CONV_WIDTH = 4
CHUNK = 64
N_GROUPS = 4
EXPERTS_PER_GROUP = 8
N_EXPERTS = N_GROUPS * EXPERTS_PER_GROUP
TOP_K = 2
D_EXPERT = 512
EXPERT_BLOCK = 256
EPS = 1e-6

ATT_Q_WIDTH = N_Q_HEADS * HEAD_DIM
ATT_KV_WIDTH = N_KV_HEADS * HEAD_DIM
M_QK_WIDTH = M_HEADS * M_QK_DIM
M_V_WIDTH = M_HEADS * M_V_DIM
IN_SIZES = (ATT_Q_WIDTH, ATT_KV_WIDTH, ATT_KV_WIDTH, M_QK_WIDTH, M_QK_WIDTH, M_V_WIDTH, M_V_WIDTH, M_HEADS, M_HEADS, D_MODEL, D_MODEL)
IN_WIDTH = sum(IN_SIZES)

kernel_name = 'hybrid_swa_mlstm_hmoe_block'


def rms_norm(x, w):
    xf = x.astype(jnp.float32)
    y = xf * lax.rsqrt(jnp.mean(xf * xf, axis=-1, keepdims=True) + EPS)
    return (y * w.astype(jnp.float32)).astype(x.dtype)


def causal_conv(u, w, b):
    c = u.shape[-1]
    y = lax.conv_general_dilated(u, w[:, None, :].astype(u.dtype), window_strides=(1,),
                                 padding=[(CONV_WIDTH - 1, 0)],
                                 dimension_numbers=('NWC', 'WIO', 'NWC'),
                                 feature_group_count=c)
    return y + b.astype(u.dtype)


def sliding_window_attention(q, k, v, sinks):
    B, S, _ = q.shape
    nb = S // WINDOW
    f32 = jnp.float32
    qb = q.astype(f32).reshape(B, nb, WINDOW, N_KV_HEADS, GQA_GROUP, HEAD_DIM)

    def band_keys(t):
        t = t.astype(f32).reshape(B, S, N_KV_HEADS, HEAD_DIM)
        t = jnp.concatenate([jnp.zeros((B, WINDOW, N_KV_HEADS, HEAD_DIM), f32), t], axis=1)
        t = t.reshape(B, nb + 1, WINDOW, N_KV_HEADS, HEAD_DIM)
        return jnp.concatenate([t[:, :-1], t[:, 1:]], axis=2)

    kw, vw = band_keys(k), band_keys(v)
    s = jnp.einsum('bnqkgd,bnskd->bnkgqs', qb, kw) * (HEAD_DIM ** -0.5)
    qi = jnp.arange(WINDOW)[:, None]
    kj = jnp.arange(2 * WINDOW)[None, :]
    band = (kj > qi) & (kj <= qi + WINDOW)
    valid = band[None] & ((jnp.arange(nb)[:, None, None] > 0) | (kj[None] >= WINDOW))
    s = jnp.where(valid[None, :, None, None], s, -jnp.inf)
    sink = jnp.broadcast_to(sinks.astype(f32).reshape(1, 1, N_KV_HEADS, GQA_GROUP, 1, 1), s.shape[:-1] + (1,))
    p = jax.nn.softmax(jnp.concatenate([s, sink], axis=-1), axis=-1)[..., :-1]
    o = jnp.einsum('bnkgqs,bnskd->bnqkgd', p, vw)
    return o.reshape(B, S, ATT_Q_WIDTH).astype(q.dtype)


def mlstm_chunkwise(q, k, v, ig, lf):
    B, S, H, DK = q.shape
    DV = v.shape[-1]
    nc = S // CHUNK

    def chunks(t):
        return t.reshape(B, nc, CHUNK, H, -1).transpose(1, 0, 3, 2, 4)

    def gate_chunks(t):
        return t.reshape(B, nc, CHUNK, H).transpose(1, 0, 3, 2)

    causal = jnp.tril(jnp.ones((CHUNK, CHUNK), dtype=bool))

    def step(carry, inp):
        C, n, m = carry
        qb, kb, vb, ib, fb = inp
        b = jnp.cumsum(fb, axis=-1)
        a = b + m[..., None]
        dmat = jnp.where(causal, b[..., :, None] - b[..., None, :] + ib[..., None, :], -jnp.inf)
        mt = jnp.maximum(a, jnp.max(dmat, axis=-1))
        wq = jnp.exp(dmat - mt[..., None])
        wa = jnp.exp(a - mt)
        sw = jnp.einsum('bhtd,bhsd->bhts', qb, kb) * wq
        num = wa[..., None] * jnp.einsum('bhtd,bhdv->bhtv', qb, C) + jnp.einsum('bhts,bhsv->bhtv', sw, vb)
        den = wa * jnp.einsum('bhtd,bhd->bht', qb, n) + jnp.sum(sw, axis=-1)
        hb = num / jnp.maximum(jnp.abs(den), jnp.exp(-mt))[..., None]
        m_new = mt[..., -1]
        wc = jnp.exp(b[..., -1] + m - m_new)
        ws = jnp.exp(b[..., -1:] - b + ib - m_new[..., None])
        C_new = wc[..., None, None] * C + jnp.einsum('bhs,bhsd,bhsv->bhdv', ws, kb, vb)
        n_new = wc[..., None] * n + jnp.einsum('bhs,bhsd->bhd', ws, kb)
        return (C_new, n_new, m_new), hb

    f32 = jnp.float32
    init = (jnp.zeros((B, H, DK, DV), f32), jnp.zeros((B, H, DK), f32), jnp.zeros((B, H), f32))
    _, hs = lax.scan(step, init, (chunks(q), chunks(k), chunks(v), gate_chunks(ig), gate_chunks(lf)))
    return hs.transpose(1, 0, 3, 2, 4).reshape(B, S, H, DV)


def hierarchical_moe(h, w_group, b_group, w_router, b_router, w_gate, w_up, w_down):
    B, S, D = h.shape
    T = B * S
    f32 = jnp.float32
    xt = h.reshape(T, D)
    gprob = jax.nn.softmax((xt @ w_group).astype(f32) + b_group.astype(f32), axis=-1)
    gp, gi = lax.top_k(gprob, 1)
    elog = ((xt @ w_router).astype(f32) + b_router.astype(f32)).reshape(T, N_GROUPS, EXPERTS_PER_GROUP)
    elog_g = jnp.take_along_axis(elog, gi[:, :, None], axis=1)[:, 0]
    ev, ej = lax.top_k(elog_g, TOP_K)
    ew = jax.nn.softmax(ev, axis=-1) * gp
    eid = gi * EXPERTS_PER_GROUP + ej

    A = T * TOP_K
    flat_e = eid.reshape(A)
    flat_tok = jnp.repeat(jnp.arange(T, dtype=jnp.int32), TOP_K)
    flat_w = ew.reshape(A)
    order = jnp.argsort(flat_e, stable=True)
    se, stok, sw = flat_e[order], flat_tok[order], flat_w[order]
    counts = jnp.bincount(flat_e, length=N_EXPERTS)
    starts = jnp.cumsum(counts) - counts
    pcounts = ((counts + EXPERT_BLOCK - 1) // EXPERT_BLOCK) * EXPERT_BLOCK
    pends = jnp.cumsum(pcounts)
    pstarts = pends - pcounts
    dest = pstarts[se] + jnp.arange(A, dtype=jnp.int32) - starts[se]
    nblk = (A + EXPERT_BLOCK - 1) // EXPERT_BLOCK + N_EXPERTS
    P = nblk * EXPERT_BLOCK
    slot_tok = jnp.full((P,), T, dtype=jnp.int32).at[dest].set(stok)
    slot_w = jnp.zeros((P,), f32).at[dest].set(sw)
    blk_e = jnp.minimum(jnp.searchsorted(pends, jnp.arange(nblk, dtype=jnp.int32) * EXPERT_BLOCK, side='right'), N_EXPERTS - 1)
    xpad = jnp.concatenate([xt, jnp.zeros((1, D), xt.dtype)], axis=0)
    xs = xpad[slot_tok].reshape(nblk, EXPERT_BLOCK, D)

    def expert_block(args):
        xb, e = args
        return (jax.nn.silu(xb @ w_gate[e]) * (xb @ w_up[e])) @ w_down[e]

    ys = lax.map(expert_block, (xs, blk_e)).reshape(P, D)
    y = jnp.zeros((T + 1, D), ys.dtype).at[slot_tok].add(ys * slot_w[:, None].astype(ys.dtype))[:T]
    return y.reshape(B, S, D)


def setup_inputs(seed: int = 0) -> dict:
    key = jax.random.key(seed)
    ks = jax.random.split(key, 24)
    f32 = jnp.float32

    def nrm(k, shape, scale):
        return jax.random.normal(k, shape, f32) * scale

    L = DEPTH
    return {
        'x': nrm(ks[0], (BATCH, SEQ, D_MODEL), 1.0),
        'norm_mix_w': 1.0 + nrm(ks[1], (L, D_MODEL), 0.02),
        'w_in': nrm(ks[2], (L, D_MODEL, IN_WIDTH), D_MODEL ** -0.5),
        'conv_w': nrm(ks[3], (L, CONV_WIDTH, 2 * M_QK_WIDTH), CONV_WIDTH ** -0.5),
        'conv_b': nrm(ks[4], (L, 2 * M_QK_WIDTH), 0.02),
        'b_igate': nrm(ks[5], (L, M_HEADS), 0.1),
        'b_fgate': jnp.linspace(3.0, 6.0, M_HEADS, dtype=f32)[None] + nrm(ks[6], (L, M_HEADS), 0.1),
        'attn_sinks': nrm(ks[7], (L, N_Q_HEADS), 0.5),
        'mlstm_norm_w': 1.0 + nrm(ks[8], (L, M_V_WIDTH), 0.02),
        'w_attn_o': nrm(ks[9], (L, ATT_Q_WIDTH, D_MODEL), ATT_Q_WIDTH ** -0.5),
        'w_mlstm_o': nrm(ks[10], (L, M_V_WIDTH, D_MODEL), M_V_WIDTH ** -0.5),
        'w_out': nrm(ks[11], (L, D_MODEL, D_MODEL), D_MODEL ** -0.5),
        'norm_ffn_w': 1.0 + nrm(ks[12], (L, D_MODEL), 0.02),
        'w_group': nrm(ks[13], (L, D_MODEL, N_GROUPS), D_MODEL ** -0.5),
        'b_group': nrm(ks[14], (L, N_GROUPS), 0.01),
        'w_router': nrm(ks[15], (L, D_MODEL, N_EXPERTS), D_MODEL ** -0.5),
        'b_router': nrm(ks[16], (L, N_EXPERTS), 0.01),
        'w_gate': nrm(ks[17], (L, N_EXPERTS, D_MODEL, D_EXPERT), D_MODEL ** -0.5),
        'w_up': nrm(ks[18], (L, N_EXPERTS, D_MODEL, D_EXPERT), D_MODEL ** -0.5),
        'w_down': nrm(ks[19], (L, N_EXPERTS, D_EXPERT, D_MODEL), D_EXPERT ** -0.5),
        'norm_final_w': 1.0 + nrm(ks[20], (D_MODEL,), 0.02),
    }


def reference(x, norm_mix_w, w_in, conv_w, conv_b, b_igate, b_fgate, attn_sinks, mlstm_norm_w,
              w_attn_o, w_mlstm_o, w_out, norm_ffn_w, w_group, b_group, w_router, b_router,
              w_gate, w_up, w_down, norm_final_w):
    B, S, _ = x.shape
    f32 = jnp.float32
    splits = np.cumsum(np.array(IN_SIZES))[:-1].tolist()
    for l in range(DEPTH):
        h = rms_norm(x, norm_mix_w[l])
        proj = h @ w_in[l]
        aq, ak, av, mq, mk, mv, mo, mi, mf, ga, gb = jnp.split(proj, splits, axis=-1)

        ya = sliding_window_attention(aq, ak, av, attn_sinks[l])

        qk = jax.nn.silu(causal_conv(jnp.concatenate([mq, mk], axis=-1), conv_w[l], conv_b[l]))
        mq, mk = jnp.split(qk, 2, axis=-1)
        q_m = mq.astype(f32).reshape(B, S, M_HEADS, M_QK_DIM)
        k_m = mk.astype(f32).reshape(B, S, M_HEADS, M_QK_DIM) * (M_QK_DIM ** -0.5)
        v_m = mv.astype(f32).reshape(B, S, M_HEADS, M_V_DIM)
        ig = mi.astype(f32) + b_igate[l].astype(f32)
        lf = jax.nn.log_sigmoid(mf.astype(f32) + b_fgate[l].astype(f32))
        hm = mlstm_chunkwise(q_m, k_m, v_m, ig, lf)
        hm = hm * lax.rsqrt(jnp.mean(hm * hm, axis=-1, keepdims=True) + EPS)
        hm = hm.reshape(B, S, M_V_WIDTH) * mlstm_norm_w[l].astype(f32)
        ym = (jax.nn.sigmoid(mo.astype(f32)) * hm).astype(x.dtype)

        mix = jax.nn.sigmoid(ga) * (ya @ w_attn_o[l]) + jax.nn.sigmoid(gb) * (ym @ w_mlstm_o[l])
        x = x + mix @ w_out[l]

        h = rms_norm(x, norm_ffn_w[l])
        x = x + hierarchical_moe(h, w_group[l], b_group[l], w_router[l], b_router[l],
                                 w_gate[l], w_up[l], w_down[l])
    return rms_norm(x, norm_final_w)
```

```cpp
#include <hip/hip_runtime.h>
#include <cstdio>
#include <cstdint>

#define LAS __attribute__((address_space(3)))
#define GAS __attribute__((address_space(1)))
typedef unsigned short bf16;
typedef short bf16x8 __attribute__((ext_vector_type(8)));
typedef short s16x4 __attribute__((ext_vector_type(4)));
typedef float f32x4 __attribute__((ext_vector_type(4)));
typedef float f32x16 __attribute__((ext_vector_type(16)));
typedef unsigned u32x4 __attribute__((ext_vector_type(4)));
typedef unsigned u32x2 __attribute__((ext_vector_type(2)));
typedef int i32x4 __attribute__((ext_vector_type(4)));
typedef float f32x2_t __attribute__((ext_vector_type(2)));
typedef __bf16 bf16x2_t __attribute__((ext_vector_type(2)));

#ifndef MK_FUSED
#define MK_FUSED 1
#endif

constexpr int T_ = 32768, D_ = 1024, SEQ_ = 4096, NB_ = 8;
constexpr int NIN = 4352;
constexpr int NEXP = 32;
constexpr float EPS_ = 1e-6f;
constexpr float LOG2E = 1.4426950408889634f;
constexpr float QSCALE = 0.125f * LOG2E;
constexpr int NWAVES = 8;
constexpr int NPH = 11;

constexpr size_t MiB = 1u << 20;
constexpr size_t WS_CTL = 0, CTL_ZERO_BYTES = 1 * MiB;
constexpr size_t WS_IGF = 1 * MiB;
constexpr size_t WS_CHS = 2 * MiB;
constexpr size_t WS_TOKI = 4 * MiB;
constexpr size_t WS_RSTD2 = 4 * MiB + 512 * 1024;
constexpr size_t WS_WR = 4 * MiB + 768 * 1024;
constexpr size_t WS_LIST = 5 * MiB;
constexpr size_t WS_SW = 9 * MiB;
constexpr size_t WS_WIN = 13 * MiB;
constexpr size_t WS_WAO = 22 * MiB, WS_WMO = 23 * MiB, WS_WOUT = 24 * MiB;
constexpr size_t WS_WGU = 26 * MiB;
constexpr size_t WS_WDN = 90 * MiB;
constexpr size_t WS_XN = 122 * MiB;
constexpr size_t WS_ATT = 186 * MiB;
constexpr size_t WS_MQK = 234 * MiB;
constexpr size_t WS_MV = 266 * MiB;
constexpr size_t WS_MO = 298 * MiB;
constexpr size_t WS_GATES = 330 * MiB;
constexpr size_t WS_HID = 186 * MiB;
constexpr size_t WS_YS = 258 * MiB;
constexpr size_t WS_END = 458 * MiB;
constexpr int CW_TMO = 0, CW_BAR = 4096, CW_GCNT = 16384;

constexpr int RING_BYTES = 131072;
constexpr int LDSCTL_OFF = RING_BYTES, MISC_OFF = LDSCTL_OFF + 320;
constexpr int TAB_OFF = LDSCTL_OFF + 1024;
constexpr int LDS_BYTES = 147456;

__device__ __forceinline__ unsigned pk2(float lo, float hi) { f32x2_t v = {lo, hi}; bf16x2_t b = __builtin_convertvector(v, bf16x2_t); return __builtin_bit_cast(unsigned, b); }
__device__ __forceinline__ float bflo(unsigned u) { return __uint_as_float(u << 16); }
__device__ __forceinline__ float bfhi(unsigned u) { return __uint_as_float(u & 0xffff0000u); }
__device__ __forceinline__ float bf2f(short s) { return __uint_as_float(((unsigned)(unsigned short)s) << 16); }
__device__ __forceinline__ float wave_sum(float v) {
#pragma unroll
    for (int o = 1; o < 64; o <<= 1) v += __shfl_xor(v, o);
    return v;
}
__device__ __forceinline__ float wave_max(float v) {
#pragma unroll
    for (int o = 1; o < 64; o <<= 1) v = fmaxf(v, __shfl_xor(v, o));
    return v;
}
__device__ __forceinline__ float sigmoidf_(float v) { return 1.0f / (1.0f + __expf(-v)); }
__device__ __forceinline__ float siluf_(float v) { return v / (1.0f + __expf(-v)); }
#define LDS_WAIT() asm volatile("s_waitcnt lgkmcnt(0)" ::: "memory")

namespace g8 {
constexpr int BM = 256, BK = 64, HALF = 128, HTB = HALF * BK * 2, STAGE_BYTES = 8 * HTB, NXCD = 8, WGM = 8;
__host__ __device__ __forceinline__ int lds_byte(int r, int c) { const int st = (r >> 4) * 2 + (c >> 5), rr = r & 15, cc = c & 31, ob = rr * 64 + cc * 2; return st * 1024 + (ob ^ (((ob >> 9) & 1) << 5)); }
__host__ __device__ __forceinline__ void stage_rc(int b, int& R, int& C) { const int st = b / 1024, sb = b % 1024, swz = sb ^ (((sb >> 9) & 1) << 5); R = (st >> 1) * 16 + swz / 64; C = (st & 1) * 32 + (swz % 64) / 2; }
__host__ __device__ __forceinline__ int perm32(int rho) { const int n = rho >> 4, i = rho & 15; return 8 * (i >> 2) + 4 * n + (i & 3); }

struct GU { const char* A; const char* B; int pm, pn, x0, x1; };

__device__ __forceinline__ void tile_of(int L, int nM, int nN, int& pm, int& pn) {
    const int nwg = nM * nN; int wgid = L; { const int q = nwg / NXCD, r = nwg % NXCD, xcd = wgid % NXCD, off = wgid / NXCD; wgid = (xcd < r ? xcd * (q + 1) : r * (q + 1) + (xcd - r) * q) + off; }
    const int nig = WGM * nN, gid = wgid / nig, fm = gid * WGM, gsz = (nM - fm) < WGM ? (nM - fm) : WGM;
    pm = fm + ((wgid % nig) % gsz); pn = (wgid % nig) / gsz;
}

template <class Epi, class Sched, bool ALIGN_EPI>
__device__ __forceinline__ void gemm_phase(LAS unsigned char* lds, const int K, const int ldb, const Sched& S, const Epi& E) {
    const int tid = threadIdx.x, wid = __builtin_amdgcn_readfirstlane(tid >> 6), lane = tid & 63, wr = wid >> 2, wc = wid & 3, fr = lane & 15, fq = lane >> 4;
    const int nt = K / BK;
    int Rr[2], Cc[2]; unsigned voffB[2];
#pragma unroll
    for (int i = 0; i < 2; ++i) { int R, C; stage_rc(tid * 16 + i * 8192, R, C); Rr[i] = R; Cc[i] = C; const int Rb = Epi::PERM ? ((R & ~31) + perm32(R & 31)) : R; voffB[i] = (unsigned)(Rb * ldb + C) * 2u; }
    const size_t kstep = (size_t)(BK * 2);
    const size_t hstepB = (size_t)HALF * ldb * 2;
    const unsigned ldsw = (unsigned)wid * 1024u;
    const int aoff = lds_byte(wr * 64 + fr, fq * 8), boff = lds_byte(wc * 32 + fr, fq * 8);
#define G8_SA(b, h) (((b) * 2 + (h)) * HTB)
#define G8_SB(b, h) ((4 + (b) * 2 + (h)) * HTB)
#define G8_STAGE(bufoff, gbase, voff) do { _Pragma("unroll") for (int _i = 0; _i < 2; ++_i) \
        __builtin_amdgcn_global_load_lds((const unsigned*)((const char*)(gbase) + (voff)[_i]), (LAS unsigned*)(lds + (bufoff) + ldsw + _i * 8192), 16, 0, 0); } while (0)
#define G8_LDA(dst, b, h) do { _Pragma("unroll") for (int m = 0; m < 4; ++m) _Pragma("unroll") for (int k = 0; k < 2; ++k) dst[m][k] = *(const LAS bf16x8*)(lds + G8_SA(b, h) + aoff + m * 2048 + k * 1024); } while (0)
#define G8_LDB(dst, b, h) do { _Pragma("unroll") for (int n = 0; n < 2; ++n) _Pragma("unroll") for (int k = 0; k < 2; ++k) dst[n][k] = *(const LAS bf16x8*)(lds + G8_SB(b, h) + boff + n * 2048 + k * 1024); } while (0)
#define G8_MMA(ai, bj, At, Bt) do { __builtin_amdgcn_s_setprio(1); _Pragma("unroll") for (int m = 0; m < 4; ++m) _Pragma("unroll") for (int n = 0; n < 2; ++n) _Pragma("unroll") for (int k = 0; k < 2; ++k) \
        acc[ai][bj][m][n] = __builtin_amdgcn_mfma_f32_16x16x32_bf16(Bt[n][k], At[m][k], acc[ai][bj][m][n], 0, 0, 0); __builtin_amdgcn_s_setprio(0); } while (0)
#define G8_WAIT_V(n) asm volatile("s_waitcnt vmcnt(" #n ")" ::: "memory")
#define G8_WAIT_L(n) asm volatile("s_waitcnt lgkmcnt(" #n ")" ::: "memory")
#define G8_BAR __builtin_amdgcn_s_barrier()
#define G8_SCHED __builtin_amdgcn_sched_barrier(0)
    GU cur, nxt; int ui = 0;
    if (!S.next(0, cur)) return;
    f32x4 acc[2][2][4][2];
#pragma unroll
    for (int a = 0; a < 2; ++a)
#pragma unroll
        for (int b = 0; b < 2; ++b)
#pragma unroll
            for (int m = 0; m < 4; ++m)
#pragma unroll
                for (int n = 0; n < 2; ++n) acc[a][b][m][n] = (f32x4){0.f, 0.f, 0.f, 0.f};
    bf16x8 At[4][2], B0[2][2], B1[2][2];
    unsigned vc0[2], vc1[2], vn0[2], vn1[2];
    S.aoff(cur, Rr, Cc, vc0, vc1);
    const char* cA = cur.A; const char* cB = cur.B;
    G8_STAGE(G8_SB(0, 0), cB, voffB); G8_STAGE(G8_SB(0, 1), cB + hstepB, voffB); G8_STAGE(G8_SA(0, 0), cA, vc0); G8_STAGE(G8_SA(0, 1), cA, vc1);
    if (wr == 1) G8_BAR;
    G8_WAIT_V(2); G8_BAR;
    G8_STAGE(G8_SB(1, 0), cB + kstep, voffB); G8_STAGE(G8_SA(1, 0), cA + kstep, vc0); G8_STAGE(G8_SB(1, 1), cB + hstepB + kstep, voffB);
    G8_WAIT_V(6); G8_BAR;
    for (;;) {
        const bool has_next = S.next(ui + 1, nxt);
        const char* nA = has_next ? nxt.A : cA; const char* nB = has_next ? nxt.B : cB;
        if (has_next) S.aoff(nxt, Rr, Cc, vn0, vn1); else { vn0[0] = vc0[0]; vn0[1] = vc0[1]; vn1[0] = vc1[0]; vn1[1] = vc1[1]; }
        for (int t = 0; t < nt; t += 2) {
            const bool last = (t == nt - 2);
            const char* a1 = cA + (size_t)(t + 1) * kstep;
            const char* a2 = last ? nA : cA + (size_t)(t + 2) * kstep; const char* b2 = last ? nB : cB + (size_t)(t + 2) * kstep;
            const char* a3 = a2 + kstep; const char* b3 = b2 + kstep;
            unsigned w0[2], w1[2]; w0[0] = last ? vn0[0] : vc0[0]; w0[1] = last ? vn0[1] : vc0[1]; w1[0] = last ? vn1[0] : vc1[0]; w1[1] = last ? vn1[1] : vc1[1];
            G8_LDB(B0, 0, 0); G8_LDB(B1, 0, 1); G8_SCHED; G8_LDA(At, 0, 0); G8_STAGE(G8_SA(1, 1), a1, vc1);
            G8_WAIT_V(8); G8_WAIT_L(0); G8_BAR; G8_MMA(0, 0, At, B0); G8_MMA(0, 1, At, B1); G8_BAR; G8_SCHED;
            G8_LDA(At, 0, 1); G8_STAGE(G8_SB(0, 0), b2, voffB); G8_STAGE(G8_SB(0, 1), b2 + hstepB, voffB); G8_STAGE(G8_SA(0, 0), a2, w0);
            G8_WAIT_V(8); G8_WAIT_L(0); G8_BAR; G8_MMA(1, 0, At, B0); G8_MMA(1, 1, At, B1); G8_BAR; G8_SCHED;
            G8_LDB(B0, 1, 0); G8_LDB(B1, 1, 1); G8_SCHED; G8_LDA(At, 1, 0); G8_STAGE(G8_SA(0, 1), a2, w1);
            G8_WAIT_V(8); G8_WAIT_L(0); G8_BAR; G8_MMA(0, 0, At, B0); G8_MMA(0, 1, At, B1); G8_BAR; G8_SCHED;
            G8_LDA(At, 1, 1); G8_STAGE(G8_SB(1, 0), b3, voffB); G8_STAGE(G8_SB(1, 1), b3 + hstepB, voffB); G8_STAGE(G8_SA(1, 0), a3, w0);
            G8_WAIT_V(8); G8_WAIT_L(0); G8_BAR; G8_MMA(1, 0, At, B0); G8_MMA(1, 1, At, B1); G8_BAR; G8_SCHED;
        }
        if constexpr (ALIGN_EPI) { if (wr == 0) G8_BAR; }
        E(acc, cur, wr, wc, fr, fq);
        if (!E.keep(cur)) {
#pragma unroll
            for (int a = 0; a < 2; ++a)
#pragma unroll
                for (int b = 0; b < 2; ++b)
#pragma unroll
                    for (int m = 0; m < 4; ++m)
#pragma unroll
                        for (int n = 0; n < 2; ++n) acc[a][b][m][n] = (f32x4){0.f, 0.f, 0.f, 0.f};
        }
        if (!has_next) break;
        cur = nxt; cA = nA; cB = nB; ++ui;
        vc0[0] = vn0[0]; vc0[1] = vn0[1]; vc1[0] = vn1[0]; vc1[1] = vn1[1];
        if constexpr (ALIGN_EPI) { if (wr == 1) G8_BAR; }
    }
    G8_WAIT_V(0);
    if constexpr (!ALIGN_EPI) { if (wr == 0) G8_BAR; }
    G8_BAR;
#undef G8_SA
#undef G8_SB
#undef G8_STAGE
#undef G8_LDA
#undef G8_LDB
#undef G8_MMA
#undef G8_WAIT_V
#undef G8_WAIT_L
#undef G8_BAR
#undef G8_SCHED
}
}

struct DenseSched {
    const char* A; const char* B; int lda, ldb, nM, nN, G, c;
    __device__ __forceinline__ bool next(int i, g8::GU& u) const {
        const long L = (long)i * G + c; if (L >= (long)nM * nN) return false;
        g8::tile_of((int)L, nM, nN, u.pm, u.pn); u.x0 = 0; u.x1 = 0;
        u.A = A + (size_t)u.pm * 256 * lda * 2; u.B = B + (size_t)u.pn * 256 * ldb * 2; return true;
    }
    __device__ __forceinline__ void aoff(const g8::GU&, const int (&R)[2], const int (&C)[2], unsigned (&v0)[2], unsigned (&v1)[2]) const {
#pragma unroll
        for (int i = 0; i < 2; ++i) { v0[i] = (unsigned)(R[i] * lda + C[i]) * 2u; v1[i] = (unsigned)((R[i] + 128) * lda + C[i]) * 2u; }
    }
};
struct MixSched {
    const char* A0; const char* A1; const char* B0; const char* B1; int lda0, lda1, nM, nN, G, c;
    __device__ __forceinline__ bool next(int i, g8::GU& u) const {
        const long L = (long)(i >> 1) * G + c; if (L >= (long)nM * nN) return false;
        g8::tile_of((int)L, nM, nN, u.pm, u.pn); const int part = i & 1; u.x0 = part; u.x1 = 0;
        u.A = (part ? A1 : A0) + (size_t)u.pm * 256 * (part ? lda1 : lda0) * 2; u.B = (part ? B1 : B0) + (size_t)u.pn * 256 * 512 * 2; return true;
    }
    __device__ __forceinline__ void aoff(const g8::GU& u, const int (&R)[2], const int (&C)[2], unsigned (&v0)[2], unsigned (&v1)[2]) const {
        const int lda = u.x0 ? lda1 : lda0;
#pragma unroll
        for (int i = 0; i < 2; ++i) { v0[i] = (unsigned)(R[i] * lda + C[i]) * 2u; v1[i] = (unsigned)((R[i] + 128) * lda + C[i]) * 2u; }
    }
};
struct MoeSched {
    const LAS int* cum; const LAS int* cnt; const char* A; const char* B; const int* list; int G, c; bool gather; int ldb, nbrows;
    __device__ __forceinline__ bool next(int i, g8::GU& u) const {
        const long L = (long)i * G + c; const int total = cum[NEXP] * 4; if (L >= total) return false;
        const int blk = (int)L >> 2; u.pn = (int)L & 3;
        int e = 0;
#pragma unroll 1
        for (int k = 16; k >= 1; k >>= 1) if (cum[e + k] <= blk) e += k;
        u.x0 = e; u.x1 = blk - cum[e]; u.pm = blk;
        u.A = gather ? A : A + (size_t)blk * 256 * 512 * 2;
        u.B = B + ((size_t)e * nbrows + (size_t)u.pn * 256) * ldb * 2; return true;
    }
    __device__ __forceinline__ void aoff(const g8::GU& u, const int (&R)[2], const int (&C)[2], unsigned (&v0)[2], unsigned (&v1)[2]) const {
        if (gather) {
            const int n = cnt[u.x0]; const int* l = list + (size_t)u.x0 * T_ + u.x1 * 256;
#pragma unroll
            for (int i = 0; i < 2; ++i) { const int r0 = R[i], r1 = R[i] + 128;
                const int t0 = (u.x1 * 256 + r0 < n) ? l[r0] : 0, t1 = (u.x1 * 256 + r1 < n) ? l[r1] : 0;
                v0[i] = (unsigned)(t0 * 1024 + C[i]) * 2u; v1[i] = (unsigned)(t1 * 1024 + C[i]) * 2u; }
        } else {
#pragma unroll
            for (int i = 0; i < 2; ++i) { v0[i] = (unsigned)(R[i] * 512 + C[i]) * 2u; v1[i] = (unsigned)((R[i] + 128) * 512 + C[i]) * 2u; }
        }
    }
};

typedef f32x4 acc_t[2][2][4][2];
struct EpiProj {
    static constexpr bool PERM = true;
    bf16 *att, *mqk, *mv, *mo, *gates;
    __device__ __forceinline__ bool keep(const g8::GU&) const { return false; }
    __device__ __forceinline__ void operator()(acc_t& acc, const g8::GU& u, int wr, int wc, int fr, int fq) const {
        bf16* base; int ldc, colt, act = 0; float sc = 1.f; const int pn = u.pn;
        if (pn < 3) { base = att; ldc = 768; colt = pn * 256; if (pn < 2) sc = QSCALE; }
        else if (pn < 5) { base = mqk; ldc = 512; colt = (pn - 3) * 256; }
        else if (pn < 7) { base = mv; ldc = 512; colt = (pn - 5) * 256; }
        else if (pn < 9) { base = mo; ldc = 512; colt = (pn - 7) * 256; act = 1; }
        else { base = gates; ldc = 2048; colt = (pn - 9) * 256; act = 1; }
        const int row0 = u.pm * 256 + wr * 64 + fr, col0 = colt + wc * 32 + 8 * fq;
#pragma unroll
        for (int ai = 0; ai < 2; ++ai)
#pragma unroll
            for (int m = 0; m < 4; ++m) { bf16* rowp = base + (size_t)(row0 + ai * 128 + m * 16) * ldc + col0;
#pragma unroll
                for (int bj = 0; bj < 2; ++bj) { f32x4 v0 = acc[ai][bj][m][0], v1 = acc[ai][bj][m][1];
                    if (act) {
#pragma unroll
                        for (int e = 0; e < 4; ++e) { v0[e] = sigmoidf_(v0[e]); v1[e] = sigmoidf_(v1[e]); } }
                    else { v0 = v0 * sc; v1 = v1 * sc; }
                    u32x4 w; w.x = pk2(v0[0], v0[1]); w.y = pk2(v0[2], v0[3]); w.z = pk2(v1[0], v1[1]); w.w = pk2(v1[2], v1[3]);
                    *(u32x4*)(rowp + bj * 128) = w; } }
    }
};
struct EpiMix {
    static constexpr bool PERM = true;
    bf16* gates;
    __device__ __forceinline__ bool keep(const g8::GU& u) const { return u.x0 == 0; }
    __device__ __forceinline__ void operator()(acc_t& acc, const g8::GU& u, int wr, int wc, int fr, int fq) const {
        const int row0 = u.pm * 256 + wr * 64 + fr, col0 = u.pn * 256 + wc * 32 + 8 * fq; const bool fin = u.x0 != 0;
#pragma unroll
        for (int ai = 0; ai < 2; ++ai)
#pragma unroll
            for (int m = 0; m < 4; ++m) { bf16* rowp = gates + (size_t)(row0 + ai * 128 + m * 16) * 2048 + col0;
#pragma unroll
                for (int bj = 0; bj < 2; ++bj) {
                    const u32x4 gb = *(const u32x4*)(rowp + 1024 + bj * 128);
                    float b[8]; b[0] = bflo(gb.x); b[1] = bfhi(gb.x); b[2] = bflo(gb.y); b[3] = bfhi(gb.y); b[4] = bflo(gb.z); b[5] = bfhi(gb.z); b[6] = bflo(gb.w); b[7] = bfhi(gb.w);
                    if (!fin) {
                        const u32x4 ga = *(const u32x4*)(rowp + bj * 128);
                        float a[8]; a[0] = bflo(ga.x); a[1] = bfhi(ga.x); a[2] = bflo(ga.y); a[3] = bfhi(ga.y); a[4] = bflo(ga.z); a[5] = bfhi(ga.z); a[6] = bflo(ga.w); a[7] = bfhi(ga.w);
#pragma unroll
                        for (int e = 0; e < 4; ++e) { acc[ai][bj][m][0][e] *= a[e] / b[e]; acc[ai][bj][m][1][e] *= a[4 + e] / b[4 + e]; }
                    } else {
                        f32x4 v0 = acc[ai][bj][m][0], v1 = acc[ai][bj][m][1];
#pragma unroll
                        for (int e = 0; e < 4; ++e) { v0[e] *= b[e]; v1[e] *= b[4 + e]; }
                        u32x4 w; w.x = pk2(v0[0], v0[1]); w.y = pk2(v0[2], v0[3]); w.z = pk2(v1[0], v1[1]); w.w = pk2(v1[2], v1[3]);
                        *(u32x4*)(rowp + bj * 128) = w;
                    } } }
    }
};
struct EpiOut {
    static constexpr bool PERM = false;
    const float* x; float* out;
    __device__ __forceinline__ bool keep(const g8::GU&) const { return false; }
    __device__ __forceinline__ void operator()(acc_t& acc, const g8::GU& u, int wr, int wc, int fr, int fq) const {
        const int row0 = u.pm * 256 + wr * 64 + fr, col0 = u.pn * 256 + wc * 32 + 4 * fq;
#pragma unroll
        for (int ai = 0; ai < 2; ++ai)
#pragma unroll
            for (int m = 0; m < 4; ++m) { const size_t off = (size_t)(row0 + ai * 128 + m * 16) * 1024 + col0;
#pragma unroll
                for (int bj = 0; bj < 2; ++bj)
#pragma unroll
                    for (int n = 0; n < 2; ++n) { const f32x4 xv = *(const f32x4*)(x + off + bj * 128 + n * 16); *(f32x4*)(out + off + bj * 128 + n * 16) = xv + acc[ai][bj][m][n]; } }
    }
};
struct EpiG1 {
    static constexpr bool PERM = true;
    bf16* hid; const float* rstd2; const int* list; const LAS int* cnt;
    __device__ __forceinline__ bool keep(const g8::GU&) const { return false; }
    __device__ __forceinline__ void operator()(acc_t& acc, const g8::GU& u, int wr, int wc, int fr, int fq) const {
        const int n = cnt[u.x0]; const int* l = list + (size_t)u.x0 * T_ + u.x1 * 256;
        const int rl0 = wr * 64 + fr, col0 = u.pn * 128 + wc * 32 + 8 * fq;
#pragma unroll
        for (int ai = 0; ai < 2; ++ai)
#pragma unroll
            for (int m = 0; m < 4; ++m) { const int rl = rl0 + ai * 128 + m * 16; float rs = 0.f;
                if (u.x1 * 256 + rl < n) rs = rstd2[l[rl]];
                const f32x4 g0 = acc[ai][0][m][0] * rs, g1 = acc[ai][0][m][1] * rs, u0 = acc[ai][1][m][0] * rs, u1 = acc[ai][1][m][1] * rs;
                f32x4 h0, h1;
#pragma unroll
                for (int e = 0; e < 4; ++e) { h0[e] = siluf_(g0[e]) * u0[e]; h1[e] = siluf_(g1[e]) * u1[e]; }
                u32x4 w; w.x = pk2(h0[0], h0[1]); w.y = pk2(h0[2], h0[3]); w.z = pk2(h1[0], h1[1]); w.w = pk2(h1[2], h1[3]);
                *(u32x4*)(hid + (size_t)(u.pm * 256 + rl) * 512 + col0) = w; }
    }
};
struct EpiG2 {
    static constexpr bool PERM = true;
    bf16* ys; const float* sw; const LAS int* cnt;
    __device__ __forceinline__ bool keep(const g8::GU&) const { return false; }
    __device__ __forceinline__ void operator()(acc_t& acc, const g8::GU& u, int wr, int wc, int fr, int fq) const {
        const int n = cnt[u.x0]; const float* s = sw + (size_t)u.x0 * T_ + u.x1 * 256;
        const int rl0 = wr * 64 + fr, col0 = u.pn * 256 + wc * 32 + 8 * fq;
#pragma unroll
        for (int ai = 0; ai < 2; ++ai)
#pragma unroll
            for (int m = 0; m < 4; ++m) { const int rl = rl0 + ai * 128 + m * 16; float wgt = 0.f;
                if (u.x1 * 256 + rl < n) wgt = s[rl];
                bf16* rowp = ys + (size_t)(u.pm * 256 + rl) * 1024 + col0;
#pragma unroll
                for (int bj = 0; bj < 2; ++bj) { const f32x4 v0 = acc[ai][bj][m][0] * wgt, v1 = acc[ai][bj][m][1] * wgt;
                    u32x4 w; w.x = pk2(v0[0], v0[1]); w.y = pk2(v0[2], v0[3]); w.z = pk2(v1[0], v1[1]); w.w = pk2(v1[2], v1[3]);
                    *(u32x4*)(rowp + bj * 128) = w; } }
    }
};

#define XB_TMO      128
#define XB_XCNT(j)  (256  + 64 * (j))
#define XB_XSUB(j)  (1280 + 64 * (j))
#define XB_XGEN(j)  (2304 + 64 * (j))
#define XB_TOP      3328
#define XB_TOPGEN   3392
#define XCD_BAR_WORDS 3456
#define XB_SPIN_CAP (1u << 18)
__device__ __forceinline__ unsigned xb_ld(unsigned* p)              { return __hip_atomic_load(p, __ATOMIC_RELAXED, __HIP_MEMORY_SCOPE_AGENT); }
__device__ __forceinline__ unsigned xb_add(unsigned* p, unsigned v) { return __hip_atomic_fetch_add(p, v, __ATOMIC_RELAXED, __HIP_MEMORY_SCOPE_AGENT); }
__device__ __forceinline__ unsigned xb_xcc_id() { return (unsigned)__builtin_amdgcn_s_getreg((3 << 11) | 20) & 0xFu; }
#define XB_SPIN(cond, bar) do { unsigned _sp = 0; while (cond) { __builtin_amdgcn_s_sleep(1); \
    if ((++_sp & 255u) == 0u) { if (xb_ld(&(bar)[XB_TMO])) break; if (_sp > XB_SPIN_CAP) { atomicAdd(&(bar)[XB_TMO], 1u); break; } } } } while (0)
struct XcdBarrier { unsigned* bar; unsigned x; volatile LAS unsigned* st; };
__device__ __forceinline__ XcdBarrier xcd_barrier_post(unsigned* bar, volatile LAS unsigned* st) {
    XcdBarrier b; b.bar = bar; b.x = xb_xcc_id(); b.st = st;
    if (threadIdx.x == 0) (void)xb_add(&bar[XB_XCNT(b.x)], 1u);
    return b;
}
__device__ __forceinline__ void xcd_barrier_complete(unsigned* bar, unsigned x, unsigned& nloc, unsigned& nx) {
    const unsigned G = gridDim.x * gridDim.y * gridDim.z;
    unsigned sum, cnt, mine, sp = 0u;
    for (;;) {
        sum = 0u; cnt = 0u; mine = 0u;
#pragma unroll
        for (unsigned j = 0; j < 16; ++j) { const unsigned c = xb_ld(&bar[XB_XCNT(j)]); sum += c; cnt += (c > 0u) ? 1u : 0u; mine = (j == x) ? c : mine; }
        if (sum == G) break;
        __builtin_amdgcn_s_sleep(1);
        if ((++sp & 255u) == 0u) { if (xb_ld(&bar[XB_TMO])) break; if (sp > XB_SPIN_CAP) { atomicAdd(&bar[XB_TMO], 1u); break; } }
    }
    nloc = mine > 0u ? mine : 1u; nx = cnt > 0u ? cnt : 1u;
}
__device__ __forceinline__ void xcd_barrier(const XcdBarrier& b) {
    asm volatile("s_waitcnt vmcnt(0)" ::: "memory");
    __syncthreads();
    if (threadIdx.x == 0) {
        unsigned* bar = b.bar;
        __builtin_amdgcn_s_waitcnt(0);
        unsigned nloc = b.st[0], nx = b.st[1];
        if (nloc == 0u) { xcd_barrier_complete(bar, b.x, nloc, nx); b.st[0] = nloc; b.st[1] = nx; }
        const unsigned old = xb_add(&bar[XB_XSUB(b.x)], 1u);
        const unsigned gen = old / nloc;
        if (old + 1u == (gen + 1u) * nloc) {
            __builtin_amdgcn_fence(__ATOMIC_RELEASE, "agent");
            asm volatile("s_waitcnt vmcnt(0)" ::: "memory");
            const unsigned og = xb_add(&bar[XB_TOP], 1u);
            const unsigned tg = og / nx;
            if (og + 1u == (tg + 1u) * nx) xb_add(&bar[XB_TOPGEN], 1u);
            else XB_SPIN(xb_ld(&bar[XB_TOPGEN]) == tg, bar);
            __builtin_amdgcn_fence(__ATOMIC_ACQUIRE, "agent");
            xb_add(&bar[XB_XGEN(b.x)], 1u);
            asm volatile("s_waitcnt vmcnt(0)" ::: "memory");
        } else {
            XB_SPIN(xb_ld(&bar[XB_XGEN(b.x)]) == gen, bar);
            __builtin_amdgcn_fence(__ATOMIC_ACQUIRE, "agent");
            asm volatile("s_waitcnt vmcnt(0)" ::: "memory");
        }
    }
    __syncthreads();
}

struct Args { const float* in[21]; float* out; unsigned char* ws; int ph_lo, ph_hi; };

__device__ __forceinline__ void p0_transpose_item(const float* W, int ldw, int srccol0, int k0, bf16* WT, int ldt, int destrow0, LAS float* scr, int lane) {
#pragma unroll 8
    for (int i = 0; i < 32; ++i) { const int kk = 2 * i + (lane >> 5); scr[kk * 33 + (lane & 31)] = W[(size_t)(k0 + kk) * ldw + srccol0 + (lane & 31)]; }
    LDS_WAIT(); asm volatile("" ::: "memory");
    const int c = lane & 7;
#pragma unroll
    for (int j = 0; j < 4; ++j) { const int n = (lane >> 3) + 8 * j; const LAS float* s = scr + (8 * c) * 33 + n;
        u32x4 o; o.x = pk2(s[0 * 33], s[1 * 33]); o.y = pk2(s[2 * 33], s[3 * 33]); o.z = pk2(s[4 * 33], s[5 * 33]); o.w = pk2(s[6 * 33], s[7 * 33]);
        *(u32x4*)(WT + (size_t)(destrow0 + n) * ldt + k0 + 8 * c) = o; }
    LDS_WAIT(); asm volatile("" ::: "memory");
}

__device__ __forceinline__ void phase0(const Args& a, LAS unsigned char* lds, int vcu, int G, int tid, int lane, int wave) {
    unsigned char* ws = a.ws;
    const float* x = a.in[0]; const float* nw = a.in[1]; const float* w_in = a.in[2];
    LAS float* WGF = (LAS float*)(lds + 69632);
    for (int i = tid; i < 8192; i += 512) { const int g = i >> 10, k = i & 1023; WGF[i] = nw[k] * w_in[(size_t)k * 4360 + 2304 + g]; }
    __syncthreads();
    const int gw = vcu * NWAVES + wave, NGW = G * NWAVES;
    {
        f32x4 nwv[4];
#pragma unroll
        for (int j = 0; j < 4; ++j) nwv[j] = ((const f32x4*)nw)[lane + 64 * j];
        float big[4], bfg[4];
#pragma unroll
        for (int h = 0; h < 4; ++h) { big[h] = a.in[5][h]; bfg[h] = a.in[6][h]; }
        bf16* XN = (bf16*)(ws + WS_XN); float* IGF = (float*)(ws + WS_IGF);
        for (int m = gw; m < T_; m += NGW) {
            const f32x4* xr = (const f32x4*)(x + (size_t)m * 1024) + lane;
            f32x4 v[4]; float s = 0.f;
#pragma unroll
            for (int j = 0; j < 4; ++j) { v[j] = xr[64 * j]; s += (v[j].x * v[j].x + v[j].y * v[j].y) + (v[j].z * v[j].z + v[j].w * v[j].w); }
            const float rstd = 1.0f / sqrtf(wave_sum(s) * (1.f / 1024.f) + EPS_);
            unsigned long long* o8 = (unsigned long long*)(XN + (size_t)m * 1024) + lane;
#pragma unroll
            for (int j = 0; j < 4; ++j) { const f32x4 y = v[j] * rstd * nwv[j]; o8[64 * j] = (unsigned long long)pk2(y.x, y.y) | ((unsigned long long)pk2(y.z, y.w) << 32); }
            float pg[8];
#pragma unroll
            for (int g = 0; g < 8; ++g) { float p = 0.f;
#pragma unroll
                for (int j = 0; j < 4; ++j) { const f32x4 w4 = *(const LAS f32x4*)(WGF + g * 1024 + 256 * j + 4 * lane); p += (v[j].x * w4.x + v[j].y * w4.y) + (v[j].z * w4.z + v[j].w * w4.w); }
                pg[g] = wave_sum(p) * rstd; }
            if (lane == 0) {
                f32x4 o0, o1;
#pragma unroll
                for (int h = 0; h < 4; ++h) { o0[h] = pg[h] + big[h]; const float z = pg[4 + h] + bfg[h]; o1[h] = fminf(z, 0.f) - log1pf(expf(-fabsf(z))); }
                *(f32x4*)(IGF + (size_t)m * 8) = o0; *(f32x4*)(IGF + (size_t)m * 8 + 4) = o1;
            }
        }
    }
    {
        LAS float* scr = (LAS float*)(lds + wave * 8704);
        bf16* Win = (bf16*)(ws + WS_WIN); bf16* Wao = (bf16*)(ws + WS_WAO); bf16* Wmo = (bf16*)(ws + WS_WMO); bf16* Wout = (bf16*)(ws + WS_WOUT);
        bf16* Wgu = (bf16*)(ws + WS_WGU); bf16* Wdn = (bf16*)(ws + WS_WDN);
        constexpr int I_IN = 16 * 136, I_AO = 8 * 32, I_OUT = 16 * 32, I_GU = 32 * 16 * 32, I_DN = 32 * 8 * 32;
        constexpr int NITEMS = I_IN + 2 * I_AO + I_OUT + I_GU + I_DN;
        for (int it = gw; it < NITEMS; it += NGW) {
            int r = it;
            if (r < I_IN) { const int kb = r / 136, nb = r % 136, d0 = nb * 32; p0_transpose_item(w_in, 4360, d0 + (d0 >= 2304 ? 8 : 0), kb * 64, Win, 1024, d0, scr, lane); continue; } r -= I_IN;
            if (r < I_AO) { const int kb = r / 32, nb = r % 32; p0_transpose_item(a.in[9], 1024, nb * 32, kb * 64, Wao, 512, nb * 32, scr, lane); continue; } r -= I_AO;
            if (r < I_AO) { const int kb = r / 32, nb = r % 32; p0_transpose_item(a.in[10], 1024, nb * 32, kb * 64, Wmo, 512, nb * 32, scr, lane); continue; } r -= I_AO;
            if (r < I_OUT) { const int kb = r / 32, nb = r % 32; p0_transpose_item(a.in[11], 1024, nb * 32, kb * 64, Wout, 1024, nb * 32, scr, lane); continue; } r -= I_OUT;
            if (r < I_GU) { const int e = r / 512, q = r % 512, kb = q / 32, nb = q % 32, d0 = nb * 32, tt = d0 >> 8, j = d0 & 255;
                const float* src = (j < 128 ? a.in[17] : a.in[18]) + (size_t)e * 1024 * 512;
                p0_transpose_item(src, 512, 128 * tt + (j & 127), kb * 64, Wgu + (size_t)e * 1024 * 1024, 1024, d0, scr, lane); continue; } r -= I_GU;
            { const int e = r / 256, q = r % 256, kb = q / 32, nb = q % 32;
                p0_transpose_item(a.in[19] + (size_t)e * 512 * 1024, 1024, nb * 32, kb * 64, Wdn + (size_t)e * 1024 * 512, 512, nb * 32, scr, lane); }
        }
        bf16* WR = (bf16*)(ws + WS_WR);
        for (int i = (vcu * 512 + tid); i < 48 * 1024; i += G * 512) { const int n = i >> 10, k = i & 1023; float v = 0.f;
            if (n < 4) v = a.in[13][k * 4 + n]; else if (n < 36) v = a.in[15][k * 32 + (n - 4)];
            WR[i] = (bf16)(pk2(v, 0.f) & 0xffffu); }
    }
}

__device__ __forceinline__ void attn_unit(const Args& a, LAS unsigned char* lds, int b, int blk, int kvh, int tid, int lane, int wave) {
    bf16* ATT = (bf16*)(a.ws + WS_ATT);
    LAS short* Ks = (LAS short*)lds;
    LAS short* VT = (LAS short*)(lds + 36864);
    const long t0 = (long)b * SEQ_ + blk * 128;
#pragma unroll
    for (int i = 0; i < 4; ++i) { const int p = tid + 512 * i, row = p >> 3, ch = p & 7;
        u32x4 kv = (u32x4){0u, 0u, 0u, 0u}, vv = (u32x4){0u, 0u, 0u, 0u};
        if (blk > 0 || row >= 128) { const bf16* src = ATT + (t0 - 128 + row) * 768; kv = *(const u32x4*)(src + 512 + kvh * 64 + ch * 8); vv = *(const u32x4*)(src + 640 + kvh * 64 + ch * 8); }
        *(LAS u32x4*)(Ks + row * 72 + ch * 8) = kv;
        LAS short* vt = VT + (ch * 8) * 264 + row;
        vt[0 * 264] = (short)(vv.x & 0xffff); vt[1 * 264] = (short)(vv.x >> 16); vt[2 * 264] = (short)(vv.y & 0xffff); vt[3 * 264] = (short)(vv.y >> 16);
        vt[4 * 264] = (short)(vv.z & 0xffff); vt[5 * 264] = (short)(vv.z >> 16); vt[6 * 264] = (short)(vv.w & 0xffff); vt[7 * 264] = (short)(vv.w >> 16); }
    __syncthreads();
    const int q = lane & 31, h = lane >> 5;
#pragma unroll 1
    for (int gi = 0; gi < 2; ++gi) {
        const int g16 = wave * 2 + gi, g = g16 >> 2, r = g16 & 3, hq = kvh * 4 + g;
        const int i = 32 * r + q;
        bf16* qrow = ATT + (t0 + i) * 768 + hq * 64;
        bf16x8 qf[4];
#pragma unroll
        for (int s = 0; s < 4; ++s) qf[s] = *(const bf16x8*)(qrow + 16 * s + 8 * h);
        const float sink2 = a.in[7][hq] * LOG2E;
        f32x16 S[5];
#pragma unroll
        for (int tt = 0; tt < 5; ++tt) { const int jt = r + tt; f32x16 c = {};
#pragma unroll
            for (int s = 0; s < 4; ++s) { const bf16x8 kf = *(const LAS bf16x8*)(Ks + (32 * jt + q) * 72 + 16 * s + 8 * h); c = __builtin_amdgcn_mfma_f32_32x32x16_bf16(kf, qf[s], c, 0, 0, 0); }
            S[tt] = c; }
        float mx = sink2;
#pragma unroll
        for (int tt = 0; tt < 5; ++tt) { const bool tv = (blk > 0) || (r + tt >= 4);
#pragma unroll
            for (int rg = 0; rg < 16; ++rg) { const int kr = (rg & 3) + 8 * (rg >> 2) + 4 * h;
                const bool ok = tv && (tt == 0 ? (kr > q) : (tt == 4 ? (kr <= q) : true));
                const float sv = ok ? S[tt][rg] : -INFINITY; S[tt][rg] = sv; mx = fmaxf(mx, sv); } }
        mx = fmaxf(mx, __shfl_xor(mx, 32));
        float l = 0.f;
#pragma unroll
        for (int tt = 0; tt < 5; ++tt)
#pragma unroll
            for (int rg = 0; rg < 16; ++rg) { const float p = __builtin_amdgcn_exp2f(S[tt][rg] - mx); S[tt][rg] = p; l += p; }
        l += __shfl_xor(l, 32);
        l += __builtin_amdgcn_exp2f(sink2 - mx);
        const float il = 1.0f / l;
        f32x16 O[2]; O[0] = (f32x16){}; O[1] = (f32x16){};
#pragma unroll
        for (int tt = 0; tt < 5; ++tt) { const int jt = r + tt;
#pragma unroll
            for (int ks = 0; ks < 2; ++ks) {
                u32x4 pw; pw.x = pk2(S[tt][8 * ks + 0], S[tt][8 * ks + 1]); pw.y = pk2(S[tt][8 * ks + 2], S[tt][8 * ks + 3]); pw.z = pk2(S[tt][8 * ks + 4], S[tt][8 * ks + 5]); pw.w = pk2(S[tt][8 * ks + 6], S[tt][8 * ks + 7]);
                const bf16x8 pf = __builtin_bit_cast(bf16x8, pw);
#pragma unroll
                for (int dt = 0; dt < 2; ++dt) { const LAS short* vp = VT + (32 * dt + q) * 264 + 32 * jt + 16 * ks + 4 * h;
                    const s16x4 lo = *(const LAS s16x4*)vp, hi = *(const LAS s16x4*)(vp + 8);
                    const bf16x8 vf = (bf16x8){lo[0], lo[1], lo[2], lo[3], hi[0], hi[1], hi[2], hi[3]};
                    O[dt] = __builtin_amdgcn_mfma_f32_32x32x16_bf16(vf, pf, O[dt], 0, 0, 0); } } }
#pragma unroll
        for (int dt = 0; dt < 2; ++dt)
#pragma unroll
            for (int g4 = 0; g4 < 4; ++g4) { u32x2 w; w.x = pk2(O[dt][4 * g4 + 0] * il, O[dt][4 * g4 + 1] * il); w.y = pk2(O[dt][4 * g4 + 2] * il, O[dt][4 * g4 + 3] * il);
                *(u32x2*)(qrow + 32 * dt + 8 * g4 + 4 * h) = w; }
    }
    __syncthreads();
}

__device__ __forceinline__ void conv8(const bf16* MQK, const float* cw, const float* cb, long trow, int s_in_seq, int cidx, float (&y)[8]) {
    const f32x4 b0 = *(const f32x4*)(cb + cidx), b1 = *(const f32x4*)(cb + cidx + 4);
    y[0] = b0.x; y[1] = b0.y; y[2] = b0.z; y[3] = b0.w; y[4] = b1.x; y[5] = b1.y; y[6] = b1.z; y[7] = b1.w;
#pragma unroll
    for (int j = 0; j < 4; ++j) { const int d = j - 3;
        if (s_in_seq + d >= 0) {
            const u32x4 u = *(const u32x4*)(MQK + (trow + d) * 512 + cidx);
            const f32x4 w0 = *(const f32x4*)(cw + j * 512 + cidx), w1 = *(const f32x4*)(cw + j * 512 + cidx + 4);
            y[0] += w0.x * bflo(u.x); y[1] += w0.y * bfhi(u.x); y[2] += w0.z * bflo(u.y); y[3] += w0.w * bfhi(u.y);
            y[4] += w1.x * bflo(u.z); y[5] += w1.y * bfhi(u.z); y[6] += w1.z * bflo(u.w); y[7] += w1.w * bfhi(u.w);
        } }
#pragma unroll
    for (int e = 0; e < 8; ++e) y[e] = siluf_(y[e]);
}

__device__ __forceinline__ void mprep_unit(const Args& a, LAS unsigned char* lds, int unit, int tid, int lane, int wave) {
    const int hh = unit & 3, c = (unit >> 2) & 63, b = unit >> 8;
    const long t0 = (long)b * SEQ_ + c * 64;
    const bf16* MQK = (const bf16*)(a.ws + WS_MQK); const bf16* MV = (const bf16*)(a.ws + WS_MV);
    const float* IGF = (const float*)(a.ws + WS_IGF); float* CHS = (float*)(a.ws + WS_CHS) + (size_t)unit * 256;
    bf16* UT = (bf16*)(a.ws + WS_XN) + (size_t)unit * 8192;
    LAS short* KwT = (LAS short*)lds;
    LAS short* VT = (LAS short*)(lds + 9216);
    LAS float* wsv = (LAS float*)(lds + 27648);
    if (wave == 0) {
        const float lf = IGF[(t0 + lane) * 8 + 4 + hh], ig = IGF[(t0 + lane) * 8 + hh];
        float bc = lf;
#pragma unroll
        for (int o = 1; o < 64; o <<= 1) { const float t = __shfl_up(bc, o); if (lane >= o) bc += t; }
        const float bl = __shfl(bc, 63);
        const float g = bl - bc + ig; const float loc = wave_max(g);
        wsv[lane] = __expf(g - loc);
        if (lane == 0) { CHS[64] = bl; CHS[65] = loc; }
    }
    __syncthreads();
    {   const int s = tid >> 3, ch = tid & 7;
        float y[8]; conv8(MQK, a.in[3], a.in[4], t0 + s, c * 64 + s, 256 + hh * 64 + ch * 8, y);
        const float wsc = wsv[s] * 0.125f;
#pragma unroll
        for (int e = 0; e < 8; ++e) KwT[(ch * 8 + e) * 72 + s] = (short)(pk2(y[e] * wsc, 0.f) & 0xffffu);
        const bf16* vsrc = MV + (t0 + s) * 512 + hh * 128 + ch * 16;
        const u32x4 v0 = *(const u32x4*)vsrc, v1 = *(const u32x4*)(vsrc + 8);
        LAS short* vt = VT + (ch * 16) * 72 + s;
        vt[0 * 72] = (short)(v0.x & 0xffff); vt[1 * 72] = (short)(v0.x >> 16); vt[2 * 72] = (short)(v0.y & 0xffff); vt[3 * 72] = (short)(v0.y >> 16);
        vt[4 * 72] = (short)(v0.z & 0xffff); vt[5 * 72] = (short)(v0.z >> 16); vt[6 * 72] = (short)(v0.w & 0xffff); vt[7 * 72] = (short)(v0.w >> 16);
        vt[8 * 72] = (short)(v1.x & 0xffff); vt[9 * 72] = (short)(v1.x >> 16); vt[10 * 72] = (short)(v1.y & 0xffff); vt[11 * 72] = (short)(v1.y >> 16);
        vt[12 * 72] = (short)(v1.z & 0xffff); vt[13 * 72] = (short)(v1.z >> 16); vt[14 * 72] = (short)(v1.w & 0xffff); vt[15 * 72] = (short)(v1.w >> 16);
    }
    __syncthreads();
    if (tid < 64) { float n = 0.f;
#pragma unroll 8
        for (int s = 0; s < 64; ++s) n += bf2f(KwT[tid * 72 + s]);
        CHS[tid] = n; }
    {   const int dkt = wave & 1, dvt = wave >> 1, q = lane & 31, h = lane >> 5;
        f32x16 acc = {};
#pragma unroll
        for (int ks = 0; ks < 4; ++ks) { const bf16x8 af = *(const LAS bf16x8*)(KwT + (32 * dkt + q) * 72 + 16 * ks + 8 * h); const bf16x8 bfr = *(const LAS bf16x8*)(VT + (32 * dvt + q) * 72 + 16 * ks + 8 * h);
            acc = __builtin_amdgcn_mfma_f32_32x32x16_bf16(af, bfr, acc, 0, 0, 0); }
        bf16* up = UT + (32 * dvt + q) * 64 + 32 * dkt + 4 * h;
#pragma unroll
        for (int g4 = 0; g4 < 4; ++g4) { u32x2 w; w.x = pk2(acc[4 * g4 + 0], acc[4 * g4 + 1]); w.y = pk2(acc[4 * g4 + 2], acc[4 * g4 + 3]); *(u32x2*)(up + 8 * g4) = w; }
    }
    __syncthreads();
}

__device__ __forceinline__ void phase3(const Args& a, int G, int tid) {
    unsigned* UT32 = (unsigned*)(a.ws + WS_XN); float* CHS = (float*)(a.ws + WS_CHS);
    for (int item = blockIdx.x * 512 + tid; item < 32 * 4096; item += G * 512) {
        const int bh = item >> 12, ep = item & 4095, b = bh >> 2, hh = bh & 3;
        float c0 = 0.f, c1 = 0.f, nst = 0.f, m = 0.f;
#pragma unroll 1
        for (int cb = 0; cb < 64; cb += 8) {
            unsigned u[8]; float bs[8], lc[8], nl[8];
#pragma unroll
            for (int k = 0; k < 8; ++k) { const int unit = ((b * 64 + cb + k) << 2) + hh; u[k] = UT32[(size_t)unit * 4096 + ep]; bs[k] = CHS[(size_t)unit * 256 + 64]; lc[k] = CHS[(size_t)unit * 256 + 65];
                nl[k] = (ep < 64) ? CHS[(size_t)unit * 256 + ep] : 0.f; }
#pragma unroll
            for (int k = 0; k < 8; ++k) { const int unit = ((b * 64 + cb + k) << 2) + hh;
                UT32[(size_t)unit * 4096 + ep] = pk2(c0, c1);
                if (ep < 64) CHS[(size_t)unit * 256 + 128 + ep] = nst;
                if (ep == 0) CHS[(size_t)unit * 256 + 66] = m;
                const float mn = fmaxf(bs[k] + m, lc[k]); const float wc = __expf(bs[k] + m - mn), sc = __expf(lc[k] - mn);
                c0 = wc * c0 + sc * bflo(u[k]); c1 = wc * c1 + sc * bfhi(u[k]); nst = wc * nst + sc * nl[k]; m = mn; }
        }
    }
}

__device__ __forceinline__ void mout_unit(const Args& a, LAS unsigned char* lds, int unit, int tid, int lane, int wave) {
    const int hh = unit & 3, c = (unit >> 2) & 63, b = unit >> 8;
    const long t0 = (long)b * SEQ_ + c * 64;
    const bf16* MQK = (const bf16*)(a.ws + WS_MQK); const bf16* MV = (const bf16*)(a.ws + WS_MV); bf16* MO = (bf16*)(a.ws + WS_MO);
    const float* IGF = (const float*)(a.ws + WS_IGF); const float* CHS = (const float*)(a.ws + WS_CHS) + (size_t)unit * 256;
    const bf16* UT = (const bf16*)(a.ws + WS_XN) + (size_t)unit * 8192;
    LAS short* QS = (LAS short*)lds;
    LAS short* QW = (LAS short*)(lds + 9216);
    LAS short* KS = (LAS short*)(lds + 18432);
    LAS short* VT = (LAS short*)(lds + 27648);
    LAS short* CT = (LAS short*)(lds + 46080);
    LAS float* alphav = (LAS float*)(lds + 64512); LAS float* ev = (LAS float*)(lds + 64768); LAS float* wav = (LAS float*)(lds + 65024);
    LAS float* emtv = (LAS float*)(lds + 65280); LAS float* npv = (LAS float*)(lds + 65536); LAS float* red = (LAS float*)(lds + 65792);
    if (wave == 0) {
        const float lf = IGF[(t0 + lane) * 8 + 4 + hh], ig = IGF[(t0 + lane) * 8 + hh];
        float bc = lf;
#pragma unroll
        for (int o = 1; o < 64; o <<= 1) { const float t = __shfl_up(bc, o); if (lane >= o) bc += t; }
        const float mp = CHS[66];
        const float e = ig - bc; float cm = e;
#pragma unroll
        for (int o = 1; o < 64; o <<= 1) { const float t = __shfl_up(cm, o); if (lane >= o) cm = fmaxf(cm, t); }
        const float mt = bc + fmaxf(mp, cm);
        alphav[lane] = bc - mt; ev[lane] = e; wav[lane] = __expf(bc + mp - mt); emtv[lane] = __expf(-mt);
        npv[lane] = CHS[128 + lane];
    }
    __syncthreads();
    {   const int s = tid >> 3, ch = tid & 7;
        float y[8];
        conv8(MQK, a.in[3], a.in[4], t0 + s, c * 64 + s, hh * 64 + ch * 8, y);
        const float wa = wav[s];
        u32x4 w; w.x = pk2(y[0], y[1]); w.y = pk2(y[2], y[3]); w.z = pk2(y[4], y[5]); w.w = pk2(y[6], y[7]);
        *(LAS u32x4*)(QS + s * 72 + ch * 8) = w;
        w.x = pk2(y[0] * wa, y[1] * wa); w.y = pk2(y[2] * wa, y[3] * wa); w.z = pk2(y[4] * wa, y[5] * wa); w.w = pk2(y[6] * wa, y[7] * wa);
        *(LAS u32x4*)(QW + s * 72 + ch * 8) = w;
        conv8(MQK, a.in[3], a.in[4], t0 + s, c * 64 + s, 256 + hh * 64 + ch * 8, y);
        w.x = pk2(y[0] * 0.125f, y[1] * 0.125f); w.y = pk2(y[2] * 0.125f, y[3] * 0.125f); w.z = pk2(y[4] * 0.125f, y[5] * 0.125f); w.w = pk2(y[6] * 0.125f, y[7] * 0.125f);
        *(LAS u32x4*)(KS + s * 72 + ch * 8) = w;
        const bf16* vsrc = MV + (t0 + s) * 512 + hh * 128 + ch * 16;
        const u32x4 v0 = *(const u32x4*)vsrc, v1 = *(const u32x4*)(vsrc + 8);
        LAS short* vt = VT + (ch * 16) * 72 + s;
        vt[0 * 72] = (short)(v0.x & 0xffff); vt[1 * 72] = (short)(v0.x >> 16); vt[2 * 72] = (short)(v0.y & 0xffff); vt[3 * 72] = (short)(v0.y >> 16);
        vt[4 * 72] = (short)(v0.z & 0xffff); vt[5 * 72] = (short)(v0.z >> 16); vt[6 * 72] = (short)(v0.w & 0xffff); vt[7 * 72] = (short)(v0.w >> 16);
        vt[8 * 72] = (short)(v1.x & 0xffff); vt[9 * 72] = (short)(v1.x >> 16); vt[10 * 72] = (short)(v1.y & 0xffff); vt[11 * 72] = (short)(v1.y >> 16);
        vt[12 * 72] = (short)(v1.z & 0xffff); vt[13 * 72] = (short)(v1.z >> 16); vt[14 * 72] = (short)(v1.w & 0xffff); vt[15 * 72] = (short)(v1.w >> 16);
#pragma unroll
        for (int i = 0; i < 2; ++i) { const int p = tid + 512 * i, row = p >> 3, cc = p & 7; *(LAS u32x4*)(CT + row * 72 + cc * 8) = *(const u32x4*)(UT + row * 64 + cc * 8); }
    }
    __syncthreads();
    const int tt = wave >> 2, dvt = wave & 3, q = lane & 31, h = lane >> 5, t = 32 * tt + q;
    float hb[16]; float rn;
    {
        bf16x8 qf[4];
#pragma unroll
        for (int ks = 0; ks < 4; ++ks) qf[ks] = *(const LAS bf16x8*)(QS + t * 72 + 16 * ks + 8 * h);
        f32x16 O = {}; float dsum = 0.f; const float al = alphav[t];
#pragma unroll
        for (int st = 0; st < 2; ++st) {
            if (st <= tt) {
                f32x16 Sx = {};
#pragma unroll
                for (int ks = 0; ks < 4; ++ks) { const bf16x8 kf = *(const LAS bf16x8*)(KS + (32 * st + q) * 72 + 16 * ks + 8 * h); Sx = __builtin_amdgcn_mfma_f32_32x32x16_bf16(kf, qf[ks], Sx, 0, 0, 0); }
#pragma unroll
                for (int rg = 0; rg < 16; ++rg) { const int kr = (rg & 3) + 8 * (rg >> 2) + 4 * h; const int s = 32 * st + kr;
                    const float p = (s <= t) ? Sx[rg] * __expf(al + ev[s]) : 0.f; Sx[rg] = p; dsum += p; }
#pragma unroll
                for (int ks = 0; ks < 2; ++ks) {
                    u32x4 pw; pw.x = pk2(Sx[8 * ks + 0], Sx[8 * ks + 1]); pw.y = pk2(Sx[8 * ks + 2], Sx[8 * ks + 3]); pw.z = pk2(Sx[8 * ks + 4], Sx[8 * ks + 5]); pw.w = pk2(Sx[8 * ks + 6], Sx[8 * ks + 7]);
                    const bf16x8 pf = __builtin_bit_cast(bf16x8, pw);
                    const LAS short* vp = VT + (32 * dvt + q) * 72 + 32 * st + 16 * ks + 4 * h;
                    const s16x4 lo = *(const LAS s16x4*)vp, hi = *(const LAS s16x4*)(vp + 8);
                    const bf16x8 vf = (bf16x8){lo[0], lo[1], lo[2], lo[3], hi[0], hi[1], hi[2], hi[3]};
                    O = __builtin_amdgcn_mfma_f32_32x32x16_bf16(vf, pf, O, 0, 0, 0); }
            } }
        float dn = 0.f;
#pragma unroll
        for (int ks = 0; ks < 4; ++ks) { const bf16x8 qw = *(const LAS bf16x8*)(QW + t * 72 + 16 * ks + 8 * h); const bf16x8 cf = *(const LAS bf16x8*)(CT + (32 * dvt + q) * 72 + 16 * ks + 8 * h);
            O = __builtin_amdgcn_mfma_f32_32x32x16_bf16(cf, qw, O, 0, 0, 0);
#pragma unroll
            for (int j = 0; j < 8; ++j) dn += bf2f(qw[j]) * npv[16 * ks + 8 * h + j]; }
        float den = dsum + dn; den += __shfl_xor(den, 32);
        const float inv = 1.0f / fmaxf(fabsf(den), emtv[t]);
        float ssq = 0.f;
#pragma unroll
        for (int rg = 0; rg < 16; ++rg) { hb[rg] = O[rg] * inv; ssq += hb[rg] * hb[rg]; }
        ssq += __shfl_xor(ssq, 32);
        if (h == 0) red[(tt * 4 + dvt) * 32 + q] = ssq;
    }
    __syncthreads();
    {   const float tot = (red[(tt * 4 + 0) * 32 + q] + red[(tt * 4 + 1) * 32 + q]) + (red[(tt * 4 + 2) * 32 + q] + red[(tt * 4 + 3) * 32 + q]);
        rn = 1.0f / sqrtf(tot * (1.f / 128.f) + EPS_);
        const float* nw = a.in[8] + hh * 128 + 32 * dvt + 4 * h;
        bf16* op = MO + (t0 + t) * 512 + hh * 128 + 32 * dvt + 4 * h;
#pragma unroll
        for (int g4 = 0; g4 < 4; ++g4) { const f32x4 w4 = *(const f32x4*)(nw + 8 * g4); const u32x2 mo = *(const u32x2*)(op + 8 * g4);
            u32x2 w; w.x = pk2(hb[4 * g4 + 0] * rn * w4.x * bflo(mo.x), hb[4 * g4 + 1] * rn * w4.y * bfhi(mo.x)); w.y = pk2(hb[4 * g4 + 2] * rn * w4.z * bflo(mo.y), hb[4 * g4 + 3] * rn * w4.w * bfhi(mo.y));
            *(u32x2*)(op + 8 * g4) = w; }
    }
    __syncthreads();
}

__device__ __forceinline__ void phase7(const Args& a, LAS unsigned char* lds, int vcu, int G, int tid, int lane, int wave) {
    const float* x1 = a.out; const float* nw = a.in[12];
    bf16* H2 = (bf16*)(a.ws + WS_XN); float* RSTD2 = (float*)(a.ws + WS_RSTD2); const bf16* WRg = (const bf16*)(a.ws + WS_WR);
    int* LIST = (int*)(a.ws + WS_LIST); float* SW = (float*)(a.ws + WS_SW); i32x4* TOKI = (i32x4*)(a.ws + WS_TOKI);
    unsigned* gcnt = (unsigned*)(a.ws + WS_CTL) + CW_GCNT;
    LAS short* WR = (LAS short*)lds;
    LAS float* lg = (LAS float*)(lds + 99072);
    LAS float* rsl = (LAS float*)(lds + 99072 + 24576);
    LAS int* hist = (LAS int*)(lds + 99072 + 24576 + 512);
    LAS int* basev = hist + 32;
    for (int p = tid; p < 48 * 128; p += 512) { const int n = p >> 7, cc = p & 127; *(LAS u32x4*)(WR + n * 1032 + cc * 8) = *(const u32x4*)(WRg + n * 1024 + cc * 8); }
    __syncthreads();
    const int r = lane & 15, g = lane >> 4;
    for (int it = vcu; it < T_ / 128; it += G) {
        if (tid < 32) hist[tid] = 0;
        __syncthreads();
        const int row = it * 128 + wave * 16 + r;
        f32x4 acc[3]; acc[0] = (f32x4){0.f, 0.f, 0.f, 0.f}; acc[1] = acc[0]; acc[2] = acc[0];
        float ssq = 0.f;
        const float* xr = x1 + (size_t)row * 1024 + 8 * g; bf16* hr = H2 + (size_t)row * 1024 + 8 * g;
#pragma unroll 4
        for (int s = 0; s < 32; ++s) {
            const f32x4 xa = *(const f32x4*)(xr + 32 * s), xb = *(const f32x4*)(xr + 32 * s + 4);
            const f32x4 wa = *(const f32x4*)(nw + 32 * s + 8 * g), wb = *(const f32x4*)(nw + 32 * s + 8 * g + 4);
            ssq += (xa.x * xa.x + xa.y * xa.y) + (xa.z * xa.z + xa.w * xa.w) + (xb.x * xb.x + xb.y * xb.y) + (xb.z * xb.z + xb.w * xb.w);
            u32x4 w; w.x = pk2(xa.x * wa.x, xa.y * wa.y); w.y = pk2(xa.z * wa.z, xa.w * wa.w); w.z = pk2(xb.x * wb.x, xb.y * wb.y); w.w = pk2(xb.z * wb.z, xb.w * wb.w);
            *(u32x4*)(hr + 32 * s) = w;
            const bf16x8 af = __builtin_bit_cast(bf16x8, w);
#pragma unroll
            for (int nt = 0; nt < 3; ++nt) { const bf16x8 bfr = *(const LAS bf16x8*)(WR + (16 * nt + r) * 1032 + 32 * s + 8 * g); acc[nt] = __builtin_amdgcn_mfma_f32_16x16x32_bf16(af, bfr, acc[nt], 0, 0, 0); }
        }
        ssq += __shfl_xor(ssq, 16); ssq += __shfl_xor(ssq, 32);
        const float rstd = 1.0f / sqrtf(ssq * (1.f / 1024.f) + EPS_);
        if (g == 0) { RSTD2[row] = rstd; rsl[wave * 16 + r] = rstd; }
#pragma unroll
        for (int nt = 0; nt < 3; ++nt)
#pragma unroll
            for (int rg = 0; rg < 4; ++rg) lg[(wave * 16 + 4 * g + rg) * 48 + 16 * nt + r] = acc[nt][rg];
        LDS_WAIT(); asm volatile("" ::: "memory");
        int e1 = 0, e2 = 0, lr1 = 0, lr2 = 0; float w1 = 0.f, w2 = 0.f;
        if (lane < 16) {
            const LAS float* lp = lg + (wave * 16 + lane) * 48; const float rs = rsl[wave * 16 + lane];
            float gl[4]; int gi = 0; float gm;
#pragma unroll
            for (int k = 0; k < 4; ++k) gl[k] = lp[k] * rs + a.in[14][k];
            gm = gl[0];
#pragma unroll
            for (int k = 1; k < 4; ++k) if (gl[k] > gm) { gm = gl[k]; gi = k; }
            float gs = 0.f;
#pragma unroll
            for (int k = 0; k < 4; ++k) gs += expf(gl[k] - gm);
            const float gp = 1.0f / gs;
            float v1 = -INFINITY, v2 = -INFINITY; int j1 = 0, j2 = 0;
#pragma unroll
            for (int j = 0; j < 8; ++j) { const float el = lp[4 + 8 * gi + j] * rs + a.in[16][8 * gi + j];
                if (el > v1) { v2 = v1; j2 = j1; v1 = el; j1 = j; } else if (el > v2) { v2 = el; j2 = j; } }
            const float ex = expf(v2 - v1); w1 = gp / (1.0f + ex); w2 = gp * ex / (1.0f + ex);
            e1 = 8 * gi + j1; e2 = 8 * gi + j2;
            lr1 = atomicAdd((int*)(hist + e1), 1); lr2 = atomicAdd((int*)(hist + e2), 1);
        }
        __syncthreads();
        if (tid < 32) { const int n = hist[tid]; basev[tid] = n > 0 ? (int)atomicAdd(gcnt + tid, (unsigned)n) : 0; }
        __syncthreads();
        if (lane < 16) { const int tok = it * 128 + wave * 16 + lane; const int r1 = basev[e1] + lr1, r2 = basev[e2] + lr2;
            LIST[(size_t)e1 * T_ + r1] = tok; LIST[(size_t)e2 * T_ + r2] = tok; SW[(size_t)e1 * T_ + r1] = w1; SW[(size_t)e2 * T_ + r2] = w2;
            TOKI[tok] = (i32x4){e1, r1, e2, r2}; }
        __syncthreads();
    }
}

__device__ __forceinline__ void moe_tables(const Args& a, LAS unsigned char* lds, int tid) {
    LAS int* cum = (LAS int*)(lds + TAB_OFF); LAS int* cnt = cum + 64;
    const unsigned* gcnt = (const unsigned*)(a.ws + WS_CTL) + CW_GCNT;
    if (tid == 0) { int c = 0; for (int e = 0; e < NEXP; ++e) { const int n = (int)__hip_atomic_load(gcnt + e, __ATOMIC_RELAXED, __HIP_MEMORY_SCOPE_AGENT); cnt[e] = n; cum[e] = c; c += (n + 255) >> 8; } cum[NEXP] = c; }
    __syncthreads();
}

__device__ __forceinline__ void phase10(const Args& a, LAS unsigned char* lds, int vcu, int G, int lane, int wave) {
    const LAS int* cum = (const LAS int*)(lds + TAB_OFF);
    float* out = a.out; const bf16* YS = (const bf16*)(a.ws + WS_YS); const i32x4* TOKI = (const i32x4*)(a.ws + WS_TOKI); const float* nw = a.in[20];
    f32x4 nwv[4];
#pragma unroll
    for (int j = 0; j < 4; ++j) nwv[j] = ((const f32x4*)nw)[lane + 64 * j];
    const int gw = vcu * NWAVES + wave, NGW = G * NWAVES;
    for (int m = gw; m < T_; m += NGW) {
        const i32x4 ti = TOKI[m];
        const size_t s1 = (size_t)cum[ti.x] * 256 + ti.y, s2 = (size_t)cum[ti.z] * 256 + ti.w;
        f32x4* xr = (f32x4*)(out + (size_t)m * 1024) + lane;
        const u32x2* y1 = (const u32x2*)(YS + s1 * 1024) + lane; const u32x2* y2 = (const u32x2*)(YS + s2 * 1024) + lane;
        f32x4 v[4]; float s = 0.f;
#pragma unroll
        for (int j = 0; j < 4; ++j) { v[j] = xr[64 * j]; const u32x2 p1 = y1[64 * j], p2 = y2[64 * j];
            v[j].x += bflo(p1.x) + bflo(p2.x); v[j].y += bfhi(p1.x) + bfhi(p2.x); v[j].z += bflo(p1.y) + bflo(p2.y); v[j].w += bfhi(p1.y) + bfhi(p2.y);
            s += (v[j].x * v[j].x + v[j].y * v[j].y) + (v[j].z * v[j].z + v[j].w * v[j].w); }
        const float rstd = 1.0f / sqrtf(wave_sum(s) * (1.f / 1024.f) + EPS_);
#pragma unroll
        for (int j = 0; j < 4; ++j) xr[64 * j] = v[j] * rstd * nwv[j];
    }
}

__global__ void __launch_bounds__(NWAVES * 64, 2) mega_fwd(Args args) {
    extern __shared__ __attribute__((aligned(16))) unsigned char lds_raw[];
    LAS unsigned char* lds = (LAS unsigned char*)lds_raw;
    const int tid = threadIdx.x, lane = tid & 63, wave = __builtin_amdgcn_readfirstlane(tid >> 6);
    const int G = gridDim.x, bx = blockIdx.x;
    const int vcu = (G % 8 == 0) ? (bx % 8) * (G / 8) + bx / 8 : bx;
    unsigned char* ws = args.ws;
    unsigned* ctl = (unsigned*)(ws + WS_CTL);
    for (int u = tid; u < (LDS_BYTES - LDSCTL_OFF) / 4; u += NWAVES * 64) ((LAS unsigned*)(lds + LDSCTL_OFF))[u] = 0u;
    __syncthreads();
    const int lo = args.ph_lo, hi = args.ph_hi;
    const bool multi = (hi - lo) > 1;
    XcdBarrier bar; bar.bar = ctl + CW_BAR; bar.x = 0; bar.st = (volatile LAS unsigned*)(lds + MISC_OFF) + 8;
    if (multi) bar = xcd_barrier_post(ctl + CW_BAR, (volatile LAS unsigned*)(lds + MISC_OFF) + 8);
#define IN(k) (lo <= (k) && (k) < hi)
#define SEAM(k) do { if (IN(k) && IN((k) + 1)) xcd_barrier(bar); } while (0)

    if (IN(0)) { phase0(args, lds, vcu, G, tid, lane, wave); SEAM(0); }

    if (IN(1)) {
        DenseSched S{(const char*)(ws + WS_XN), (const char*)(ws + WS_WIN), 1024, 1024, T_ / 256, NIN / 256, G, bx};
        EpiProj E{(bf16*)(ws + WS_ATT), (bf16*)(ws + WS_MQK), (bf16*)(ws + WS_MV), (bf16*)(ws + WS_MO), (bf16*)(ws + WS_GATES)};
        g8::gemm_phase<EpiProj, DenseSched, true>(lds, 1024, 1024, S, E);
        SEAM(1);
    }
    if (IN(2)) {
        for (int u = vcu; u < NB_ * 32 * 2; u += G) attn_unit(args, lds, u >> 6, (u >> 1) & 31, u & 1, tid, lane, wave);
        for (int u = vcu; u < 2048; u += G) mprep_unit(args, lds, u, tid, lane, wave);
        SEAM(2);
    }
    if (IN(3)) { phase3(args, G, tid); SEAM(3); }
    if (IN(4)) { for (int u = vcu; u < 2048; u += G) mout_unit(args, lds, u, tid, lane, wave); SEAM(4); }
    if (IN(5)) {
        MixSched S{(const char*)(ws + WS_ATT), (const char*)(ws + WS_MO), (const char*)(ws + WS_WAO), (const char*)(ws + WS_WMO), 768, 512, T_ / 256, 4, G, bx};
        EpiMix E{(bf16*)(ws + WS_GATES)};
        g8::gemm_phase<EpiMix, MixSched, true>(lds, 512, 512, S, E);
        SEAM(5);
    }
    if (IN(6)) {
        DenseSched S{(const char*)(ws + WS_GATES), (const char*)(ws + WS_WOUT), 2048, 1024, T_ / 256, 4, G, bx};
        EpiOut E{args.in[0], args.out};
        g8::gemm_phase<EpiOut, DenseSched, true>(lds, 1024, 1024, S, E);
        SEAM(6);
    }
    if (IN(7)) { phase7(args, lds, vcu, G, tid, lane, wave); SEAM(7); }
    if (IN(8) || IN(9) || IN(10)) moe_tables(args, lds, tid);
    if (IN(8)) {
        const LAS int* cum = (const LAS int*)(lds + TAB_OFF); const LAS int* cnt = cum + 64;
        MoeSched S{cum, cnt, (const char*)(ws + WS_XN), (const char*)(ws + WS_WGU), (const int*)(ws + WS_LIST), G, vcu, true, 1024, 1024};
        EpiG1 E{(bf16*)(ws + WS_HID), (const float*)(ws + WS_RSTD2), (const int*)(ws + WS_LIST), cnt};
        g8::gemm_phase<EpiG1, MoeSched, true>(lds, 1024, 1024, S, E);
        SEAM(8);
    }
    if (IN(9)) {
        const LAS int* cum = (const LAS int*)(lds + TAB_OFF); const LAS int* cnt = cum + 64;
        MoeSched S{cum, cnt, (const char*)(ws + WS_HID), (const char*)(ws + WS_WDN), (const int*)(ws + WS_LIST), G, vcu, false, 512, 1024};
        EpiG2 E{(bf16*)(ws + WS_YS), (const float*)(ws + WS_SW), cnt};
        g8::gemm_phase<EpiG2, MoeSched, true>(lds, 512, 512, S, E);
        SEAM(9);
    }
    if (IN(10)) phase10(args, lds, vcu, G, lane, wave);
#undef IN
#undef SEAM
}

extern "C" void kernel_launch(void* const* d_in, const int* in_sizes, int n_in, void* d_out, int out_size, void* d_ws, size_t ws_size, hipStream_t stream) {
    static int grid = 0;
    if (grid == 0) {
        if (n_in != 21 || in_sizes[0] != T_ * D_ || out_size != T_ * D_ || ws_size < WS_END) { fprintf(stderr, "kernel_launch: unexpected shapes / workspace (n_in %d, ws %zu, need %zu)\n", n_in, ws_size, (size_t)WS_END); grid = -1; return; }
        int dev = 0, cus = 0, per_cu = 0;
        if (hipGetDevice(&dev) != hipSuccess || hipDeviceGetAttribute(&cus, hipDeviceAttributeMultiprocessorCount, dev) != hipSuccess) { grid = -1; return; }
        if (hipFuncSetAttribute((const void*)mega_fwd, hipFuncAttributeMaxDynamicSharedMemorySize, LDS_BYTES) != hipSuccess) { fprintf(stderr, "kernel_launch: hipFuncSetAttribute failed\n"); grid = -1; return; }
        if (hipOccupancyMaxActiveBlocksPerMultiprocessor(&per_cu, (const void*)mega_fwd, NWAVES * 64, LDS_BYTES) != hipSuccess || per_cu < 1) { fprintf(stderr, "kernel_launch: occupancy query reports %d blocks per CU\n", per_cu); (void)hipGetLastError(); grid = -1; return; }
        grid = cus;
    }
    if (grid < 0) return;
    (void)hipMemsetAsync((char*)d_ws + WS_CTL, 0, CTL_ZERO_BYTES, stream);
    Args a{};
    for (int i = 0; i < 21; ++i) a.in[i] = (const float*)d_in[i];
    a.out = (float*)d_out; a.ws = (unsigned char*)d_ws;
#if MK_FUSED
    a.ph_lo = 0; a.ph_hi = NPH;
    void* kargs[] = {&a};
    hipError_t e = hipLaunchCooperativeKernel((const void*)mega_fwd, dim3(grid), dim3(NWAVES * 64), kargs, LDS_BYTES, stream);
    if (e != hipSuccess) fprintf(stderr, "kernel_launch: cooperative launch failed: %s (grid %d)\n", hipGetErrorString(e), grid);
#else
    for (int p = 0; p < NPH; ++p) { a.ph_lo = p; a.ph_hi = p + 1; hipLaunchKernelGGL(mega_fwd, dim3(grid), dim3(NWAVES * 64), LDS_BYTES, stream, a); }
#endif
}
```

```cpp
#include <hip/hip_runtime.h>
#include <cstdio>
#include <cstdint>

#define LAS __attribute__((address_space(3)))
#define GAS __attribute__((address_space(1)))
typedef unsigned short bf16;
typedef short bf16x8 __attribute__((ext_vector_type(8)));
typedef short s16x4 __attribute__((ext_vector_type(4)));
typedef float f32x4 __attribute__((ext_vector_type(4)));
typedef float f32x16 __attribute__((ext_vector_type(16)));
typedef unsigned u32x4 __attribute__((ext_vector_type(4)));
typedef unsigned u32x2 __attribute__((ext_vector_type(2)));
typedef int i32x4 __attribute__((ext_vector_type(4)));
typedef float f32x2_t __attribute__((ext_vector_type(2)));
typedef __bf16 bf16x2_t __attribute__((ext_vector_type(2)));

#ifndef PROBE_PH
#define PROBE_PH -1
#endif
#ifndef PROBE_AMP
#define PROBE_AMP 4
#endif
#ifndef MK_FUSED
#define MK_FUSED 1
#endif

constexpr int T_ = 32768, D_ = 1024, SEQ_ = 4096, NB_ = 8;
constexpr int NIN = 4352;
constexpr int NEXP = 32;
constexpr float EPS_ = 1e-6f;
constexpr float LOG2E = 1.4426950408889634f;
constexpr float QSCALE = 0.125f * LOG2E;
constexpr int NWAVES = 8;
constexpr int NPH = 11;

constexpr size_t MiB = 1u << 20;
constexpr size_t WS_CTL = 0, CTL_ZERO_BYTES = 1 * MiB;
constexpr size_t WS_IGF = 1 * MiB;
constexpr size_t WS_CHS = 2 * MiB;
constexpr size_t WS_TOKI = 4 * MiB;
constexpr size_t WS_RSTD2 = 4 * MiB + 512 * 1024;
constexpr size_t WS_WR = 4 * MiB + 768 * 1024;
constexpr size_t WS_LIST = 5 * MiB;
constexpr size_t WS_SW = 9 * MiB;
constexpr size_t WS_WIN = 13 * MiB;
constexpr size_t WS_WAO = 22 * MiB, WS_WMO = 23 * MiB, WS_WOUT = 24 * MiB;
constexpr size_t WS_WGU = 26 * MiB;
constexpr size_t WS_WDN = 90 * MiB;
constexpr size_t WS_XN = 122 * MiB;
constexpr size_t WS_ATT = 186 * MiB;
constexpr size_t WS_MQK = 234 * MiB;
constexpr size_t WS_MV = 266 * MiB;
constexpr size_t WS_MO = 298 * MiB;
constexpr size_t WS_GATES = 330 * MiB;
constexpr size_t WS_HID = 186 * MiB;
constexpr size_t WS_YS = 258 * MiB;
constexpr size_t WS_END = 458 * MiB;
constexpr int CW_TMO = 0, CW_BAR = 4096, CW_GCNT = 16384;

constexpr int RING_BYTES = 131072;
constexpr int LDSCTL_OFF = RING_BYTES, MISC_OFF = LDSCTL_OFF + 320;
constexpr int TAB_OFF = LDSCTL_OFF + 1024;
constexpr int LDS_BYTES = 147456;

__device__ __forceinline__ unsigned pk2(float lo, float hi) { f32x2_t v = {lo, hi}; bf16x2_t b = __builtin_convertvector(v, bf16x2_t); return __builtin_bit_cast(unsigned, b); }
__device__ __forceinline__ float bflo(unsigned u) { return __uint_as_float(u << 16); }
__device__ __forceinline__ float bfhi(unsigned u) { return __uint_as_float(u & 0xffff0000u); }
__device__ __forceinline__ float bf2f(short s) { return __uint_as_float(((unsigned)(unsigned short)s) << 16); }
__device__ __forceinline__ float wave_sum(float v) {
#pragma unroll
    for (int o = 1; o < 64; o <<= 1) v += __shfl_xor(v, o);
    return v;
}
__device__ __forceinline__ float wave_max(float v) {
#pragma unroll
    for (int o = 1; o < 64; o <<= 1) v = fmaxf(v, __shfl_xor(v, o));
    return v;
}
__device__ __forceinline__ float sigmoidf_(float v) { return __builtin_amdgcn_rcpf(1.0f + __expf(-v)); }
__device__ __forceinline__ float siluf_(float v) { return v * __builtin_amdgcn_rcpf(1.0f + __expf(-v)); }
#define LDS_WAIT() asm volatile("s_waitcnt lgkmcnt(0)" ::: "memory")

namespace g8 {
constexpr int BM = 256, BK = 64, HALF = 128, HTB = HALF * BK * 2, STAGE_BYTES = 8 * HTB, NXCD = 8, WGM = 8;
__host__ __device__ __forceinline__ int lds_byte(int r, int c) { const int st = (r >> 4) * 2 + (c >> 5), rr = r & 15, cc = c & 31, ob = rr * 64 + cc * 2; return st * 1024 + (ob ^ (((ob >> 9) & 1) << 5)); }
__host__ __device__ __forceinline__ void stage_rc(int b, int& R, int& C) { const int st = b / 1024, sb = b % 1024, swz = sb ^ (((sb >> 9) & 1) << 5); R = (st >> 1) * 16 + swz / 64; C = (st & 1) * 32 + (swz % 64) / 2; }
__host__ __device__ __forceinline__ int perm32(int rho) { const int n = rho >> 4, i = rho & 15; return 8 * (i >> 2) + 4 * n + (i & 3); }

struct GU { const char* A; const char* B; int pm, pn, x0, x1; };

__device__ __forceinline__ void tile_of(int L, int nM, int nN, int& pm, int& pn) {
    const int nwg = nM * nN; int wgid = L; { const int q = nwg / NXCD, r = nwg % NXCD, xcd = wgid % NXCD, off = wgid / NXCD; wgid = (xcd < r ? xcd * (q + 1) : r * (q + 1) + (xcd - r) * q) + off; }
    const int nig = WGM * nN, gid = wgid / nig, fm = gid * WGM, gsz = (nM - fm) < WGM ? (nM - fm) : WGM;
    pm = fm + ((wgid % nig) % gsz); pn = (wgid % nig) / gsz;
}

template <class Epi, class Sched, bool ALIGN_EPI>
__device__ __forceinline__ void gemm_phase(LAS unsigned char* lds, const int K, const int ldb, const Sched& S, const Epi& E) {
    const int tid = threadIdx.x, wid = __builtin_amdgcn_readfirstlane(tid >> 6), lane = tid & 63, wr = wid >> 2, wc = wid & 3, fr = lane & 15, fq = lane >> 4;
    const int nt = K / BK;
    int Rr[2], Cc[2]; unsigned voffB[2];
#pragma unroll
    for (int i = 0; i < 2; ++i) { int R, C; stage_rc(tid * 16 + i * 8192, R, C); Rr[i] = R; Cc[i] = C; const int Rb = Epi::PERM ? ((R & ~31) + perm32(R & 31)) : R; voffB[i] = (unsigned)(Rb * ldb + C) * 2u; }
    const size_t kstep = (size_t)(BK * 2);
    const size_t hstepB = (size_t)HALF * ldb * 2;
    const unsigned ldsw = (unsigned)wid * 1024u;
    const int aoff = lds_byte(wr * 64 + fr, fq * 8), boff = lds_byte(wc * 32 + fr, fq * 8);
#define G8_SA(b, h) (((b) * 2 + (h)) * HTB)
#define G8_SB(b, h) ((4 + (b) * 2 + (h)) * HTB)
#define G8_STAGE(bufoff, gbase, voff) do { _Pragma("unroll") for (int _i = 0; _i < 2; ++_i) \
        __builtin_amdgcn_global_load_lds((const unsigned*)((const char*)(gbase) + (voff)[_i]), (LAS unsigned*)(lds + (bufoff) + ldsw + _i * 8192), 16, 0, 0); } while (0)
#define G8_LDA(dst, b, h) do { _Pragma("unroll") for (int m = 0; m < 4; ++m) _Pragma("unroll") for (int k = 0; k < 2; ++k) dst[m][k] = *(const LAS bf16x8*)(lds + G8_SA(b, h) + aoff + m * 2048 + k * 1024); } while (0)
#define G8_LDB(dst, b, h) do { _Pragma("unroll") for (int n = 0; n < 2; ++n) _Pragma("unroll") for (int k = 0; k < 2; ++k) dst[n][k] = *(const LAS bf16x8*)(lds + G8_SB(b, h) + boff + n * 2048 + k * 1024); } while (0)
#define G8_MMA(ai, bj, At, Bt) do { __builtin_amdgcn_s_setprio(1); _Pragma("unroll") for (int m = 0; m < 4; ++m) _Pragma("unroll") for (int n = 0; n < 2; ++n) _Pragma("unroll") for (int k = 0; k < 2; ++k) \
        acc[ai][bj][m][n] = __builtin_amdgcn_mfma_f32_16x16x32_bf16(Bt[n][k], At[m][k], acc[ai][bj][m][n], 0, 0, 0); __builtin_amdgcn_s_setprio(0); } while (0)
#define G8_WAIT_V(n) asm volatile("s_waitcnt vmcnt(" #n ")" ::: "memory")
#define G8_WAIT_L(n) asm volatile("s_waitcnt lgkmcnt(" #n ")" ::: "memory")
#define G8_BAR __builtin_amdgcn_s_barrier()
#define G8_SCHED __builtin_amdgcn_sched_barrier(0)
    GU cur, nxt; int ui = 0;
    if (!S.next(0, cur)) return;
    f32x4 acc[2][2][4][2];
#pragma unroll
    for (int a = 0; a < 2; ++a)
#pragma unroll
        for (int b = 0; b < 2; ++b)
#pragma unroll
            for (int m = 0; m < 4; ++m)
#pragma unroll
                for (int n = 0; n < 2; ++n) acc[a][b][m][n] = (f32x4){0.f, 0.f, 0.f, 0.f};
    bf16x8 At[4][2], B0[2][2], B1[2][2];
    unsigned vc0[2], vc1[2], vn0[2], vn1[2];
    S.aoff(cur, Rr, Cc, vc0, vc1);
    const char* cA = cur.A; const char* cB = cur.B;
    G8_STAGE(G8_SB(0, 0), cB, voffB); G8_STAGE(G8_SB(0, 1), cB + hstepB, voffB); G8_STAGE(G8_SA(0, 0), cA, vc0); G8_STAGE(G8_SA(0, 1), cA, vc1);
    if (wr == 1) G8_BAR;
    G8_WAIT_V(2); G8_BAR;
    G8_STAGE(G8_SB(1, 0), cB + kstep, voffB); G8_STAGE(G8_SA(1, 0), cA + kstep, vc0); G8_STAGE(G8_SB(1, 1), cB + hstepB + kstep, voffB);
    G8_WAIT_V(6); G8_BAR;
    for (;;) {
        const bool has_next = S.next(ui + 1, nxt);
        const char* nA = has_next ? nxt.A : cA; const char* nB = has_next ? nxt.B : cB;
        if (has_next) S.aoff(nxt, Rr, Cc, vn0, vn1); else { vn0[0] = vc0[0]; vn0[1] = vc0[1]; vn1[0] = vc1[0]; vn1[1] = vc1[1]; }
        for (int t = 0; t < nt; t += 2) {
            const bool last = (t == nt - 2);
            const char* a1 = cA + (size_t)(t + 1) * kstep;
            const char* a2 = last ? nA : cA + (size_t)(t + 2) * kstep; const char* b2 = last ? nB : cB + (size_t)(t + 2) * kstep;
            const char* a3 = a2 + kstep; const char* b3 = b2 + kstep;
            unsigned w0[2], w1[2]; w0[0] = last ? vn0[0] : vc0[0]; w0[1] = last ? vn0[1] : vc0[1]; w1[0] = last ? vn1[0] : vc1[0]; w1[1] = last ? vn1[1] : vc1[1];
            G8_LDB(B0, 0, 0); G8_LDB(B1, 0, 1); G8_SCHED; G8_LDA(At, 0, 0); G8_STAGE(G8_SA(1, 1), a1, vc1);
            G8_WAIT_V(8); G8_WAIT_L(0); G8_BAR; G8_MMA(0, 0, At, B0); G8_MMA(0, 1, At, B1); G8_BAR; G8_SCHED;
            G8_LDA(At, 0, 1); G8_STAGE(G8_SB(0, 0), b2, voffB); G8_STAGE(G8_SB(0, 1), b2 + hstepB, voffB); G8_STAGE(G8_SA(0, 0), a2, w0);
            G8_WAIT_V(8); G8_WAIT_L(0); G8_BAR; G8_MMA(1, 0, At, B0); G8_MMA(1, 1, At, B1); G8_BAR; G8_SCHED;
            G8_LDB(B0, 1, 0); G8_LDB(B1, 1, 1); G8_SCHED; G8_LDA(At, 1, 0); G8_STAGE(G8_SA(0, 1), a2, w1);
            G8_WAIT_V(8); G8_WAIT_L(0); G8_BAR; G8_MMA(0, 0, At, B0); G8_MMA(0, 1, At, B1); G8_BAR; G8_SCHED;
            G8_LDA(At, 1, 1); G8_STAGE(G8_SB(1, 0), b3, voffB); G8_STAGE(G8_SB(1, 1), b3 + hstepB, voffB); G8_STAGE(G8_SA(1, 0), a3, w0);
            G8_WAIT_V(8); G8_WAIT_L(0); G8_BAR; G8_MMA(1, 0, At, B0); G8_MMA(1, 1, At, B1); G8_BAR; G8_SCHED;
        }
        if constexpr (ALIGN_EPI) { if (wr == 0) G8_BAR; }
        E(acc, cur, wr, wc, fr, fq);
        if (!E.keep(cur)) {
#pragma unroll
            for (int a = 0; a < 2; ++a)
#pragma unroll
                for (int b = 0; b < 2; ++b)
#pragma unroll
                    for (int m = 0; m < 4; ++m)
#pragma unroll
                        for (int n = 0; n < 2; ++n) acc[a][b][m][n] = (f32x4){0.f, 0.f, 0.f, 0.f};
        }
        if (!has_next) break;
        cur = nxt; cA = nA; cB = nB; ++ui;
        vc0[0] = vn0[0]; vc0[1] = vn0[1]; vc1[0] = vn1[0]; vc1[1] = vn1[1];
        if constexpr (ALIGN_EPI) { if (wr == 1) G8_BAR; }
    }
    G8_WAIT_V(0);
    if constexpr (!ALIGN_EPI) { if (wr == 0) G8_BAR; }
    G8_BAR;
#undef G8_SA
#undef G8_SB
#undef G8_STAGE
#undef G8_LDA
#undef G8_LDB
#undef G8_MMA
#undef G8_WAIT_V
#undef G8_WAIT_L
#undef G8_BAR
#undef G8_SCHED
}
}

struct DenseSched {
    const char* A; const char* B; int lda, ldb, nM, nN, G, c;
    __device__ __forceinline__ bool next(int i, g8::GU& u) const {
        const long L = (long)i * G + c; if (L >= (long)nM * nN) return false;
        g8::tile_of((int)L, nM, nN, u.pm, u.pn); u.x0 = 0; u.x1 = 0;
        u.A = A + (size_t)u.pm * 256 * lda * 2; u.B = B + (size_t)u.pn * 256 * ldb * 2; return true;
    }
    __device__ __forceinline__ void aoff(const g8::GU&, const int (&R)[2], const int (&C)[2], unsigned (&v0)[2], unsigned (&v1)[2]) const {
#pragma unroll
        for (int i = 0; i < 2; ++i) { v0[i] = (unsigned)(R[i] * lda + C[i]) * 2u; v1[i] = (unsigned)((R[i] + 128) * lda + C[i]) * 2u; }
    }
};
struct MixSched {
    const char* A0; const char* A1; const char* B0; const char* B1; int lda0, lda1, nM, nN, G, c;
    __device__ __forceinline__ bool next(int i, g8::GU& u) const {
        const long L = (long)(i >> 1) * G + c; if (L >= (long)nM * nN) return false;
        g8::tile_of((int)L, nM, nN, u.pm, u.pn); const int part = i & 1; u.x0 = part; u.x1 = 0;
        u.A = (part ? A1 : A0) + (size_t)u.pm * 256 * (part ? lda1 : lda0) * 2; u.B = (part ? B1 : B0) + (size_t)u.pn * 256 * 512 * 2; return true;
    }
    __device__ __forceinline__ void aoff(const g8::GU& u, const int (&R)[2], const int (&C)[2], unsigned (&v0)[2], unsigned (&v1)[2]) const {
        const int lda = u.x0 ? lda1 : lda0;
#pragma unroll
        for (int i = 0; i < 2; ++i) { v0[i] = (unsigned)(R[i] * lda + C[i]) * 2u; v1[i] = (unsigned)((R[i] + 128) * lda + C[i]) * 2u; }
    }
};
struct MoeSched {
    const LAS int* cum; const LAS int* cnt; const char* A; const char* B; const int* list; int G, c; bool gather; int ldb, nbrows;
    __device__ __forceinline__ bool next(int i, g8::GU& u) const {
        const long L = (long)i * G + c; const int total = cum[NEXP] * 4; if (L >= total) return false;
        const int blk = (int)L >> 2; u.pn = (int)L & 3;
        int e = 0;
#pragma unroll 1
        for (int k = 16; k >= 1; k >>= 1) if (cum[e + k] <= blk) e += k;
        u.x0 = e; u.x1 = blk - cum[e]; u.pm = blk;
        u.A = gather ? A : A + (size_t)blk * 256 * 512 * 2;
        u.B = B + ((size_t)e * nbrows + (size_t)u.pn * 256) * ldb * 2; return true;
    }
    __device__ __forceinline__ void aoff(const g8::GU& u, const int (&R)[2], const int (&C)[2], unsigned (&v0)[2], unsigned (&v1)[2]) const {
        if (gather) {
            const int n = cnt[u.x0]; const int* l = list + (size_t)u.x0 * T_ + u.x1 * 256;
#pragma unroll
            for (int i = 0; i < 2; ++i) { const int r0 = R[i], r1 = R[i] + 128;
                const int t0 = (u.x1 * 256 + r0 < n) ? l[r0] : 0, t1 = (u.x1 * 256 + r1 < n) ? l[r1] : 0;
                v0[i] = (unsigned)(t0 * 1024 + C[i]) * 2u; v1[i] = (unsigned)(t1 * 1024 + C[i]) * 2u; }
        } else {
#pragma unroll
            for (int i = 0; i < 2; ++i) { v0[i] = (unsigned)(R[i] * 512 + C[i]) * 2u; v1[i] = (unsigned)((R[i] + 128) * 512 + C[i]) * 2u; }
        }
    }
};

typedef f32x4 acc_t[2][2][4][2];
struct EpiProj {
    static constexpr bool PERM = true;
    bf16 *att, *mqk, *mv, *mo, *gates;
    __device__ __forceinline__ bool keep(const g8::GU&) const { return false; }
    __device__ __forceinline__ void operator()(acc_t& acc, const g8::GU& u, int wr, int wc, int fr, int fq) const {
        const int pn = u.pn; const int row0 = u.pm * 256 + wr * 64 + fr;
        if (pn >= 9) {
            const int col0 = (pn - 9) * 128 + wc * 32 + 8 * fq;
#pragma unroll
            for (int ai = 0; ai < 2; ++ai)
#pragma unroll
                for (int m = 0; m < 4; ++m) { bf16* rowp = gates + (size_t)(row0 + ai * 128 + m * 16) * 2048 + col0;
                    float rr[8], sb[8];
#pragma unroll
                    for (int n = 0; n < 2; ++n)
#pragma unroll
                        for (int e = 0; e < 4; ++e) { const float ea = __expf(-acc[ai][0][m][n][e]), eb = __expf(-acc[ai][1][m][n][e]);
                            rr[4 * n + e] = (1.0f + eb) * __builtin_amdgcn_rcpf(1.0f + ea); sb[4 * n + e] = __builtin_amdgcn_rcpf(1.0f + eb); }
                    u32x4 w; w.x = pk2(rr[0], rr[1]); w.y = pk2(rr[2], rr[3]); w.z = pk2(rr[4], rr[5]); w.w = pk2(rr[6], rr[7]);
                    *(u32x4*)rowp = w;
                    w.x = pk2(sb[0], sb[1]); w.y = pk2(sb[2], sb[3]); w.z = pk2(sb[4], sb[5]); w.w = pk2(sb[6], sb[7]);
                    *(u32x4*)(rowp + 1024) = w; }
            return;
        }
        bf16* base; int ldc, colt, act = 0; float sc = 1.f;
        if (pn < 3) { base = att; ldc = 768; colt = pn * 256; if (pn < 2) sc = QSCALE; }
        else if (pn < 5) { base = mqk; ldc = 512; colt = (pn - 3) * 256; }
        else if (pn < 7) { base = mv; ldc = 512; colt = (pn - 5) * 256; }
        else { base = mo; ldc = 512; colt = (pn - 7) * 256; act = 1; }
        const int col0 = colt + wc * 32 + 8 * fq;
#pragma unroll
        for (int ai = 0; ai < 2; ++ai)
#pragma unroll
            for (int m = 0; m < 4; ++m) { bf16* rowp = base + (size_t)(row0 + ai * 128 + m * 16) * ldc + col0;
#pragma unroll
                for (int bj = 0; bj < 2; ++bj) { f32x4 v0 = acc[ai][bj][m][0], v1 = acc[ai][bj][m][1];
                    if (act) {
#pragma unroll
                        for (int e = 0; e < 4; ++e) { v0[e] = sigmoidf_(v0[e]); v1[e] = sigmoidf_(v1[e]); } }
                    else { v0 = v0 * sc; v1 = v1 * sc; }
                    u32x4 w; w.x = pk2(v0[0], v0[1]); w.y = pk2(v0[2], v0[3]); w.z = pk2(v1[0], v1[1]); w.w = pk2(v1[2], v1[3]);
                    *(u32x4*)(rowp + bj * 128) = w; } }
    }
};
struct EpiMix {
    static constexpr bool PERM = true;
    bf16* gates;
    __device__ __forceinline__ bool keep(const g8::GU& u) const { return u.x0 == 0; }
    __device__ __forceinline__ void operator()(acc_t& acc, const g8::GU& u, int wr, int wc, int fr, int fq) const {
        const int row0 = u.pm * 256 + wr * 64 + fr, col0 = u.pn * 256 + wc * 32 + 8 * fq; const bool fin = u.x0 != 0;
#pragma unroll
        for (int ai = 0; ai < 2; ++ai)
#pragma unroll
            for (int m = 0; m < 4; ++m) { bf16* rowp = gates + (size_t)(row0 + ai * 128 + m * 16) * 2048 + col0;
#pragma unroll
                for (int bj = 0; bj < 2; ++bj) {
                    const u32x4 gv = *(const u32x4*)(rowp + (fin ? 1024 : 0) + bj * 128);
                    f32x4 v0 = acc[ai][bj][m][0], v1 = acc[ai][bj][m][1];
                    v0[0] *= bflo(gv.x); v0[1] *= bfhi(gv.x); v0[2] *= bflo(gv.y); v0[3] *= bfhi(gv.y); v1[0] *= bflo(gv.z); v1[1] *= bfhi(gv.z); v1[2] *= bflo(gv.w); v1[3] *= bfhi(gv.w);
                    if (!fin) { acc[ai][bj][m][0] = v0; acc[ai][bj][m][1] = v1; }
                    else { u32x4 w; w.x = pk2(v0[0], v0[1]); w.y = pk2(v0[2], v0[3]); w.z = pk2(v1[0], v1[1]); w.w = pk2(v1[2], v1[3]); *(u32x4*)(rowp + bj * 128) = w; }
                } }
    }
};
struct EpiOut {
    static constexpr bool PERM = false;
    const float* x; float* out;
    __device__ __forceinline__ bool keep(const g8::GU&) const { return false; }
    __device__ __forceinline__ void operator()(acc_t& acc, const g8::GU& u, int wr, int wc, int fr, int fq) const {
        const int row0 = u.pm * 256 + wr * 64 + fr, col0 = u.pn * 256 + wc * 32 + 4 * fq;
#pragma unroll
        for (int ai = 0; ai < 2; ++ai)
#pragma unroll
            for (int m = 0; m < 4; ++m) { const size_t off = (size_t)(row0 + ai * 128 + m * 16) * 1024 + col0;
#pragma unroll
                for (int bj = 0; bj < 2; ++bj)
#pragma unroll
                    for (int n = 0; n < 2; ++n) { const f32x4 xv = *(const f32x4*)(x + off + bj * 128 + n * 16); *(f32x4*)(out + off + bj * 128 + n * 16) = xv + acc[ai][bj][m][n]; } }
    }
};
struct EpiG1 {
    static constexpr bool PERM = true;
    bf16* hid; const float* rstd2; const int* list; const LAS int* cnt;
    __device__ __forceinline__ bool keep(const g8::GU&) const { return false; }
    __device__ __forceinline__ void operator()(acc_t& acc, const g8::GU& u, int wr, int wc, int fr, int fq) const {
        const int n = cnt[u.x0]; const int* l = list + (size_t)u.x0 * T_ + u.x1 * 256;
        const int rl0 = wr * 64 + fr, col0 = u.pn * 128 + wc * 32 + 8 * fq;
#pragma unroll
        for (int ai = 0; ai < 2; ++ai)
#pragma unroll
            for (int m = 0; m < 4; ++m) { const int rl = rl0 + ai * 128 + m * 16; float rs = 0.f;
                if (u.x1 * 256 + rl < n) rs = rstd2[l[rl]];
                const f32x4 g0 = acc[ai][0][m][0] * rs, g1 = acc[ai][0][m][1] * rs, u0 = acc[ai][1][m][0] * rs, u1 = acc[ai][1][m][1] * rs;
                f32x4 h0, h1;
#pragma unroll
                for (int e = 0; e < 4; ++e) { h0[e] = siluf_(g0[e]) * u0[e]; h1[e] = siluf_(g1[e]) * u1[e]; }
                u32x4 w; w.x = pk2(h0[0], h0[1]); w.y = pk2(h0[2], h0[3]); w.z = pk2(h1[0], h1[1]); w.w = pk2(h1[2], h1[3]);
                *(u32x4*)(hid + (size_t)(u.pm * 256 + rl) * 512 + col0) = w; }
    }
};
struct EpiG2 {
    static constexpr bool PERM = true;
    bf16* ys; const float* sw; const LAS int* cnt;
    __device__ __forceinline__ bool keep(const g8::GU&) const { return false; }
    __device__ __forceinline__ void operator()(acc_t& acc, const g8::GU& u, int wr, int wc, int fr, int fq) const {
        const int n = cnt[u.x0]; const float* s = sw + (size_t)u.x0 * T_ + u.x1 * 256;
        const int rl0 = wr * 64 + fr, col0 = u.pn * 256 + wc * 32 + 8 * fq;
#pragma unroll
        for (int ai = 0; ai < 2; ++ai)
#pragma unroll
            for (int m = 0; m < 4; ++m) { const int rl = rl0 + ai * 128 + m * 16; float wgt = 0.f;
                if (u.x1 * 256 + rl < n) wgt = s[rl];
                bf16* rowp = ys + (size_t)(u.pm * 256 + rl) * 1024 + col0;
#pragma unroll
                for (int bj = 0; bj < 2; ++bj) { const f32x4 v0 = acc[ai][bj][m][0] * wgt, v1 = acc[ai][bj][m][1] * wgt;
                    u32x4 w; w.x = pk2(v0[0], v0[1]); w.y = pk2(v0[2], v0[3]); w.z = pk2(v1[0], v1[1]); w.w = pk2(v1[2], v1[3]);
                    *(u32x4*)(rowp + bj * 128) = w; } }
    }
};

#define XB_TMO      128
#define XB_XCNT(j)  (256  + 64 * (j))
#define XB_XSUB(j)  (1280 + 64 * (j))
#define XB_XGEN(j)  (2304 + 64 * (j))
#define XB_TOP      3328
#define XB_TOPGEN   3392
#define XCD_BAR_WORDS 3456
#define XB_SPIN_CAP (1u << 18)
__device__ __forceinline__ unsigned xb_ld(unsigned* p)              { return __hip_atomic_load(p, __ATOMIC_RELAXED, __HIP_MEMORY_SCOPE_AGENT); }
__device__ __forceinline__ unsigned xb_add(unsigned* p, unsigned v) { return __hip_atomic_fetch_add(p, v, __ATOMIC_RELAXED, __HIP_MEMORY_SCOPE_AGENT); }
__device__ __forceinline__ unsigned xb_xcc_id() { return (unsigned)__builtin_amdgcn_s_getreg((3 << 11) | 20) & 0xFu; }
#define XB_SPIN(cond, bar) do { unsigned _sp = 0; while (cond) { __builtin_amdgcn_s_sleep(1); \
    if ((++_sp & 255u) == 0u) { if (xb_ld(&(bar)[XB_TMO])) break; if (_sp > XB_SPIN_CAP) { atomicAdd(&(bar)[XB_TMO], 1u); break; } } } } while (0)
struct XcdBarrier { unsigned* bar; unsigned x; volatile LAS unsigned* st; };
__device__ __forceinline__ XcdBarrier xcd_barrier_post(unsigned* bar, volatile LAS unsigned* st) {
    XcdBarrier b; b.bar = bar; b.x = xb_xcc_id(); b.st = st;
    if (threadIdx.x == 0) (void)xb_add(&bar[XB_XCNT(b.x)], 1u);
    return b;
}
__device__ __forceinline__ void xcd_barrier_complete(unsigned* bar, unsigned x, unsigned& nloc, unsigned& nx) {
    const unsigned G = gridDim.x * gridDim.y * gridDim.z;
    unsigned sum, cnt, mine, sp = 0u;
    for (;;) {
        sum = 0u; cnt = 0u; mine = 0u;
#pragma unroll
        for (unsigned j = 0; j < 16; ++j) { const unsigned c = xb_ld(&bar[XB_XCNT(j)]); sum += c; cnt += (c > 0u) ? 1u : 0u; mine = (j == x) ? c : mine; }
        if (sum == G) break;
        __builtin_amdgcn_s_sleep(1);
        if ((++sp & 255u) == 0u) { if (xb_ld(&bar[XB_TMO])) break; if (sp > XB_SPIN_CAP) { atomicAdd(&bar[XB_TMO], 1u); break; } }
    }
    nloc = mine > 0u ? mine : 1u; nx = cnt > 0u ? cnt : 1u;
}
__device__ __forceinline__ void xcd_barrier(const XcdBarrier& b) {
    asm volatile("s_waitcnt vmcnt(0)" ::: "memory");
    __syncthreads();
    if (threadIdx.x == 0) {
        unsigned* bar = b.bar;
        __builtin_amdgcn_s_waitcnt(0);
        unsigned nloc = b.st[0], nx = b.st[1];
        if (nloc == 0u) { xcd_barrier_complete(bar, b.x, nloc, nx); b.st[0] = nloc; b.st[1] = nx; }
        const unsigned old = xb_add(&bar[XB_XSUB(b.x)], 1u);
        const unsigned gen = old / nloc;
        if (old + 1u == (gen + 1u) * nloc) {
            __builtin_amdgcn_fence(__ATOMIC_RELEASE, "agent");
            asm volatile("s_waitcnt vmcnt(0)" ::: "memory");
            const unsigned og = xb_add(&bar[XB_TOP], 1u);
            const unsigned tg = og / nx;
            if (og + 1u == (tg + 1u) * nx) xb_add(&bar[XB_TOPGEN], 1u);
            else XB_SPIN(xb_ld(&bar[XB_TOPGEN]) == tg, bar);
            __builtin_amdgcn_fence(__ATOMIC_ACQUIRE, "agent");
            xb_add(&bar[XB_XGEN(b.x)], 1u);
            asm volatile("s_waitcnt vmcnt(0)" ::: "memory");
        } else {
            XB_SPIN(xb_ld(&bar[XB_XGEN(b.x)]) == gen, bar);
            __builtin_amdgcn_fence(__ATOMIC_ACQUIRE, "agent");
            asm volatile("s_waitcnt vmcnt(0)" ::: "memory");
        }
    }
    __syncthreads();
}

struct Args { const float* in[21]; float* out; unsigned char* ws; int ph_lo, ph_hi; };

__device__ __forceinline__ void p0_transpose_item(const float* W, int ldw, int srccol0, int k0, bf16* WT, int ldt, int destrow0, int lane) {
    const int kk = lane >> 3, n4 = lane & 7;
    const float* src = W + (size_t)(k0 + 8 * kk) * ldw + srccol0 + 4 * n4;
    f32x4 v[8];
#pragma unroll
    for (int i = 0; i < 8; ++i) v[i] = *(const f32x4*)(src + (size_t)i * ldw);
    bf16* dst = WT + (size_t)(destrow0 + 4 * n4) * ldt + k0 + 8 * kk;
#pragma unroll
    for (int c = 0; c < 4; ++c) { u32x4 o; o.x = pk2(v[0][c], v[1][c]); o.y = pk2(v[2][c], v[3][c]); o.z = pk2(v[4][c], v[5][c]); o.w = pk2(v[6][c], v[7][c]);
        *(u32x4*)(dst + (size_t)c * ldt) = o; }
}

__device__ __forceinline__ void phase0(const Args& a, LAS unsigned char* lds, int vcu, int G, int tid, int lane, int wave) {
    unsigned char* ws = a.ws;
    const float* x = a.in[0]; const float* nw = a.in[1]; const float* w_in = a.in[2];
    LAS float* WGF = (LAS float*)(lds + 69632);
    for (int i = tid; i < 8192; i += 512) { const int g = i >> 10, k = i & 1023; WGF[i] = nw[k] * w_in[(size_t)k * 4360 + 2304 + g]; }
    __syncthreads();
    const int gw = vcu * NWAVES + wave, NGW = G * NWAVES;
    {
        f32x4 nwv[4];
#pragma unroll
        for (int j = 0; j < 4; ++j) nwv[j] = ((const f32x4*)nw)[lane + 64 * j];
        float big[4], bfg[4];
#pragma unroll
        for (int h = 0; h < 4; ++h) { big[h] = a.in[5][h]; bfg[h] = a.in[6][h]; }
        bf16* XN = (bf16*)(ws + WS_XN); float* IGF = (float*)(ws + WS_IGF);
        const bool hi32 = (lane & 32) != 0, hi16 = (lane & 16) != 0, hi8 = (lane & 8) != 0; const int gsel = lane >> 3;
        f32x4 v[4], vn[4];
        if (gw < T_) {
#pragma unroll
            for (int j = 0; j < 4; ++j) v[j] = ((const f32x4*)(x + (size_t)gw * 1024) + lane)[64 * j]; }
        for (int m = gw; m < T_; m += NGW) {
            const int mn = (m + NGW < T_) ? m + NGW : m;
#pragma unroll
            for (int j = 0; j < 4; ++j) vn[j] = ((const f32x4*)(x + (size_t)mn * 1024) + lane)[64 * j];
            float s = 0.f;
#pragma unroll
            for (int j = 0; j < 4; ++j) s += (v[j].x * v[j].x + v[j].y * v[j].y) + (v[j].z * v[j].z + v[j].w * v[j].w);
            const float rstd = 1.0f / sqrtf(wave_sum(s) * (1.f / 1024.f) + EPS_);
            unsigned long long* o8 = (unsigned long long*)(XN + (size_t)m * 1024) + lane;
#pragma unroll
            for (int j = 0; j < 4; ++j) { const f32x4 y = v[j] * rstd * nwv[j]; o8[64 * j] = (unsigned long long)pk2(y.x, y.y) | ((unsigned long long)pk2(y.z, y.w) << 32); }
            float pg[8];
#pragma unroll
            for (int g = 0; g < 8; ++g) { float p = 0.f;
#pragma unroll
                for (int j = 0; j < 4; ++j) { const f32x4 w4 = *(const LAS f32x4*)(WGF + g * 1024 + 256 * j + 4 * lane); p += (v[j].x * w4.x + v[j].y * w4.y) + (v[j].z * w4.z + v[j].w * w4.w); }
                pg[g] = p; }
            float a4[4], a2[2], a1;
#pragma unroll
            for (int i = 0; i < 4; ++i) { const float keep = hi32 ? pg[4 + i] : pg[i], send = hi32 ? pg[i] : pg[4 + i]; a4[i] = keep + __shfl_xor(send, 32); }
#pragma unroll
            for (int i = 0; i < 2; ++i) { const float keep = hi16 ? a4[2 + i] : a4[i], send = hi16 ? a4[i] : a4[2 + i]; a2[i] = keep + __shfl_xor(send, 16); }
            { const float keep = hi8 ? a2[1] : a2[0], send = hi8 ? a2[0] : a2[1]; a1 = keep + __shfl_xor(send, 8); }
            a1 += __shfl_xor(a1, 4); a1 += __shfl_xor(a1, 2); a1 += __shfl_xor(a1, 1);
            if ((lane & 7) == 0) { const float z0 = a1 * rstd;
                float o;
                if (gsel < 4) o = z0 + big[gsel & 3]; else { const float z = z0 + bfg[gsel & 3]; o = fminf(z, 0.f) - log1pf(expf(-fabsf(z))); }
                IGF[(size_t)m * 8 + gsel] = o; }
#pragma unroll
            for (int j = 0; j < 4; ++j) v[j] = vn[j];
        }
    }
    {
        bf16* Win = (bf16*)(ws + WS_WIN); bf16* Wao = (bf16*)(ws + WS_WAO); bf16* Wmo = (bf16*)(ws + WS_WMO); bf16* Wout = (bf16*)(ws + WS_WOUT);
        bf16* Wgu = (bf16*)(ws + WS_WGU); bf16* Wdn = (bf16*)(ws + WS_WDN);
        constexpr int I_IN = 16 * 136, I_AO = 8 * 32, I_OUT = 16 * 32, I_GU = 32 * 16 * 32, I_DN = 32 * 8 * 32;
        constexpr int NITEMS = I_IN + 2 * I_AO + I_OUT + I_GU + I_DN;
        for (int it = gw; it < NITEMS; it += NGW) {
            int r = it;
            if (r < I_IN) { const int kb = r / 136, nb = r % 136, d0 = nb * 32; int sc0 = d0;
                if (d0 >= 2304) { const int q = d0 - 2304, j = q >> 8, rr = q & 255; sc0 = (rr < 128 ? 2312 : 3336) + 128 * j + (rr & 127); }
                p0_transpose_item(w_in, 4360, sc0, kb * 64, Win, 1024, d0, lane); continue; } r -= I_IN;
            if (r < I_AO) { const int kb = r / 32, nb = r % 32; p0_transpose_item(a.in[9], 1024, nb * 32, kb * 64, Wao, 512, nb * 32, lane); continue; } r -= I_AO;
            if (r < I_AO) { const int kb = r / 32, nb = r % 32; p0_transpose_item(a.in[10], 1024, nb * 32, kb * 64, Wmo, 512, nb * 32, lane); continue; } r -= I_AO;
            if (r < I_OUT) { const int kb = r / 32, nb = r % 32; p0_transpose_item(a.in[11], 1024, nb * 32, kb * 64, Wout, 1024, nb * 32, lane); continue; } r -= I_OUT;
            if (r < I_GU) { const int e = r / 512, q = r % 512, kb = q / 32, nb = q % 32, d0 = nb * 32, tt = d0 >> 8, j = d0 & 255;
                const float* src = (j < 128 ? a.in[17] : a.in[18]) + (size_t)e * 1024 * 512;
                p0_transpose_item(src, 512, 128 * tt + (j & 127), kb * 64, Wgu + (size_t)e * 1024 * 1024, 1024, d0, lane); continue; } r -= I_GU;
            { const int e = r / 256, q = r % 256, kb = q / 32, nb = q % 32;
                p0_transpose_item(a.in[19] + (size_t)e * 512 * 1024, 1024, nb * 32, kb * 64, Wdn + (size_t)e * 1024 * 512, 512, nb * 32, lane); }
        }
        bf16* WR = (bf16*)(ws + WS_WR);
        for (int i = (vcu * 512 + tid); i < 48 * 1024; i += G * 512) { const int n = i >> 10, k = i & 1023; float v = 0.f;
            if (n < 4) v = a.in[13][k * 4 + n]; else if (n < 36) v = a.in[15][k * 32 + (n - 4)];
            WR[i] = (bf16)(pk2(v, 0.f) & 0xffffu); }
    }
}

__device__ __forceinline__ void attn_unit(const Args& a, LAS unsigned char* lds, int b, int blk, int kvh, int tid, int lane, int wave) {
    bf16* ATT = (bf16*)(a.ws + WS_ATT);
    LAS short* Ks = (LAS short*)lds;
    LAS short* VT = (LAS short*)(lds + 36864);
    const long t0 = (long)b * SEQ_ + blk * 128;
#pragma unroll
    for (int i = 0; i < 4; ++i) { const int p = tid + 512 * i, row = p >> 3, ch = p & 7;
        u32x4 kv = (u32x4){0u, 0u, 0u, 0u}, vv = (u32x4){0u, 0u, 0u, 0u};
        if (blk > 0 || row >= 128) { const bf16* src = ATT + (t0 - 128 + row) * 768; kv = *(const u32x4*)(src + 512 + kvh * 64 + ch * 8); vv = *(const u32x4*)(src + 640 + kvh * 64 + ch * 8); }
        *(LAS u32x4*)(Ks + row * 72 + ch * 8) = kv;
        LAS short* vt = VT + (ch * 8) * 264 + row;
        vt[0 * 264] = (short)(vv.x & 0xffff); vt[1 * 264] = (short)(vv.x >> 16); vt[2 * 264] = (short)(vv.y & 0xffff); vt[3 * 264] = (short)(vv.y >> 16);
        vt[4 * 264] = (short)(vv.z & 0xffff); vt[5 * 264] = (short)(vv.z >> 16); vt[6 * 264] = (short)(vv.w & 0xffff); vt[7 * 264] = (short)(vv.w >> 16); }
    __syncthreads();
    const int q = lane & 31, h = lane >> 5;
#pragma unroll 1
    for (int gi = 0; gi < 2; ++gi) {
        const int g16 = wave * 2 + gi, g = g16 >> 2, r = g16 & 3, hq = kvh * 4 + g;
        const int i = 32 * r + q;
        bf16* qrow = ATT + (t0 + i) * 768 + hq * 64;
        bf16x8 qf[4];
#pragma unroll
        for (int s = 0; s < 4; ++s) qf[s] = *(const bf16x8*)(qrow + 16 * s + 8 * h);
        const float sink2 = a.in[7][hq] * LOG2E;
        f32x16 S[5];
#pragma unroll
        for (int tt = 0; tt < 5; ++tt) { const int jt = r + tt; f32x16 c = {};
#pragma unroll
            for (int s = 0; s < 4; ++s) { const bf16x8 kf = *(const LAS bf16x8*)(Ks + (32 * jt + q) * 72 + 16 * s + 8 * h); c = __builtin_amdgcn_mfma_f32_32x32x16_bf16(kf, qf[s], c, 0, 0, 0); }
            S[tt] = c; }
        float mx = sink2;
#pragma unroll
        for (int tt = 0; tt < 5; ++tt) { const bool tv = (blk > 0) || (r + tt >= 4);
#pragma unroll
            for (int rg = 0; rg < 16; ++rg) { const int kr = (rg & 3) + 8 * (rg >> 2) + 4 * h;
                const bool ok = tv && (tt == 0 ? (kr > q) : (tt == 4 ? (kr <= q) : true));
                const float sv = ok ? S[tt][rg] : -INFINITY; S[tt][rg] = sv; mx = fmaxf(mx, sv); } }
        mx = fmaxf(mx, __shfl_xor(mx, 32));
        float l = 0.f;
#pragma unroll
        for (int tt = 0; tt < 5; ++tt)
#pragma unroll
            for (int rg = 0; rg < 16; ++rg) { const float p = __builtin_amdgcn_exp2f(S[tt][rg] - mx); S[tt][rg] = p; l += p; }
        l += __shfl_xor(l, 32);
        l += __builtin_amdgcn_exp2f(sink2 - mx);
        const float il = 1.0f / l;
        f32x16 O[2]; O[0] = (f32x16){}; O[1] = (f32x16){};
#pragma unroll
        for (int tt = 0; tt < 5; ++tt) { const int jt = r + tt;
#pragma unroll
            for (int ks = 0; ks < 2; ++ks) {
                u32x4 pw; pw.x = pk2(S[tt][8 * ks + 0], S[tt][8 * ks + 1]); pw.y = pk2(S[tt][8 * ks + 2], S[tt][8 * ks + 3]); pw.z = pk2(S[tt][8 * ks + 4], S[tt][8 * ks + 5]); pw.w = pk2(S[tt][8 * ks + 6], S[tt][8 * ks + 7]);
                const bf16x8 pf = __builtin_bit_cast(bf16x8, pw);
#pragma unroll
                for (int dt = 0; dt < 2; ++dt) { const LAS short* vp = VT + (32 * dt + q) * 264 + 32 * jt + 16 * ks + 4 * h;
                    const s16x4 lo = *(const LAS s16x4*)vp, hi = *(const LAS s16x4*)(vp + 8);
                    const bf16x8 vf = (bf16x8){lo[0], lo[1], lo[2], lo[3], hi[0], hi[1], hi[2], hi[3]};
                    O[dt] = __builtin_amdgcn_mfma_f32_32x32x16_bf16(vf, pf, O[dt], 0, 0, 0); } } }
#pragma unroll
        for (int dt = 0; dt < 2; ++dt)
#pragma unroll
            for (int g4 = 0; g4 < 4; ++g4) { u32x2 w; w.x = pk2(O[dt][4 * g4 + 0] * il, O[dt][4 * g4 + 1] * il); w.y = pk2(O[dt][4 * g4 + 2] * il, O[dt][4 * g4 + 3] * il);
                *(u32x2*)(qrow + 32 * dt + 8 * g4 + 4 * h) = w; }
    }
    __syncthreads();
}

__device__ __forceinline__ void conv8(const bf16* MQK, const float* cw, const float* cb, long trow, int s_in_seq, int cidx, float (&y)[8]) {
    const f32x4 b0 = *(const f32x4*)(cb + cidx), b1 = *(const f32x4*)(cb + cidx + 4);
    y[0] = b0.x; y[1] = b0.y; y[2] = b0.z; y[3] = b0.w; y[4] = b1.x; y[5] = b1.y; y[6] = b1.z; y[7] = b1.w;
#pragma unroll
    for (int j = 0; j < 4; ++j) { const int d = j - 3;
        if (s_in_seq + d >= 0) {
            const u32x4 u = *(const u32x4*)(MQK + (trow + d) * 512 + cidx);
            const f32x4 w0 = *(const f32x4*)(cw + j * 512 + cidx), w1 = *(const f32x4*)(cw + j * 512 + cidx + 4);
            y[0] += w0.x * bflo(u.x); y[1] += w0.y * bfhi(u.x); y[2] += w0.z * bflo(u.y); y[3] += w0.w * bfhi(u.y);
            y[4] += w1.x * bflo(u.z); y[5] += w1.y * bfhi(u.z); y[6] += w1.z * bflo(u.w); y[7] += w1.w * bfhi(u.w);
        } }
#pragma unroll
    for (int e = 0; e < 8; ++e) y[e] = siluf_(y[e]);
}

__device__ __forceinline__ void mprep_unit(const Args& a, LAS unsigned char* lds, int unit, int tid, int lane, int wave) {
    const int hh = unit & 3, c = (unit >> 2) & 63, b = unit >> 8;
    const long t0 = (long)b * SEQ_ + c * 64;
    const bf16* MQK = (const bf16*)(a.ws + WS_MQK); const bf16* MV = (const bf16*)(a.ws + WS_MV);
    const float* IGF = (const float*)(a.ws + WS_IGF); float* CHS = (float*)(a.ws + WS_CHS) + (size_t)unit * 256;
    bf16* UT = (bf16*)(a.ws + WS_XN) + (size_t)unit * 8192;
    LAS short* KwT = (LAS short*)lds;
    LAS short* VT = (LAS short*)(lds + 9216);
    LAS float* wsv = (LAS float*)(lds + 27648);
    if (wave == 0) {
        const float lf = IGF[(t0 + lane) * 8 + 4 + hh], ig = IGF[(t0 + lane) * 8 + hh];
        float bc = lf;
#pragma unroll
        for (int o = 1; o < 64; o <<= 1) { const float t = __shfl_up(bc, o); if (lane >= o) bc += t; }
        const float bl = __shfl(bc, 63);
        const float g = bl - bc + ig; const float loc = wave_max(g);
        wsv[lane] = __expf(g - loc);
        if (lane == 0) { CHS[64] = bl; CHS[65] = loc; }
    }
    __syncthreads();
    {   const int s = tid >> 3, ch = tid & 7;
        float y[8]; conv8(MQK, a.in[3], a.in[4], t0 + s, c * 64 + s, 256 + hh * 64 + ch * 8, y);
        const float wsc = wsv[s] * 0.125f;
#pragma unroll
        for (int e = 0; e < 8; ++e) KwT[(ch * 8 + e) * 72 + s] = (short)(pk2(y[e] * wsc, 0.f) & 0xffffu);
        const bf16* vsrc = MV + (t0 + s) * 512 + hh * 128 + ch * 16;
        const u32x4 v0 = *(const u32x4*)vsrc, v1 = *(const u32x4*)(vsrc + 8);
        LAS short* vt = VT + (ch * 16) * 72 + s;
        vt[0 * 72] = (short)(v0.x & 0xffff); vt[1 * 72] = (short)(v0.x >> 16); vt[2 * 72] = (short)(v0.y & 0xffff); vt[3 * 72] = (short)(v0.y >> 16);
        vt[4 * 72] = (short)(v0.z & 0xffff); vt[5 * 72] = (short)(v0.z >> 16); vt[6 * 72] = (short)(v0.w & 0xffff); vt[7 * 72] = (short)(v0.w >> 16);
        vt[8 * 72] = (short)(v1.x & 0xffff); vt[9 * 72] = (short)(v1.x >> 16); vt[10 * 72] = (short)(v1.y & 0xffff); vt[11 * 72] = (short)(v1.y >> 16);
        vt[12 * 72] = (short)(v1.z & 0xffff); vt[13 * 72] = (short)(v1.z >> 16); vt[14 * 72] = (short)(v1.w & 0xffff); vt[15 * 72] = (short)(v1.w >> 16);
    }
    __syncthreads();
    if (tid < 64) { float n = 0.f;
#pragma unroll 8
        for (int s = 0; s < 64; ++s) n += bf2f(KwT[tid * 72 + s]);
        CHS[tid] = n; }
    {   const int dkt = wave & 1, dvt = wave >> 1, q = lane & 31, h = lane >> 5;
        f32x16 acc = {};
#pragma unroll
        for (int ks = 0; ks < 4; ++ks) { const bf16x8 af = *(const LAS bf16x8*)(KwT + (32 * dkt + q) * 72 + 16 * ks + 8 * h); const bf16x8 bfr = *(const LAS bf16x8*)(VT + (32 * dvt + q) * 72 + 16 * ks + 8 * h);
            acc = __builtin_amdgcn_mfma_f32_32x32x16_bf16(af, bfr, acc, 0, 0, 0); }
        bf16* up = UT + (32 * dvt + q) * 64 + 32 * dkt + 4 * h;
#pragma unroll
        for (int g4 = 0; g4 < 4; ++g4) { u32x2 w; w.x = pk2(acc[4 * g4 + 0], acc[4 * g4 + 1]); w.y = pk2(acc[4 * g4 + 2], acc[4 * g4 + 3]); *(u32x2*)(up + 8 * g4) = w; }
    }
    __syncthreads();
}

__device__ __forceinline__ void phase3(const Args& a, int G, int tid) {
    unsigned* UT32 = (unsigned*)(a.ws + WS_XN); float* CHS = (float*)(a.ws + WS_CHS);
    for (int item = blockIdx.x * 512 + tid; item < 32 * 4096; item += G * 512) {
        const int bh = item >> 12, ep = item & 4095, b = bh >> 2, hh = bh & 3;
        float c0 = 0.f, c1 = 0.f, nst = 0.f, m = 0.f;
#pragma unroll 1
        for (int cb = 0; cb < 64; cb += 8) {
            unsigned u[8]; float bs[8], lc[8], nl[8];
#pragma unroll
            for (int k = 0; k < 8; ++k) { const int unit = ((b * 64 + cb + k) << 2) + hh; u[k] = UT32[(size_t)unit * 4096 + ep]; bs[k] = CHS[(size_t)unit * 256 + 64]; lc[k] = CHS[(size_t)unit * 256 + 65];
                nl[k] = (ep < 64) ? CHS[(size_t)unit * 256 + ep] : 0.f; }
#pragma unroll
            for (int k = 0; k < 8; ++k) { const int unit = ((b * 64 + cb + k) << 2) + hh;
                UT32[(size_t)unit * 4096 + ep] = pk2(c0, c1);
                if (ep < 64) CHS[(size_t)unit * 256 + 128 + ep] = nst;
                if (ep == 0) CHS[(size_t)unit * 256 + 66] = m;
                const float mn = fmaxf(bs[k] + m, lc[k]); const float wc = __expf(bs[k] + m - mn), sc = __expf(lc[k] - mn);
                c0 = wc * c0 + sc * bflo(u[k]); c1 = wc * c1 + sc * bfhi(u[k]); nst = wc * nst + sc * nl[k]; m = mn; }
        }
    }
}

__device__ __forceinline__ void mout_unit(const Args& a, LAS unsigned char* lds, int unit, int tid, int lane, int wave) {
    const int hh = unit & 3, c = (unit >> 2) & 63, b = unit >> 8;
    const long t0 = (long)b * SEQ_ + c * 64;
    const bf16* MQK = (const bf16*)(a.ws + WS_MQK); const bf16* MV = (const bf16*)(a.ws + WS_MV); bf16* MO = (bf16*)(a.ws + WS_MO);
    const float* IGF = (const float*)(a.ws + WS_IGF); const float* CHS = (const float*)(a.ws + WS_CHS) + (size_t)unit * 256;
    const bf16* UT = (const bf16*)(a.ws + WS_XN) + (size_t)unit * 8192;
    LAS short* QS = (LAS short*)lds;
    LAS short* QW = (LAS short*)(lds + 9216);
    LAS short* KS = (LAS short*)(lds + 18432);
    LAS short* VT = (LAS short*)(lds + 27648);
    LAS short* CT = (LAS short*)(lds + 46080);
    LAS float* alphav = (LAS float*)(lds + 64512); LAS float* ev = (LAS float*)(lds + 64768); LAS float* wav = (LAS float*)(lds + 65024);
    LAS float* emtv = (LAS float*)(lds + 65280); LAS float* npv = (LAS float*)(lds + 65536); LAS float* red = (LAS float*)(lds + 65792);
    if (wave == 0) {
        const float lf = IGF[(t0 + lane) * 8 + 4 + hh], ig = IGF[(t0 + lane) * 8 + hh];
        float bc = lf;
#pragma unroll
        for (int o = 1; o < 64; o <<= 1) { const float t = __shfl_up(bc, o); if (lane >= o) bc += t; }
        const float mp = CHS[66];
        const float e = ig - bc; float cm = e;
#pragma unroll
        for (int o = 1; o < 64; o <<= 1) { const float t = __shfl_up(cm, o); if (lane >= o) cm = fmaxf(cm, t); }
        const float mt = bc + fmaxf(mp, cm);
        alphav[lane] = bc - mt; ev[lane] = e; wav[lane] = __expf(bc + mp - mt); emtv[lane] = __expf(-mt);
        npv[lane] = CHS[128 + lane];
    }
    __syncthreads();
    {   const int s = tid >> 3, ch = tid & 7;
        float y[8];
        conv8(MQK, a.in[3], a.in[4], t0 + s, c * 64 + s, hh * 64 + ch * 8, y);
        const float wa = wav[s];
        u32x4 w; w.x = pk2(y[0], y[1]); w.y = pk2(y[2], y[3]); w.z = pk2(y[4], y[5]); w.w = pk2(y[6], y[7]);
        *(LAS u32x4*)(QS + s * 72 + ch * 8) = w;
        w.x = pk2(y[0] * wa, y[1] * wa); w.y = pk2(y[2] * wa, y[3] * wa); w.z = pk2(y[4] * wa, y[5] * wa); w.w = pk2(y[6] * wa, y[7] * wa);
        *(LAS u32x4*)(QW + s * 72 + ch * 8) = w;
        conv8(MQK, a.in[3], a.in[4], t0 + s, c * 64 + s, 256 + hh * 64 + ch * 8, y);
        w.x = pk2(y[0] * 0.125f, y[1] * 0.125f); w.y = pk2(y[2] * 0.125f, y[3] * 0.125f); w.z = pk2(y[4] * 0.125f, y[5] * 0.125f); w.w = pk2(y[6] * 0.125f, y[7] * 0.125f);
        *(LAS u32x4*)(KS + s * 72 + ch * 8) = w;
        const bf16* vsrc = MV + (t0 + s) * 512 + hh * 128 + ch * 16;
        const u32x4 v0 = *(const u32x4*)vsrc, v1 = *(const u32x4*)(vsrc + 8);
        LAS short* vt = VT + (ch * 16) * 72 + s;
        vt[0 * 72] = (short)(v0.x & 0xffff); vt[1 * 72] = (short)(v0.x >> 16); vt[2 * 72] = (short)(v0.y & 0xffff); vt[3 * 72] = (short)(v0.y >> 16);
        vt[4 * 72] = (short)(v0.z & 0xffff); vt[5 * 72] = (short)(v0.z >> 16); vt[6 * 72] = (short)(v0.w & 0xffff); vt[7 * 72] = (short)(v0.w >> 16);
        vt[8 * 72] = (short)(v1.x & 0xffff); vt[9 * 72] = (short)(v1.x >> 16); vt[10 * 72] = (short)(v1.y & 0xffff); vt[11 * 72] = (short)(v1.y >> 16);
        vt[12 * 72] = (short)(v1.z & 0xffff); vt[13 * 72] = (short)(v1.z >> 16); vt[14 * 72] = (short)(v1.w & 0xffff); vt[15 * 72] = (short)(v1.w >> 16);
#pragma unroll
        for (int i = 0; i < 2; ++i) { const int p = tid + 512 * i, row = p >> 3, cc = p & 7; *(LAS u32x4*)(CT + row * 72 + cc * 8) = *(const u32x4*)(UT + row * 64 + cc * 8); }
    }
    __syncthreads();
    const int tt = wave >> 2, dvt = wave & 3, q = lane & 31, h = lane >> 5, t = 32 * tt + q;
    float hb[16]; float rn;
    {
        bf16x8 qf[4];
#pragma unroll
        for (int ks = 0; ks < 4; ++ks) qf[ks] = *(const LAS bf16x8*)(QS + t * 72 + 16 * ks + 8 * h);
        f32x16 O = {}; float dsum = 0.f; const float al = alphav[t];
#pragma unroll
        for (int st = 0; st < 2; ++st) {
            if (st <= tt) {
                f32x16 Sx = {};
#pragma unroll
                for (int ks = 0; ks < 4; ++ks) { const bf16x8 kf = *(const LAS bf16x8*)(KS + (32 * st + q) * 72 + 16 * ks + 8 * h); Sx = __builtin_amdgcn_mfma_f32_32x32x16_bf16(kf, qf[ks], Sx, 0, 0, 0); }
#pragma unroll
                for (int rg = 0; rg < 16; ++rg) { const int kr = (rg & 3) + 8 * (rg >> 2) + 4 * h; const int s = 32 * st + kr;
                    const float p = (s <= t) ? Sx[rg] * __expf(al + ev[s]) : 0.f; Sx[rg] = p; dsum += p; }
#pragma unroll
                for (int ks = 0; ks < 2; ++ks) {
                    u32x4 pw; pw.x = pk2(Sx[8 * ks + 0], Sx[8 * ks + 1]); pw.y = pk2(Sx[8 * ks + 2], Sx[8 * ks + 3]); pw.z = pk2(Sx[8 * ks + 4], Sx[8 * ks + 5]); pw.w = pk2(Sx[8 * ks + 6], Sx[8 * ks + 7]);
                    const bf16x8 pf = __builtin_bit_cast(bf16x8, pw);
                    const LAS short* vp = VT + (32 * dvt + q) * 72 + 32 * st + 16 * ks + 4 * h;
                    const s16x4 lo = *(const LAS s16x4*)vp, hi = *(const LAS s16x4*)(vp + 8);
                    const bf16x8 vf = (bf16x8){lo[0], lo[1], lo[2], lo[3], hi[0], hi[1], hi[2], hi[3]};
                    O = __builtin_amdgcn_mfma_f32_32x32x16_bf16(vf, pf, O, 0, 0, 0); }
            } }
        float dn = 0.f;
#pragma unroll
        for (int ks = 0; ks < 4; ++ks) { const bf16x8 qw = *(const LAS bf16x8*)(QW + t * 72 + 16 * ks + 8 * h); const bf16x8 cf = *(const LAS bf16x8*)(CT + (32 * dvt + q) * 72 + 16 * ks + 8 * h);
            O = __builtin_amdgcn_mfma_f32_32x32x16_bf16(cf, qw, O, 0, 0, 0);
#pragma unroll
            for (int j = 0; j < 8; ++j) dn += bf2f(qw[j]) * npv[16 * ks + 8 * h + j]; }
        float den = dsum + dn; den += __shfl_xor(den, 32);
        const float inv = 1.0f / fmaxf(fabsf(den), emtv[t]);
        float ssq = 0.f;
#pragma unroll
        for (int rg = 0; rg < 16; ++rg) { hb[rg] = O[rg] * inv; ssq += hb[rg] * hb[rg]; }
        ssq += __shfl_xor(ssq, 32);
        if (h == 0) red[(tt * 4 + dvt) * 32 + q] = ssq;
    }
    __syncthreads();
    {   const float tot = (red[(tt * 4 + 0) * 32 + q] + red[(tt * 4 + 1) * 32 + q]) + (red[(tt * 4 + 2) * 32 + q] + red[(tt * 4 + 3) * 32 + q]);
        rn = 1.0f / sqrtf(tot * (1.f / 128.f) + EPS_);
        const float* nw = a.in[8] + hh * 128 + 32 * dvt + 4 * h;
        bf16* op = MO + (t0 + t) * 512 + hh * 128 + 32 * dvt + 4 * h;
#pragma unroll
        for (int g4 = 0; g4 < 4; ++g4) { const f32x4 w4 = *(const f32x4*)(nw + 8 * g4); const u32x2 mo = *(const u32x2*)(op + 8 * g4);
            u32x2 w; w.x = pk2(hb[4 * g4 + 0] * rn * w4.x * bflo(mo.x), hb[4 * g4 + 1] * rn * w4.y * bfhi(mo.x)); w.y = pk2(hb[4 * g4 + 2] * rn * w4.z * bflo(mo.y), hb[4 * g4 + 3] * rn * w4.w * bfhi(mo.y));
            *(u32x2*)(op + 8 * g4) = w; }
    }
    __syncthreads();
}

__device__ __forceinline__ void phase7(const Args& a, LAS unsigned char* lds, int vcu, int G, int tid, int lane, int wave) {
    const float* x1 = a.out; const float* nw = a.in[12];
    bf16* H2 = (bf16*)(a.ws + WS_XN); float* RSTD2 = (float*)(a.ws + WS_RSTD2); const bf16* WRg = (const bf16*)(a.ws + WS_WR);
    int* LIST = (int*)(a.ws + WS_LIST); float* SW = (float*)(a.ws + WS_SW); i32x4* TOKI = (i32x4*)(a.ws + WS_TOKI);
    unsigned* gcnt = (unsigned*)(a.ws + WS_CTL) + CW_GCNT;
    LAS short* WR = (LAS short*)lds;
    LAS float* lg = (LAS float*)(lds + 99072);
    LAS float* rsl = (LAS float*)(lds + 99072 + 24576);
    LAS int* hist = (LAS int*)(lds + 99072 + 24576 + 512);
    LAS int* basev = hist + 32;
    for (int p = tid; p < 48 * 128; p += 512) { const int n = p >> 7, cc = p & 127; *(LAS u32x4*)(WR + n * 1032 + cc * 8) = *(const u32x4*)(WRg + n * 1024 + cc * 8); }
    __syncthreads();
    const int r = lane & 15, g = lane >> 4;
    for (int it = vcu; it < T_ / 128; it += G) {
        if (tid < 32) hist[tid] = 0;
        __syncthreads();
        const int row = it * 128 + wave * 16 + r;
        f32x4 acc[3]; acc[0] = (f32x4){0.f, 0.f, 0.f, 0.f}; acc[1] = acc[0]; acc[2] = acc[0];
        float ssq = 0.f;
        const float* xr = x1 + (size_t)row * 1024 + 8 * g; bf16* hr = H2 + (size_t)row * 1024 + 8 * g;
#pragma unroll 4
        for (int s = 0; s < 32; ++s) {
            const f32x4 xa = *(const f32x4*)(xr + 32 * s), xb = *(const f32x4*)(xr + 32 * s + 4);
            const f32x4 wa = *(const f32x4*)(nw + 32 * s + 8 * g), wb = *(const f32x4*)(nw + 32 * s + 8 * g + 4);
            ssq += (xa.x * xa.x + xa.y * xa.y) + (xa.z * xa.z + xa.w * xa.w) + (xb.x * xb.x + xb.y * xb.y) + (xb.z * xb.z + xb.w * xb.w);
            u32x4 w; w.x = pk2(xa.x * wa.x, xa.y * wa.y); w.y = pk2(xa.z * wa.z, xa.w * wa.w); w.z = pk2(xb.x * wb.x, xb.y * wb.y); w.w = pk2(xb.z * wb.z, xb.w * wb.w);
            *(u32x4*)(hr + 32 * s) = w;
            const bf16x8 af = __builtin_bit_cast(bf16x8, w);
#pragma unroll
            for (int nt = 0; nt < 3; ++nt) { const bf16x8 bfr = *(const LAS bf16x8*)(WR + (16 * nt + r) * 1032 + 32 * s + 8 * g); acc[nt] = __builtin_amdgcn_mfma_f32_16x16x32_bf16(af, bfr, acc[nt], 0, 0, 0); }
        }
        ssq += __shfl_xor(ssq, 16); ssq += __shfl_xor(ssq, 32);
        const float rstd = 1.0f / sqrtf(ssq * (1.f / 1024.f) + EPS_);
        if (g == 0) { RSTD2[row] = rstd; rsl[wave * 16 + r] = rstd; }
#pragma unroll
        for (int nt = 0; nt < 3; ++nt)
#pragma unroll
            for (int rg = 0; rg < 4; ++rg) lg[(wave * 16 + 4 * g + rg) * 48 + 16 * nt + r] = acc[nt][rg];
        LDS_WAIT(); asm volatile("" ::: "memory");
        int e1 = 0, e2 = 0, lr1 = 0, lr2 = 0; float w1 = 0.f, w2 = 0.f;
        if (lane < 16) {
            const LAS float* lp = lg + (wave * 16 + lane) * 48; const float rs = rsl[wave * 16 + lane];
            float gl[4]; int gi = 0; float gm;
#pragma unroll
            for (int k = 0; k < 4; ++k) gl[k] = lp[k] * rs + a.in[14][k];
            gm = gl[0];
#pragma unroll
            for (int k = 1; k < 4; ++k) if (gl[k] > gm) { gm = gl[k]; gi = k; }
            float gs = 0.f;
#pragma unroll
            for (int k = 0; k < 4; ++k) gs += expf(gl[k] - gm);
            const float gp = 1.0f / gs;
            float v1 = -INFINITY, v2 = -INFINITY; int j1 = 0, j2 = 0;
#pragma unroll
            for (int j = 0; j < 8; ++j) { const float el = lp[4 + 8 * gi + j] * rs + a.in[16][8 * gi + j];
                if (el > v1) { v2 = v1; j2 = j1; v1 = el; j1 = j; } else if (el > v2) { v2 = el; j2 = j; } }
            const float ex = expf(v2 - v1); w1 = gp / (1.0f + ex); w2 = gp * ex / (1.0f + ex);
            e1 = 8 * gi + j1; e2 = 8 * gi + j2;
            lr1 = atomicAdd((int*)(hist + e1), 1); lr2 = atomicAdd((int*)(hist + e2), 1);
        }
        __syncthreads();
        if (tid < 32) { const int n = hist[tid]; basev[tid] = n > 0 ? (int)atomicAdd(gcnt + tid, (unsigned)n) : 0; }
        __syncthreads();
        if (lane < 16) { const int tok = it * 128 + wave * 16 + lane; const int r1 = basev[e1] + lr1, r2 = basev[e2] + lr2;
            LIST[(size_t)e1 * T_ + r1] = tok; LIST[(size_t)e2 * T_ + r2] = tok; SW[(size_t)e1 * T_ + r1] = w1; SW[(size_t)e2 * T_ + r2] = w2;
            TOKI[tok] = (i32x4){e1, r1, e2, r2}; }
        __syncthreads();
    }
}

__device__ __forceinline__ void moe_tables(const Args& a, LAS unsigned char* lds, int tid) {
    LAS int* cum = (LAS int*)(lds + TAB_OFF); LAS int* cnt = cum + 64;
    const unsigned* gcnt = (const unsigned*)(a.ws + WS_CTL) + CW_GCNT;
    if (tid == 0) { int c = 0; for (int e = 0; e < NEXP; ++e) { const int n = (int)__hip_atomic_load(gcnt + e, __ATOMIC_RELAXED, __HIP_MEMORY_SCOPE_AGENT); cnt[e] = n; cum[e] = c; c += (n + 255) >> 8; } cum[NEXP] = c; }
    __syncthreads();
}

__device__ __forceinline__ void phase10(const Args& a, LAS unsigned char* lds, int vcu, int G, int lane, int wave) {
    const LAS int* cum = (const LAS int*)(lds + TAB_OFF);
    float* out = a.out; const bf16* YS = (const bf16*)(a.ws + WS_YS); const i32x4* TOKI = (const i32x4*)(a.ws + WS_TOKI); const float* nw = a.in[20];
    f32x4 nwv[4];
#pragma unroll
    for (int j = 0; j < 4; ++j) nwv[j] = ((const f32x4*)nw)[lane + 64 * j];
    const int gw = vcu * NWAVES + wave, NGW = G * NWAVES;
    for (int m = gw; m < T_; m += NGW) {
        const i32x4 ti = TOKI[m];
        const size_t s1 = (size_t)cum[ti.x] * 256 + ti.y, s2 = (size_t)cum[ti.z] * 256 + ti.w;
        f32x4* xr = (f32x4*)(out + (size_t)m * 1024) + lane;
        const u32x2* y1 = (const u32x2*)(YS + s1 * 1024) + lane; const u32x2* y2 = (const u32x2*)(YS + s2 * 1024) + lane;
        f32x4 v[4]; float s = 0.f;
#pragma unroll
        for (int j = 0; j < 4; ++j) { v[j] = xr[64 * j]; const u32x2 p1 = y1[64 * j], p2 = y2[64 * j];
            v[j].x += bflo(p1.x) + bflo(p2.x); v[j].y += bfhi(p1.x) + bfhi(p2.x); v[j].z += bflo(p1.y) + bflo(p2.y); v[j].w += bfhi(p1.y) + bfhi(p2.y);
            s += (v[j].x * v[j].x + v[j].y * v[j].y) + (v[j].z * v[j].z + v[j].w * v[j].w); }
        const float rstd = 1.0f / sqrtf(wave_sum(s) * (1.f / 1024.f) + EPS_);
#pragma unroll
        for (int j = 0; j < 4; ++j) xr[64 * j] = v[j] * rstd * nwv[j];
    }
}

__global__ void __launch_bounds__(NWAVES * 64, 2) mega_fwd(Args args) {
    extern __shared__ __attribute__((aligned(16))) unsigned char lds_raw[];
    LAS unsigned char* lds = (LAS unsigned char*)lds_raw;
    const int tid = threadIdx.x, lane = tid & 63, wave = __builtin_amdgcn_readfirstlane(tid >> 6);
    const int G = gridDim.x, bx = blockIdx.x;
    const int vcu = (G % 8 == 0) ? (bx % 8) * (G / 8) + bx / 8 : bx;
    unsigned char* ws = args.ws;
    unsigned* ctl = (unsigned*)(ws + WS_CTL);
    for (int u = tid; u < (LDS_BYTES - LDSCTL_OFF) / 4; u += NWAVES * 64) ((LAS unsigned*)(lds + LDSCTL_OFF))[u] = 0u;
    __syncthreads();
    const int lo = args.ph_lo, hi = args.ph_hi;
    const bool multi = (hi - lo) > 1;
    XcdBarrier bar; bar.bar = ctl + CW_BAR; bar.x = 0; bar.st = (volatile LAS unsigned*)(lds + MISC_OFF) + 8;
    if (multi) bar = xcd_barrier_post(ctl + CW_BAR, (volatile LAS unsigned*)(lds + MISC_OFF) + 8);
#define IN(k) (lo <= (k) && (k) < hi)
#if PROBE_PH >= 0
    unsigned long long tp0 = 0, tp1 = 0;
#define SEAM(k) do { if (IN(k) && IN((k) + 1)) xcd_barrier(bar); if ((k) == PROBE_PH) tp1 = __builtin_amdgcn_s_memrealtime(); if ((k) + 1 == PROBE_PH) tp0 = __builtin_amdgcn_s_memrealtime(); } while (0)
    if (PROBE_PH == 0) tp0 = __builtin_amdgcn_s_memrealtime();
#else
#define SEAM(k) do { if (IN(k) && IN((k) + 1)) xcd_barrier(bar); } while (0)
#endif

    if (IN(0)) { phase0(args, lds, vcu, G, tid, lane, wave); SEAM(0); }

    if (IN(1)) {
        DenseSched S{(const char*)(ws + WS_XN), (const char*)(ws + WS_WIN), 1024, 1024, T_ / 256, NIN / 256, G, bx};
        EpiProj E{(bf16*)(ws + WS_ATT), (bf16*)(ws + WS_MQK), (bf16*)(ws + WS_MV), (bf16*)(ws + WS_MO), (bf16*)(ws + WS_GATES)};
        g8::gemm_phase<EpiProj, DenseSched, true>(lds, 1024, 1024, S, E);
        SEAM(1);
    }
    if (IN(2)) {
        for (int u = vcu; u < NB_ * 32 * 2; u += G) attn_unit(args, lds, u >> 6, (u >> 1) & 31, u & 1, tid, lane, wave);
        for (int u = vcu; u < 2048; u += G) mprep_unit(args, lds, u, tid, lane, wave);
        SEAM(2);
    }
    if (IN(3)) { phase3(args, G, tid); SEAM(3); }
    if (IN(4)) { for (int u = vcu; u < 2048; u += G) mout_unit(args, lds, u, tid, lane, wave); SEAM(4); }
    if (IN(5)) {
        MixSched S{(const char*)(ws + WS_ATT), (const char*)(ws + WS_MO), (const char*)(ws + WS_WAO), (const char*)(ws + WS_WMO), 768, 512, T_ / 256, 4, G, bx};
        EpiMix E{(bf16*)(ws + WS_GATES)};
        g8::gemm_phase<EpiMix, MixSched, true>(lds, 512, 512, S, E);
        SEAM(5);
    }
    if (IN(6)) {
        DenseSched S{(const char*)(ws + WS_GATES), (const char*)(ws + WS_WOUT), 2048, 1024, T_ / 256, 4, G, bx};
        EpiOut E{args.in[0], args.out};
        g8::gemm_phase<EpiOut, DenseSched, true>(lds, 1024, 1024, S, E);
        SEAM(6);
    }
    if (IN(7)) { phase7(args, lds, vcu, G, tid, lane, wave); SEAM(7); }
    if (IN(8) || IN(9) || IN(10)) moe_tables(args, lds, tid);
    if (IN(8)) {
        const LAS int* cum = (const LAS int*)(lds + TAB_OFF); const LAS int* cnt = cum + 64;
        MoeSched S{cum, cnt, (const char*)(ws + WS_XN), (const char*)(ws + WS_WGU), (const int*)(ws + WS_LIST), G, vcu, true, 1024, 1024};
        EpiG1 E{(bf16*)(ws + WS_HID), (const float*)(ws + WS_RSTD2), (const int*)(ws + WS_LIST), cnt};
        g8::gemm_phase<EpiG1, MoeSched, true>(lds, 1024, 1024, S, E);
        SEAM(8);
    }
    if (IN(9)) {
        const LAS int* cum = (const LAS int*)(lds + TAB_OFF); const LAS int* cnt = cum + 64;
        MoeSched S{cum, cnt, (const char*)(ws + WS_HID), (const char*)(ws + WS_WDN), (const int*)(ws + WS_LIST), G, vcu, false, 512, 1024};
        EpiG2 E{(bf16*)(ws + WS_YS), (const float*)(ws + WS_SW), cnt};
        g8::gemm_phase<EpiG2, MoeSched, true>(lds, 512, 512, S, E);
        SEAM(9);
    }
    if (IN(10)) phase10(args, lds, vcu, G, lane, wave);
#if PROBE_PH >= 0
    if (PROBE_PH == 10) { asm volatile("s_waitcnt vmcnt(0)" ::: "memory"); __syncthreads(); tp1 = __builtin_amdgcn_s_memrealtime(); }
    if (bx == 0 && tid == 0) { const unsigned long long d = (tp1 - tp0) * PROBE_AMP; const unsigned long long te = __builtin_amdgcn_s_memrealtime(); while (__builtin_amdgcn_s_memrealtime() - te < d) __builtin_amdgcn_s_sleep(8); }
#endif
#undef IN
#undef SEAM
}

extern "C" void kernel_launch(void* const* d_in, const int* in_sizes, int n_in, void* d_out, int out_size, void* d_ws, size_t ws_size, hipStream_t stream) {
    static int grid = 0;
    if (grid == 0) {
        if (n_in != 21 || in_sizes[0] != T_ * D_ || out_size != T_ * D_ || ws_size < WS_END) { fprintf(stderr, "kernel_launch: unexpected shapes / workspace (n_in %d, ws %zu, need %zu)\n", n_in, ws_size, (size_t)WS_END); grid = -1; return; }
        int dev = 0, cus = 0, per_cu = 0;
        if (hipGetDevice(&dev) != hipSuccess || hipDeviceGetAttribute(&cus, hipDeviceAttributeMultiprocessorCount, dev) != hipSuccess) { grid = -1; return; }
        if (hipFuncSetAttribute((const void*)mega_fwd, hipFuncAttributeMaxDynamicSharedMemorySize, LDS_BYTES) != hipSuccess) { fprintf(stderr, "kernel_launch: hipFuncSetAttribute failed\n"); grid = -1; return; }
        if (hipOccupancyMaxActiveBlocksPerMultiprocessor(&per_cu, (const void*)mega_fwd, NWAVES * 64, LDS_BYTES) != hipSuccess || per_cu < 1) { fprintf(stderr, "kernel_launch: occupancy query reports %d blocks per CU\n", per_cu); (void)hipGetLastError(); grid = -1; return; }
        grid = cus;
    }
    if (grid < 0) return;
    (void)hipMemsetAsync((char*)d_ws + WS_CTL, 0, CTL_ZERO_BYTES, stream);
    Args a{};
    for (int i = 0; i < 21; ++i) a.in[i] = (const float*)d_in[i];
    a.out = (float*)d_out; a.ws = (unsigned char*)d_ws;
#if MK_FUSED
    a.ph_lo = 0; a.ph_hi = NPH;
    void* kargs[] = {&a};
    hipError_t e = hipLaunchCooperativeKernel((const void*)mega_fwd, dim3(grid), dim3(NWAVES * 64), kargs, LDS_BYTES, stream);
    if (e != hipSuccess) fprintf(stderr, "kernel_launch: cooperative launch failed: %s (grid %d)\n", hipGetErrorString(e), grid);
#else
    for (int p = 0; p < NPH; ++p) { a.ph_lo = p; a.ph_hi = p + 1; hipLaunchKernelGGL(mega_fwd, dim3(grid), dim3(NWAVES * 64), LDS_BYTES, stream, a); }
#endif
}
```

```cpp
#include <hip/hip_runtime.h>
#include <cstdio>
#include <cstdint>

#define LAS __attribute__((address_space(3)))
#define GAS __attribute__((address_space(1)))
typedef unsigned short bf16;
typedef short bf16x8 __attribute__((ext_vector_type(8)));
typedef short s16x4 __attribute__((ext_vector_type(4)));
typedef float f32x4 __attribute__((ext_vector_type(4)));
typedef float f32x16 __attribute__((ext_vector_type(16)));
typedef unsigned u32x4 __attribute__((ext_vector_type(4)));
typedef unsigned u32x2 __attribute__((ext_vector_type(2)));
typedef int i32x4 __attribute__((ext_vector_type(4)));
typedef float f32x2_t __attribute__((ext_vector_type(2)));
typedef __bf16 bf16x2_t __attribute__((ext_vector_type(2)));

#ifndef PROBE_PH
#define PROBE_PH -1
#endif
#ifndef PROBE_AMP
#define PROBE_AMP 4
#endif
#ifndef PH_MASK
#define PH_MASK 0x7ff
#endif
#ifndef MK_FUSED
#define MK_FUSED 1
#endif

constexpr int T_ = 32768, D_ = 1024, SEQ_ = 4096, NB_ = 8;
constexpr int NIN = 4352;
constexpr int NEXP = 32;
constexpr float EPS_ = 1e-6f;
constexpr float LOG2E = 1.4426950408889634f;
constexpr float QSCALE = 0.125f * LOG2E;
constexpr int NWAVES = 8;
constexpr int NPH = 11;

constexpr size_t MiB = 1u << 20;
constexpr size_t WS_CTL = 0, CTL_ZERO_BYTES = 1 * MiB;
constexpr size_t WS_IGF = 1 * MiB;
constexpr size_t WS_CHS = 2 * MiB;
constexpr size_t WS_TOKI = 4 * MiB;
constexpr size_t WS_RSTD2 = 4 * MiB + 512 * 1024;
constexpr size_t WS_WR = 4 * MiB + 768 * 1024;
constexpr size_t WS_LIST = 5 * MiB;
constexpr size_t WS_SW = 9 * MiB;
constexpr size_t WS_WIN = 13 * MiB;
constexpr size_t WS_WAO = 22 * MiB, WS_WMO = 23 * MiB, WS_WOUT = 24 * MiB;
constexpr size_t WS_WGU = 26 * MiB;
constexpr size_t WS_WDN = 90 * MiB;
constexpr size_t WS_XN = 122 * MiB;
constexpr size_t WS_ATT = 186 * MiB;
constexpr size_t WS_MQK = 234 * MiB;
constexpr size_t WS_MV = 266 * MiB;
constexpr size_t WS_MO = 298 * MiB;
constexpr size_t WS_GATES = 330 * MiB;
constexpr size_t WS_HID = 186 * MiB;
constexpr size_t WS_YS = 258 * MiB;
constexpr size_t WS_END = 458 * MiB;
constexpr int CW_TMO = 0, CW_BAR = 4096, CW_GCNT = 16384;

constexpr int RING_BYTES = 131072;
constexpr int LDS_BYTES = 163840;
constexpr int LDSCTL_OFF = LDS_BYTES - 1024, MISC_OFF = LDSCTL_OFF;
constexpr int TAB_OFF = LDSCTL_OFF + 256;
constexpr int STG_OFF = 7 * 16384;
constexpr int STG_ROWB = 528, STG_BUF = 32 * STG_ROWB;

__device__ __forceinline__ unsigned pk2(float lo, float hi) { f32x2_t v = {lo, hi}; bf16x2_t b = __builtin_convertvector(v, bf16x2_t); return __builtin_bit_cast(unsigned, b); }
__device__ __forceinline__ float bflo(unsigned u) { return __uint_as_float(u << 16); }
__device__ __forceinline__ float bfhi(unsigned u) { return __uint_as_float(u & 0xffff0000u); }
__device__ __forceinline__ float bf2f(short s) { return __uint_as_float(((unsigned)(unsigned short)s) << 16); }
__device__ __forceinline__ float wave_sum(float v) {
#pragma unroll
    for (int o = 1; o < 64; o <<= 1) v += __shfl_xor(v, o);
    return v;
}
__device__ __forceinline__ float wave_max(float v) {
#pragma unroll
    for (int o = 1; o < 64; o <<= 1) v = fmaxf(v, __shfl_xor(v, o));
    return v;
}
__device__ __forceinline__ float sigmoidf_(float v) { return __builtin_amdgcn_rcpf(1.0f + __expf(-v)); }
__device__ __forceinline__ float siluf_(float v) { return v * __builtin_amdgcn_rcpf(1.0f + __expf(-v)); }
#define LDS_WAIT() asm volatile("s_waitcnt lgkmcnt(0)" ::: "memory")

namespace g8 {
constexpr int BM = 256, BK = 64, HALF = 128, HTB = HALF * BK * 2, STAGE_BYTES = 8 * HTB, NXCD = 8, WGM = 8;
__host__ __device__ __forceinline__ int lds_byte(int r, int c) { const int st = (r >> 4) * 2 + (c >> 5), rr = r & 15, cc = c & 31, ob = rr * 64 + cc * 2; return st * 1024 + (ob ^ (((ob >> 9) & 1) << 5)); }
__host__ __device__ __forceinline__ void stage_rc(int b, int& R, int& C) { const int st = b / 1024, sb = b % 1024, swz = sb ^ (((sb >> 9) & 1) << 5); R = (st >> 1) * 16 + swz / 64; C = (st & 1) * 32 + (swz % 64) / 2; }
__host__ __device__ __forceinline__ int perm32(int rho) { const int n = rho >> 4, i = rho & 15; return 8 * (i >> 2) + 4 * n + (i & 3); }

struct GU { const char* A; const char* B; int pm, pn, x0, x1; };

__device__ __forceinline__ void tile_of(int L, int nM, int nN, int& pm, int& pn) {
    const int nwg = nM * nN; int wgid = L; { const int q = nwg / NXCD, r = nwg % NXCD, xcd = wgid % NXCD, off = wgid / NXCD; wgid = (xcd < r ? xcd * (q + 1) : r * (q + 1) + (xcd - r) * q) + off; }
    const int nig = WGM * nN, gid = wgid / nig, fm = gid * WGM, gsz = (nM - fm) < WGM ? (nM - fm) : WGM;
    pm = fm + ((wgid % nig) % gsz); pn = (wgid % nig) / gsz;
}

template <class Epi, class Sched, bool ALIGN_EPI>
__device__ __forceinline__ void gemm_phase(LAS unsigned char* lds, const int K, const int ldb, const Sched& S, const Epi& E) {
    const int tid = threadIdx.x, wid = __builtin_amdgcn_readfirstlane(tid >> 6), lane = tid & 63, wr = wid >> 2, wc = wid & 3, fr = lane & 15, fq = lane >> 4;
    const int nt = K / BK;
    int Rr[2], Cc[2]; unsigned voffB[2];
#pragma unroll
    for (int i = 0; i < 2; ++i) { int R, C; stage_rc(tid * 16 + i * 8192, R, C); Rr[i] = R; Cc[i] = C; const int Rb = Epi::PERM ? ((R & ~31) + perm32(R & 31)) : R; voffB[i] = (unsigned)(Rb * ldb + C) * 2u; }
    const size_t kstep = (size_t)(BK * 2);
    const size_t hstepB = (size_t)HALF * ldb * 2;
    const unsigned ldsw = (unsigned)wid * 1024u;
    const int aoff = lds_byte(wr * 64 + fr, fq * 8), boff = lds_byte(wc * 32 + fr, fq * 8);
#define G8_SA(b, h) ((((b) * 2 + (h)) == 3 ? 7 : ((b) * 2 + (h))) * HTB)
#define G8_SB(b, h) ((3 + (b) * 2 + (h)) * HTB)
#define G8_STAGE(bufoff, gbase, voff) do { _Pragma("unroll") for (int _i = 0; _i < 2; ++_i) \
        __builtin_amdgcn_global_load_lds((const unsigned*)((const char*)(gbase) + (voff)[_i]), (LAS unsigned*)(lds + (bufoff) + ldsw + _i * 8192), 16, 0, 0); } while (0)
#define G8_LDA(dst, b, h) do { _Pragma("unroll") for (int m = 0; m < 4; ++m) _Pragma("unroll") for (int k = 0; k < 2; ++k) dst[m][k] = *(const LAS bf16x8*)(lds + G8_SA(b, h) + aoff + m * 2048 + k * 1024); } while (0)
#define G8_LDB(dst, b, h) do { _Pragma("unroll") for (int n = 0; n < 2; ++n) _Pragma("unroll") for (int k = 0; k < 2; ++k) dst[n][k] = *(const LAS bf16x8*)(lds + G8_SB(b, h) + boff + n * 2048 + k * 1024); } while (0)
#define G8_MMA(ai, bj, At, Bt) do { __builtin_amdgcn_s_setprio(1); _Pragma("unroll") for (int m = 0; m < 4; ++m) _Pragma("unroll") for (int n = 0; n < 2; ++n) _Pragma("unroll") for (int k = 0; k < 2; ++k) \
        acc[ai][bj][m][n] = __builtin_amdgcn_mfma_f32_16x16x32_bf16(Bt[n][k], At[m][k], acc[ai][bj][m][n], 0, 0, 0); __builtin_amdgcn_s_setprio(0); } while (0)
#define G8_WAIT_V(n) asm volatile("s_waitcnt vmcnt(" #n ")" ::: "memory")
#define G8_WAIT_L(n) asm volatile("s_waitcnt lgkmcnt(" #n ")" ::: "memory")
#define G8_BAR __builtin_amdgcn_s_barrier()
#define G8_SCHED __builtin_amdgcn_sched_barrier(0)
    GU cur, nxt; int ui = 0;
    if (!S.next(0, cur)) return;
    f32x4 acc[2][2][4][2];
#pragma unroll
    for (int a = 0; a < 2; ++a)
#pragma unroll
        for (int b = 0; b < 2; ++b)
#pragma unroll
            for (int m = 0; m < 4; ++m)
#pragma unroll
                for (int n = 0; n < 2; ++n) acc[a][b][m][n] = (f32x4){0.f, 0.f, 0.f, 0.f};
    bf16x8 At[4][2], B0[2][2], B1[2][2];
    unsigned vc0[2], vc1[2], vn0[2], vn1[2];
    S.aoff(cur, Rr, Cc, vc0, vc1);
    const char* cA = cur.A; const char* cB = cur.B;
    G8_STAGE(G8_SB(0, 0), cB, voffB); G8_STAGE(G8_SB(0, 1), cB + hstepB, voffB); G8_STAGE(G8_SA(0, 0), cA, vc0); G8_STAGE(G8_SA(0, 1), cA, vc1);
    if (wr == 1) G8_BAR;
    G8_WAIT_V(2); G8_BAR;
    G8_STAGE(G8_SB(1, 0), cB + kstep, voffB); G8_STAGE(G8_SA(1, 0), cA + kstep, vc0); G8_STAGE(G8_SB(1, 1), cB + hstepB + kstep, voffB);
    G8_WAIT_V(6); G8_BAR;
    for (;;) {
        const bool has_next = S.next(ui + 1, nxt);
        const char* nA = has_next ? nxt.A : cA; const char* nB = has_next ? nxt.B : cB;
        if (has_next) S.aoff(nxt, Rr, Cc, vn0, vn1); else { vn0[0] = vc0[0]; vn0[1] = vc0[1]; vn1[0] = vc1[0]; vn1[1] = vc1[1]; }
        for (int t = 0; t < nt; t += 2) {
            const bool last = (t == nt - 2);
            const char* a1 = cA + (size_t)(t + 1) * kstep;
            const char* a2 = last ? nA : cA + (size_t)(t + 2) * kstep; const char* b2 = last ? nB : cB + (size_t)(t + 2) * kstep;
            const char* a3 = a2 + kstep; const char* b3 = b2 + kstep;
            unsigned w0[2], w1[2]; w0[0] = last ? vn0[0] : vc0[0]; w0[1] = last ? vn0[1] : vc0[1]; w1[0] = last ? vn1[0] : vc1[0]; w1[1] = last ? vn1[1] : vc1[1];
            G8_LDB(B0, 0, 0); G8_LDB(B1, 0, 1); G8_SCHED; G8_LDA(At, 0, 0); G8_STAGE(G8_SA(1, 1), a1, vc1);
            G8_WAIT_V(8); G8_WAIT_L(0); G8_BAR; G8_MMA(0, 0, At, B0); G8_MMA(0, 1, At, B1); G8_BAR; G8_SCHED;
            G8_LDA(At, 0, 1); G8_STAGE(G8_SB(0, 0), b2, voffB); G8_STAGE(G8_SB(0, 1), b2 + hstepB, voffB); G8_STAGE(G8_SA(0, 0), a2, w0);
            G8_WAIT_V(8); G8_WAIT_L(0); G8_BAR; G8_MMA(1, 0, At, B0); G8_MMA(1, 1, At, B1); G8_BAR; G8_SCHED;
            G8_LDB(B0, 1, 0); G8_LDB(B1, 1, 1); G8_SCHED; G8_LDA(At, 1, 0); G8_STAGE(G8_SA(0, 1), a2, w1);
            G8_WAIT_V(8); G8_WAIT_L(0); G8_BAR; G8_MMA(0, 0, At, B0); G8_MMA(0, 1, At, B1); G8_BAR; G8_SCHED;
            G8_LDA(At, 1, 1); G8_STAGE(G8_SB(1, 0), b3, voffB); G8_STAGE(G8_SB(1, 1), b3 + hstepB, voffB); G8_STAGE(G8_SA(1, 0), a3, w0);
            G8_WAIT_V(8); G8_WAIT_L(0); G8_BAR; G8_MMA(1, 0, At, B0); G8_MMA(1, 1, At, B1); G8_BAR; G8_SCHED;
        }
        if constexpr (ALIGN_EPI) { if (wr == 0) G8_BAR; }
        E(acc, cur, wr, wc, fr, fq, lds);
        if (!E.keep(cur)) {
#pragma unroll
            for (int a = 0; a < 2; ++a)
#pragma unroll
                for (int b = 0; b < 2; ++b)
#pragma unroll
                    for (int m = 0; m < 4; ++m)
#pragma unroll
                        for (int n = 0; n < 2; ++n) acc[a][b][m][n] = (f32x4){0.f, 0.f, 0.f, 0.f};
        }
        if (!has_next) break;
        cur = nxt; cA = nA; cB = nB; ++ui;
        vc0[0] = vn0[0]; vc0[1] = vn0[1]; vc1[0] = vn1[0]; vc1[1] = vn1[1];
        if constexpr (ALIGN_EPI) { if (wr == 1) G8_BAR; }
    }
    G8_WAIT_V(0);
    if constexpr (!ALIGN_EPI) { if (wr == 0) G8_BAR; }
    G8_BAR;
#undef G8_SA
#undef G8_SB
#undef G8_STAGE
#undef G8_LDA
#undef G8_LDB
#undef G8_MMA
#undef G8_WAIT_V
#undef G8_WAIT_L
#undef G8_BAR
#undef G8_SCHED
}
}

struct DenseSched {
    const char* A; const char* B; int lda, ldb, nM, nN, G, c;
    __device__ __forceinline__ bool next(int i, g8::GU& u) const {
        const long L = (long)i * G + c; if (L >= (long)nM * nN) return false;
        g8::tile_of((int)L, nM, nN, u.pm, u.pn); u.x0 = 0; u.x1 = 0;
        u.A = A + (size_t)u.pm * 256 * lda * 2; u.B = B + (size_t)u.pn * 256 * ldb * 2; return true;
    }
    __device__ __forceinline__ void aoff(const g8::GU&, const int (&R)[2], const int (&C)[2], unsigned (&v0)[2], unsigned (&v1)[2]) const {
#pragma unroll
        for (int i = 0; i < 2; ++i) { v0[i] = (unsigned)(R[i] * lda + C[i]) * 2u; v1[i] = (unsigned)((R[i] + 128) * lda + C[i]) * 2u; }
    }
};
struct MixSched {
    const char* A0; const char* A1; const char* B0; const char* B1; int lda0, lda1, nM, nN, G, c;
    __device__ __forceinline__ bool next(int i, g8::GU& u) const {
        const long L = (long)(i >> 1) * G + c; if (L >= (long)nM * nN) return false;
        g8::tile_of((int)L, nM, nN, u.pm, u.pn); const int part = i & 1; u.x0 = part; u.x1 = 0;
        u.A = (part ? A1 : A0) + (size_t)u.pm * 256 * (part ? lda1 : lda0) * 2; u.B = (part ? B1 : B0) + (size_t)u.pn * 256 * 512 * 2; return true;
    }
    __device__ __forceinline__ void aoff(const g8::GU& u, const int (&R)[2], const int (&C)[2], unsigned (&v0)[2], unsigned (&v1)[2]) const {
        const int lda = u.x0 ? lda1 : lda0;
#pragma unroll
        for (int i = 0; i < 2; ++i) { v0[i] = (unsigned)(R[i] * lda + C[i]) * 2u; v1[i] = (unsigned)((R[i] + 128) * lda + C[i]) * 2u; }
    }
};
struct MoeSched {
    const LAS int* cum; const LAS int* cnt; const char* A; const char* B; const int* list; int G, c; bool gather; int ldb, nbrows;
    __device__ __forceinline__ bool next(int i, g8::GU& u) const {
        const long L = (long)i * G + c; const int total = cum[NEXP] * 4; if (L >= total) return false;
        const int blk = (int)L >> 2; u.pn = (int)L & 3;
        int e = 0;
#pragma unroll 1
        for (int k = 16; k >= 1; k >>= 1) if (cum[e + k] <= blk) e += k;
        u.x0 = e; u.x1 = blk - cum[e]; u.pm = blk;
        u.A = gather ? A : A + (size_t)blk * 256 * 512 * 2;
        u.B = B + ((size_t)e * nbrows + (size_t)u.pn * 256) * ldb * 2; return true;
    }
    __device__ __forceinline__ void aoff(const g8::GU& u, const int (&R)[2], const int (&C)[2], unsigned (&v0)[2], unsigned (&v1)[2]) const {
        if (gather) {
            const int n = cnt[u.x0]; const int* l = list + (size_t)u.x0 * T_ + u.x1 * 256;
#pragma unroll
            for (int i = 0; i < 2; ++i) { const int r0 = R[i], r1 = R[i] + 128;
                const int t0 = (u.x1 * 256 + r0 < n) ? l[r0] : 0, t1 = (u.x1 * 256 + r1 < n) ? l[r1] : 0;
                v0[i] = (unsigned)(t0 * 1024 + C[i]) * 2u; v1[i] = (unsigned)(t1 * 1024 + C[i]) * 2u; }
        } else {
#pragma unroll
            for (int i = 0; i < 2; ++i) { v0[i] = (unsigned)(R[i] * 512 + C[i]) * 2u; v1[i] = (unsigned)((R[i] + 128) * 512 + C[i]) * 2u; }
        }
    }
};

typedef f32x4 acc_t[2][2][4][2];
#define STG_SYNC() do { asm volatile("s_waitcnt lgkmcnt(0)" ::: "memory"); __builtin_amdgcn_s_barrier(); asm volatile("" ::: "memory"); } while (0)
__device__ __forceinline__ LAS unsigned char* stg_buf(LAS unsigned char* lds, int step) { return lds + STG_OFF + (step & 1) * STG_BUF; }
__device__ __forceinline__ void stg_put2(LAS unsigned char* buf, int wr, int wc, int fr, int fq, const u32x4& w0, const u32x4& w1) {
    LAS unsigned char* p = buf + (16 * wr + fr) * STG_ROWB + (32 * wc + 8 * fq) * 2; *(LAS u32x4*)p = w0; *(LAS u32x4*)(p + 256) = w1; }
__device__ __forceinline__ void stg_get2(const LAS unsigned char* buf, int wr, int wc, int fr, int fq, u32x4& w0, u32x4& w1) {
    const LAS unsigned char* p = buf + (16 * wr + fr) * STG_ROWB + (32 * wc + 8 * fq) * 2; w0 = *(const LAS u32x4*)p; w1 = *(const LAS u32x4*)(p + 256); }
__device__ __forceinline__ int stg_grow(int ai, int m, int rl) { return 128 * ai + 64 * (rl >> 4) + 16 * m + (rl & 15); }
__device__ __forceinline__ u32x4 pack8(const f32x4& v0, const f32x4& v1) { u32x4 w; w.x = pk2(v0[0], v0[1]); w.y = pk2(v0[2], v0[3]); w.z = pk2(v1[0], v1[1]); w.w = pk2(v1[2], v1[3]); return w; }

struct EpiProj {
    static constexpr bool PERM = true;
    bf16 *att, *mqk, *mv, *mo, *gates;
    __device__ __forceinline__ bool keep(const g8::GU&) const { return false; }
    __device__ __forceinline__ void operator()(acc_t& acc, const g8::GU& u, int wr, int wc, int fr, int fq, LAS unsigned char* lds) const {
        const int pn = u.pn; int tid = threadIdx.x; asm volatile("" : "+v"(tid));
        const bool gate = pn >= 9;
        bf16* base; int ldc, colt, act = 0; float sc = 1.f;
        if (pn < 3) { base = att; ldc = 768; colt = pn * 256; if (pn < 2) sc = QSCALE; }
        else if (pn < 5) { base = mqk; ldc = 512; colt = (pn - 3) * 256; }
        else if (pn < 7) { base = mv; ldc = 512; colt = (pn - 5) * 256; }
        else if (pn < 9) { base = mo; ldc = 512; colt = (pn - 7) * 256; act = 1; }
        else { base = gates; ldc = 2048; colt = (pn - 9) * 128; }
#pragma unroll
        for (int ai = 0; ai < 2; ++ai)
#pragma unroll
            for (int m = 0; m < 4; ++m) {
                u32x4 w0, w1;
                if (gate) {
                    f32x4 r0, r1, s0, s1;
#pragma unroll
                    for (int e = 0; e < 4; ++e) {
                        const float ea0 = __expf(-acc[ai][0][m][0][e]), eb0 = __expf(-acc[ai][1][m][0][e]), ea1 = __expf(-acc[ai][0][m][1][e]), eb1 = __expf(-acc[ai][1][m][1][e]);
                        r0[e] = (1.0f + eb0) * __builtin_amdgcn_rcpf(1.0f + ea0); s0[e] = __builtin_amdgcn_rcpf(1.0f + eb0);
                        r1[e] = (1.0f + eb1) * __builtin_amdgcn_rcpf(1.0f + ea1); s1[e] = __builtin_amdgcn_rcpf(1.0f + eb1); }
                    w0 = pack8(r0, r1); w1 = pack8(s0, s1);
                } else {
                    f32x4 a0 = acc[ai][0][m][0], a1 = acc[ai][0][m][1], b0 = acc[ai][1][m][0], b1 = acc[ai][1][m][1];
                    if (act) {
#pragma unroll
                        for (int e = 0; e < 4; ++e) { a0[e] = sigmoidf_(a0[e]); a1[e] = sigmoidf_(a1[e]); b0[e] = sigmoidf_(b0[e]); b1[e] = sigmoidf_(b1[e]); } }
                    else { a0 = a0 * sc; a1 = a1 * sc; b0 = b0 * sc; b1 = b1 * sc; }
                    w0 = pack8(a0, a1); w1 = pack8(b0, b1);
                }
                LAS unsigned char* buf = stg_buf(lds, ai * 4 + m);
                stg_put2(buf, wr, wc, fr, fq, w0, w1);
                STG_SYNC();
#pragma unroll
                for (int i = 0; i < 2; ++i) { const int p = tid + 512 * i, rl = p >> 5, ch = p & 31;
                    const u32x4 v = *(const LAS u32x4*)(buf + rl * STG_ROWB + ch * 16);
                    const int col = gate ? (ch < 16 ? colt + 8 * ch : 1024 + colt + 8 * (ch - 16)) : colt + 8 * ch;
                    *(u32x4*)(base + (size_t)(u.pm * 256 + stg_grow(ai, m, rl)) * ldc + col) = v; }
            }
        STG_SYNC();
    }
};
struct EpiMix {
    static constexpr bool PERM = true;
    bf16* gates;
    __device__ __forceinline__ bool keep(const g8::GU& u) const { return u.x0 == 0; }
    __device__ __forceinline__ void operator()(acc_t& acc, const g8::GU& u, int wr, int wc, int fr, int fq, LAS unsigned char* lds) const {
        int tid = threadIdx.x; asm volatile("" : "+v"(tid)); const bool fin = u.x0 != 0;
        bf16* gt = gates + (size_t)(u.pm * 256) * 2048 + u.pn * 256;
        if (!fin) {
#pragma unroll
            for (int ai = 0; ai < 2; ++ai)
#pragma unroll
                for (int m = 0; m < 4; ++m) {
                    LAS unsigned char* buf = stg_buf(lds, ai * 4 + m);
#pragma unroll
                    for (int i = 0; i < 2; ++i) { const int p = tid + 512 * i, rl = p >> 5, ch = p & 31;
                        *(LAS u32x4*)(buf + rl * STG_ROWB + ch * 16) = *(const u32x4*)(gt + (size_t)stg_grow(ai, m, rl) * 2048 + 8 * ch); }
                    STG_SYNC();
                    u32x4 g0, g1; stg_get2(buf, wr, wc, fr, fq, g0, g1);
                    f32x4 &a0 = acc[ai][0][m][0], &a1 = acc[ai][0][m][1], &b0 = acc[ai][1][m][0], &b1 = acc[ai][1][m][1];
                    a0[0] *= bflo(g0.x); a0[1] *= bfhi(g0.x); a0[2] *= bflo(g0.y); a0[3] *= bfhi(g0.y); a1[0] *= bflo(g0.z); a1[1] *= bfhi(g0.z); a1[2] *= bflo(g0.w); a1[3] *= bfhi(g0.w);
                    b0[0] *= bflo(g1.x); b0[1] *= bfhi(g1.x); b0[2] *= bflo(g1.y); b0[3] *= bfhi(g1.y); b1[0] *= bflo(g1.z); b1[1] *= bfhi(g1.z); b1[2] *= bflo(g1.w); b1[3] *= bfhi(g1.w);
                }
            STG_SYNC();
        } else {
#pragma unroll
            for (int ai = 0; ai < 2; ++ai)
#pragma unroll
                for (int m = 0; m < 4; ++m) {
                    LAS unsigned char* buf = stg_buf(lds, ai * 4 + m);
                    stg_put2(buf, wr, wc, fr, fq, pack8(acc[ai][0][m][0], acc[ai][0][m][1]), pack8(acc[ai][1][m][0], acc[ai][1][m][1]));
                    STG_SYNC();
#pragma unroll
                    for (int i = 0; i < 2; ++i) { const int p = tid + 512 * i, rl = p >> 5, ch = p & 31;
                        bf16* gp = gt + (size_t)stg_grow(ai, m, rl) * 2048 + 8 * ch;
                        const u32x4 g = *(const u32x4*)(gp + 1024); const u32x4 v = *(const LAS u32x4*)(buf + rl * STG_ROWB + ch * 16);
                        u32x4 w; w.x = pk2(bflo(v.x) * bflo(g.x), bfhi(v.x) * bfhi(g.x)); w.y = pk2(bflo(v.y) * bflo(g.y), bfhi(v.y) * bfhi(g.y));
                        w.z = pk2(bflo(v.z) * bflo(g.z), bfhi(v.z) * bfhi(g.z)); w.w = pk2(bflo(v.w) * bflo(g.w), bfhi(v.w) * bfhi(g.w));
                        *(u32x4*)gp = w; }
                }
            STG_SYNC();
        }
    }
};
struct EpiOut {
    static constexpr bool PERM = false;
    const float* x; float* out;
    __device__ __forceinline__ bool keep(const g8::GU&) const { return false; }
    __device__ __forceinline__ void operator()(acc_t& acc, const g8::GU& u, int wr, int wc, int fr, int fq, LAS unsigned char* lds) const {
        int tid = threadIdx.x; asm volatile("" : "+v"(tid));
#pragma unroll
        for (int ai = 0; ai < 2; ++ai)
#pragma unroll
            for (int m = 0; m < 4; ++m)
#pragma unroll
                for (int bj = 0; bj < 2; ++bj) {
                    LAS unsigned char* buf = stg_buf(lds, (ai * 4 + m) * 2 + bj);
                    LAS unsigned char* pp = buf + (16 * wr + fr) * STG_ROWB + (32 * wc + 4 * fq) * 4;
                    *(LAS f32x4*)pp = acc[ai][bj][m][0]; *(LAS f32x4*)(pp + 64) = acc[ai][bj][m][1];
                    f32x4 xv[2];
#pragma unroll
                    for (int i = 0; i < 2; ++i) { const int p = tid + 512 * i, rl = p >> 5, ch = p & 31; xv[i] = *(const f32x4*)(x + (size_t)(u.pm * 256 + stg_grow(ai, m, rl)) * 1024 + u.pn * 256 + bj * 128 + 4 * ch); }
                    STG_SYNC();
#pragma unroll
                    for (int i = 0; i < 2; ++i) { const int p = tid + 512 * i, rl = p >> 5, ch = p & 31;
                        const f32x4 v = *(const LAS f32x4*)(buf + rl * STG_ROWB + ch * 16);
                        *(f32x4*)(out + (size_t)(u.pm * 256 + stg_grow(ai, m, rl)) * 1024 + u.pn * 256 + bj * 128 + 4 * ch) = xv[i] + v; }
                }
        STG_SYNC();
    }
};
struct EpiG1 {
    static constexpr bool PERM = true;
    bf16* hid; const float* rstd2; const int* list; const LAS int* cnt;
    __device__ __forceinline__ bool keep(const g8::GU&) const { return false; }
    __device__ __forceinline__ void operator()(acc_t& acc, const g8::GU& u, int wr, int wc, int fr, int fq, LAS unsigned char* lds) const {
        int tid = threadIdx.x; asm volatile("" : "+v"(tid)); const int n = cnt[u.x0]; const int* l = list + (size_t)u.x0 * T_ + u.x1 * 256;
        const int rl0 = wr * 64 + fr;
#pragma unroll
        for (int ai = 0; ai < 2; ++ai)
#pragma unroll
            for (int m = 0; m < 4; ++m) { const int rl = rl0 + ai * 128 + m * 16; float rs = 0.f;
                if (u.x1 * 256 + rl < n) rs = rstd2[l[rl]];
                const f32x4 g0 = acc[ai][0][m][0] * rs, g1 = acc[ai][0][m][1] * rs, u0 = acc[ai][1][m][0] * rs, u1 = acc[ai][1][m][1] * rs;
                f32x4 h0, h1;
#pragma unroll
                for (int e = 0; e < 4; ++e) { h0[e] = siluf_(g0[e]) * u0[e]; h1[e] = siluf_(g1[e]) * u1[e]; }
                LAS unsigned char* buf = stg_buf(lds, ai * 4 + m);
                *(LAS u32x4*)(buf + (16 * wr + fr) * STG_ROWB + (32 * wc + 8 * fq) * 2) = pack8(h0, h1);
                STG_SYNC();
                { const int prl = tid >> 4, ch = tid & 15;
                  *(u32x4*)(hid + (size_t)(u.pm * 256 + stg_grow(ai, m, prl)) * 512 + u.pn * 128 + 8 * ch) = *(const LAS u32x4*)(buf + prl * STG_ROWB + ch * 16); }
            }
        STG_SYNC();
    }
};
struct EpiG2 {
    static constexpr bool PERM = true;
    bf16* ys; const float* sw; const LAS int* cnt;
    __device__ __forceinline__ bool keep(const g8::GU&) const { return false; }
    __device__ __forceinline__ void operator()(acc_t& acc, const g8::GU& u, int wr, int wc, int fr, int fq, LAS unsigned char* lds) const {
        int tid = threadIdx.x; asm volatile("" : "+v"(tid)); const int n = cnt[u.x0]; const float* s = sw + (size_t)u.x0 * T_ + u.x1 * 256;
        const int rl0 = wr * 64 + fr;
#pragma unroll
        for (int ai = 0; ai < 2; ++ai)
#pragma unroll
            for (int m = 0; m < 4; ++m) { const int rl = rl0 + ai * 128 + m * 16; float wgt = 0.f;
                if (u.x1 * 256 + rl < n) wgt = s[rl];
                LAS unsigned char* buf = stg_buf(lds, ai * 4 + m);
                stg_put2(buf, wr, wc, fr, fq, pack8(acc[ai][0][m][0] * wgt, acc[ai][0][m][1] * wgt), pack8(acc[ai][1][m][0] * wgt, acc[ai][1][m][1] * wgt));
                STG_SYNC();
#pragma unroll
                for (int i = 0; i < 2; ++i) { const int p = tid + 512 * i, prl = p >> 5, ch = p & 31;
                    *(u32x4*)(ys + (size_t)(u.pm * 256 + stg_grow(ai, m, prl)) * 1024 + u.pn * 256 + 8 * ch) = *(const LAS u32x4*)(buf + prl * STG_ROWB + ch * 16); }
            }
        STG_SYNC();
    }
};

#define XB_TMO      128
#define XB_XCNT(j)  (256  + 64 * (j))
#define XB_XSUB(j)  (1280 + 64 * (j))
#define XB_XGEN(j)  (2304 + 64 * (j))
#define XB_TOP      3328
#define XB_TOPGEN   3392
#define XCD_BAR_WORDS 3456
#define XB_SPIN_CAP (1u << 18)
__device__ __forceinline__ unsigned xb_ld(unsigned* p)              { return __hip_atomic_load(p, __ATOMIC_RELAXED, __HIP_MEMORY_SCOPE_AGENT); }
__device__ __forceinline__ unsigned xb_add(unsigned* p, unsigned v) { return __hip_atomic_fetch_add(p, v, __ATOMIC_RELAXED, __HIP_MEMORY_SCOPE_AGENT); }
__device__ __forceinline__ unsigned xb_xcc_id() { return (unsigned)__builtin_amdgcn_s_getreg((3 << 11) | 20) & 0xFu; }
#define XB_SPIN(cond, bar) do { unsigned _sp = 0; while (cond) { __builtin_amdgcn_s_sleep(1); \
    if ((++_sp & 255u) == 0u) { if (xb_ld(&(bar)[XB_TMO])) break; if (_sp > XB_SPIN_CAP) { atomicAdd(&(bar)[XB_TMO], 1u); break; } } } } while (0)
struct XcdBarrier { unsigned* bar; unsigned x; volatile LAS unsigned* st; };
__device__ __forceinline__ XcdBarrier xcd_barrier_post(unsigned* bar, volatile LAS unsigned* st) {
    XcdBarrier b; b.bar = bar; b.x = xb_xcc_id(); b.st = st;
    if (threadIdx.x == 0) (void)xb_add(&bar[XB_XCNT(b.x)], 1u);
    return b;
}
__device__ __forceinline__ void xcd_barrier_complete(unsigned* bar, unsigned x, unsigned& nloc, unsigned& nx) {
    const unsigned G = gridDim.x * gridDim.y * gridDim.z;
    unsigned sum, cnt, mine, sp = 0u;
    for (;;) {
        sum = 0u; cnt = 0u; mine = 0u;
#pragma unroll
        for (unsigned j = 0; j < 16; ++j) { const unsigned c = xb_ld(&bar[XB_XCNT(j)]); sum += c; cnt += (c > 0u) ? 1u : 0u; mine = (j == x) ? c : mine; }
        if (sum == G) break;
        __builtin_amdgcn_s_sleep(1);
        if ((++sp & 255u) == 0u) { if (xb_ld(&bar[XB_TMO])) break; if (sp > XB_SPIN_CAP) { atomicAdd(&bar[XB_TMO], 1u); break; } }
    }
    nloc = mine > 0u ? mine : 1u; nx = cnt > 0u ? cnt : 1u;
}
__device__ __forceinline__ void xcd_barrier(const XcdBarrier& b) {
    asm volatile("s_waitcnt vmcnt(0)" ::: "memory");
    __syncthreads();
    if (threadIdx.x == 0) {
        unsigned* bar = b.bar;
        __builtin_amdgcn_s_waitcnt(0);
        unsigned nloc = b.st[0], nx = b.st[1];
        if (nloc == 0u) { xcd_barrier_complete(bar, b.x, nloc, nx); b.st[0] = nloc; b.st[1] = nx; }
        const unsigned old = xb_add(&bar[XB_XSUB(b.x)], 1u);
        const unsigned gen = old / nloc;
        if (old + 1u == (gen + 1u) * nloc) {
            __builtin_amdgcn_fence(__ATOMIC_RELEASE, "agent");
            asm volatile("s_waitcnt vmcnt(0)" ::: "memory");
            const unsigned og = xb_add(&bar[XB_TOP], 1u);
            const unsigned tg = og / nx;
            if (og + 1u == (tg + 1u) * nx) xb_add(&bar[XB_TOPGEN], 1u);
            else XB_SPIN(xb_ld(&bar[XB_TOPGEN]) == tg, bar);
            __builtin_amdgcn_fence(__ATOMIC_ACQUIRE, "agent");
            xb_add(&bar[XB_XGEN(b.x)], 1u);
            asm volatile("s_waitcnt vmcnt(0)" ::: "memory");
        } else {
            XB_SPIN(xb_ld(&bar[XB_XGEN(b.x)]) == gen, bar);
            __builtin_amdgcn_fence(__ATOMIC_ACQUIRE, "agent");
            asm volatile("s_waitcnt vmcnt(0)" ::: "memory");
        }
    }
    __syncthreads();
}

struct Args { const float* in[21]; float* out; unsigned char* ws; int ph_lo, ph_hi; };

__device__ __forceinline__ void p0_transpose_item(const float* W, int ldw, int srccol0, int k0, bf16* WT, int ldt, int destrow0, int lane) {
    const int kk = lane >> 3, n4 = lane & 7;
    const float* src = W + (size_t)(k0 + 8 * kk) * ldw + srccol0 + 4 * n4;
    f32x4 v[8];
#pragma unroll
    for (int i = 0; i < 8; ++i) v[i] = *(const f32x4*)(src + (size_t)i * ldw);
    bf16* dst = WT + (size_t)(destrow0 + 4 * n4) * ldt + k0 + 8 * kk;
#pragma unroll
    for (int c = 0; c < 4; ++c) { u32x4 o; o.x = pk2(v[0][c], v[1][c]); o.y = pk2(v[2][c], v[3][c]); o.z = pk2(v[4][c], v[5][c]); o.w = pk2(v[6][c], v[7][c]);
        *(u32x4*)(dst + (size_t)c * ldt) = o; }
}

__device__ __forceinline__ void phase0(const Args& a, LAS unsigned char* lds, int vcu, int G, int tid, int lane, int wave) {
    unsigned char* ws = a.ws;
    const float* x = a.in[0]; const float* nw = a.in[1]; const float* w_in = a.in[2];
    LAS float* WGF = (LAS float*)(lds + 69632);
#if PROBE_PH >= 100
    unsigned long long sp0 = __builtin_amdgcn_s_memrealtime(), sp1 = 0, sp2 = 0, sp3 = 0;
#endif
    for (int i = tid; i < 8192; i += 512) { const int g = i >> 10, k = i & 1023; WGF[i] = nw[k] * w_in[(size_t)k * 4360 + 2304 + g]; }
    __syncthreads();
    const int gw = vcu * NWAVES + wave, NGW = G * NWAVES;
#if PROBE_PH >= 100
    sp1 = __builtin_amdgcn_s_memrealtime();
#endif
    {
        f32x4 nwv[4];
#pragma unroll
        for (int j = 0; j < 4; ++j) nwv[j] = ((const f32x4*)nw)[lane + 64 * j];
        float big[4], bfg[4];
#pragma unroll
        for (int h = 0; h < 4; ++h) { big[h] = a.in[5][h]; bfg[h] = a.in[6][h]; }
        bf16* XN = (bf16*)(ws + WS_XN); float* IGF = (float*)(ws + WS_IGF);
        const bool hi32 = (lane & 32) != 0, hi16 = (lane & 16) != 0, hi8 = (lane & 8) != 0; const int gsel = lane >> 3;
        f32x4 v[4], vn[4];
        if (gw < T_) {
#pragma unroll
            for (int j = 0; j < 4; ++j) v[j] = ((const f32x4*)(x + (size_t)gw * 1024) + lane)[64 * j]; }
        for (int m = gw; m < T_; m += NGW) {
            const int mn = (m + NGW < T_) ? m + NGW : m;
#pragma unroll
            for (int j = 0; j < 4; ++j) vn[j] = ((const f32x4*)(x + (size_t)mn * 1024) + lane)[64 * j];
            float s = 0.f;
#pragma unroll
            for (int j = 0; j < 4; ++j) s += (v[j].x * v[j].x + v[j].y * v[j].y) + (v[j].z * v[j].z + v[j].w * v[j].w);
            const float rstd = 1.0f / sqrtf(wave_sum(s) * (1.f / 1024.f) + EPS_);
            unsigned long long* o8 = (unsigned long long*)(XN + (size_t)m * 1024) + lane;
#pragma unroll
            for (int j = 0; j < 4; ++j) { const f32x4 y = v[j] * rstd * nwv[j]; o8[64 * j] = (unsigned long long)pk2(y.x, y.y) | ((unsigned long long)pk2(y.z, y.w) << 32); }
            float pg[8];
#pragma unroll
            for (int g = 0; g < 8; ++g) { float p = 0.f;
#pragma unroll
                for (int j = 0; j < 4; ++j) { const f32x4 w4 = *(const LAS f32x4*)(WGF + g * 1024 + 256 * j + 4 * lane); p += (v[j].x * w4.x + v[j].y * w4.y) + (v[j].z * w4.z + v[j].w * w4.w); }
                pg[g] = p; }
            float a4[4], a2[2], a1;
#pragma unroll
            for (int i = 0; i < 4; ++i) { const float keep = hi32 ? pg[4 + i] : pg[i], send = hi32 ? pg[i] : pg[4 + i]; a4[i] = keep + __shfl_xor(send, 32); }
#pragma unroll
            for (int i = 0; i < 2; ++i) { const float keep = hi16 ? a4[2 + i] : a4[i], send = hi16 ? a4[i] : a4[2 + i]; a2[i] = keep + __shfl_xor(send, 16); }
            { const float keep = hi8 ? a2[1] : a2[0], send = hi8 ? a2[0] : a2[1]; a1 = keep + __shfl_xor(send, 8); }
            a1 += __shfl_xor(a1, 4); a1 += __shfl_xor(a1, 2); a1 += __shfl_xor(a1, 1);
            if ((lane & 7) == 0) { const float z0 = a1 * rstd;
                float o;
                if (gsel < 4) o = z0 + big[gsel & 3]; else { const float z = z0 + bfg[gsel & 3]; o = fminf(z, 0.f) - log1pf(expf(-fabsf(z))); }
                IGF[(size_t)m * 8 + gsel] = o; }
#pragma unroll
            for (int j = 0; j < 4; ++j) v[j] = vn[j];
        }
    }
#if PROBE_PH >= 100
    asm volatile("s_waitcnt vmcnt(0)" ::: "memory"); __syncthreads(); sp2 = __builtin_amdgcn_s_memrealtime();
#endif
    {
        bf16* Win = (bf16*)(ws + WS_WIN); bf16* Wao = (bf16*)(ws + WS_WAO); bf16* Wmo = (bf16*)(ws + WS_WMO); bf16* Wout = (bf16*)(ws + WS_WOUT);
        bf16* Wgu = (bf16*)(ws + WS_WGU); bf16* Wdn = (bf16*)(ws + WS_WDN);
        constexpr int I_IN = 16 * 136, I_AO = 8 * 32, I_OUT = 16 * 32, I_GU = 32 * 16 * 32, I_DN = 32 * 8 * 32;
        constexpr int NITEMS = I_IN + 2 * I_AO + I_OUT + I_GU + I_DN;
        for (int it = gw; it < NITEMS; it += NGW) {
            int r = it;
            if (r < I_IN) { const int kb = r / 136, nb = r % 136, d0 = nb * 32; int sc0 = d0;
                if (d0 >= 2304) { const int q = d0 - 2304, j = q >> 8, rr = q & 255; sc0 = (rr < 128 ? 2312 : 3336) + 128 * j + (rr & 127); }
                p0_transpose_item(w_in, 4360, sc0, kb * 64, Win, 1024, d0, lane); continue; } r -= I_IN;
            if (r < I_AO) { const int kb = r / 32, nb = r % 32; p0_transpose_item(a.in[9], 1024, nb * 32, kb * 64, Wao, 512, nb * 32, lane); continue; } r -= I_AO;
            if (r < I_AO) { const int kb = r / 32, nb = r % 32; p0_transpose_item(a.in[10], 1024, nb * 32, kb * 64, Wmo, 512, nb * 32, lane); continue; } r -= I_AO;
            if (r < I_OUT) { const int kb = r / 32, nb = r % 32; p0_transpose_item(a.in[11], 1024, nb * 32, kb * 64, Wout, 1024, nb * 32, lane); continue; } r -= I_OUT;
            if (r < I_GU) { const int e = r / 512, q = r % 512, kb = q / 32, nb = q % 32, d0 = nb * 32, tt = d0 >> 8, j = d0 & 255;
                const float* src = (j < 128 ? a.in[17] : a.in[18]) + (size_t)e * 1024 * 512;
                p0_transpose_item(src, 512, 128 * tt + (j & 127), kb * 64, Wgu + (size_t)e * 1024 * 1024, 1024, d0, lane); continue; } r -= I_GU;
            { const int e = r / 256, q = r % 256, kb = q / 32, nb = q % 32;
                p0_transpose_item(a.in[19] + (size_t)e * 512 * 1024, 1024, nb * 32, kb * 64, Wdn + (size_t)e * 1024 * 512, 512, nb * 32, lane); }
        }
        bf16* WR = (bf16*)(ws + WS_WR);
        for (int i = (vcu * 512 + tid); i < 48 * 1024; i += G * 512) { const int n = i >> 10, k = i & 1023; float v = 0.f;
            if (n < 4) v = a.in[13][k * 4 + n]; else if (n < 36) v = a.in[15][k * 32 + (n - 4)];
            WR[i] = (bf16)(pk2(v, 0.f) & 0xffffu); }
    }
#if PROBE_PH >= 100
    asm volatile("s_waitcnt vmcnt(0)" ::: "memory"); __syncthreads(); sp3 = __builtin_amdgcn_s_memrealtime();
    if (blockIdx.x == 0 && tid == 0) { const unsigned long long d = (PROBE_PH == 100 ? sp2 - sp1 : PROBE_PH == 101 ? sp3 - sp2 : sp1 - sp0) * PROBE_AMP; const unsigned long long te = __builtin_amdgcn_s_memrealtime(); while (__builtin_amdgcn_s_memrealtime() - te < d) __builtin_amdgcn_s_sleep(8); }
#endif
}

__device__ __forceinline__ void attn_unit(const Args& a, LAS unsigned char* lds, int b, int blk, int kvh, int tid, int lane, int wave) {
    bf16* ATT = (bf16*)(a.ws + WS_ATT);
    LAS short* Ks = (LAS short*)lds;
    LAS short* VT = (LAS short*)(lds + 36864);
    const long t0 = (long)b * SEQ_ + blk * 128;
#pragma unroll
    for (int i = 0; i < 4; ++i) { const int p = tid + 512 * i, row = p >> 3, ch = p & 7;
        u32x4 kv = (u32x4){0u, 0u, 0u, 0u}, vv = (u32x4){0u, 0u, 0u, 0u};
        if (blk > 0 || row >= 128) { const bf16* src = ATT + (t0 - 128 + row) * 768; kv = *(const u32x4*)(src + 512 + kvh * 64 + ch * 8); vv = *(const u32x4*)(src + 640 + kvh * 64 + ch * 8); }
        *(LAS u32x4*)(Ks + row * 72 + ch * 8) = kv;
        LAS short* vt = VT + (ch * 8) * 264 + row;
        vt[0 * 264] = (short)(vv.x & 0xffff); vt[1 * 264] = (short)(vv.x >> 16); vt[2 * 264] = (short)(vv.y & 0xffff); vt[3 * 264] = (short)(vv.y >> 16);
        vt[4 * 264] = (short)(vv.z & 0xffff); vt[5 * 264] = (short)(vv.z >> 16); vt[6 * 264] = (short)(vv.w & 0xffff); vt[7 * 264] = (short)(vv.w >> 16); }
    __syncthreads();
    const int q = lane & 31, h = lane >> 5;
#pragma unroll 1
    for (int gi = 0; gi < 2; ++gi) {
        const int g16 = wave * 2 + gi, g = g16 >> 2, r = g16 & 3, hq = kvh * 4 + g;
        const int i = 32 * r + q;
        bf16* qrow = ATT + (t0 + i) * 768 + hq * 64;
        bf16x8 qf[4];
#pragma unroll
        for (int s = 0; s < 4; ++s) qf[s] = *(const bf16x8*)(qrow + 16 * s + 8 * h);
        const float sink2 = a.in[7][hq] * LOG2E;
        f32x16 S[5];
#pragma unroll
        for (int tt = 0; tt < 5; ++tt) { const int jt = r + tt; f32x16 c = {};
#pragma unroll
            for (int s = 0; s < 4; ++s) { const bf16x8 kf = *(const LAS bf16x8*)(Ks + (32 * jt + q) * 72 + 16 * s + 8 * h); c = __builtin_amdgcn_mfma_f32_32x32x16_bf16(kf, qf[s], c, 0, 0, 0); }
            S[tt] = c; }
        float mx = sink2;
#pragma unroll
        for (int tt = 0; tt < 5; ++tt) { const bool tv = (blk > 0) || (r + tt >= 4);
#pragma unroll
            for (int rg = 0; rg < 16; ++rg) { const int kr = (rg & 3) + 8 * (rg >> 2) + 4 * h;
                const bool ok = tv && (tt == 0 ? (kr > q) : (tt == 4 ? (kr <= q) : true));
                const float sv = ok ? S[tt][rg] : -INFINITY; S[tt][rg] = sv; mx = fmaxf(mx, sv); } }
        mx = fmaxf(mx, __shfl_xor(mx, 32));
        float l = 0.f;
#pragma unroll
        for (int tt = 0; tt < 5; ++tt)
#pragma unroll
            for (int rg = 0; rg < 16; ++rg) { const float p = __builtin_amdgcn_exp2f(S[tt][rg] - mx); S[tt][rg] = p; l += p; }
        l += __shfl_xor(l, 32);
        l += __builtin_amdgcn_exp2f(sink2 - mx);
        const float il = 1.0f / l;
        f32x16 O[2]; O[0] = (f32x16){}; O[1] = (f32x16){};
#pragma unroll
        for (int tt = 0; tt < 5; ++tt) { const int jt = r + tt;
#pragma unroll
            for (int ks = 0; ks < 2; ++ks) {
                u32x4 pw; pw.x = pk2(S[tt][8 * ks + 0], S[tt][8 * ks + 1]); pw.y = pk2(S[tt][8 * ks + 2], S[tt][8 * ks + 3]); pw.z = pk2(S[tt][8 * ks + 4], S[tt][8 * ks + 5]); pw.w = pk2(S[tt][8 * ks + 6], S[tt][8 * ks + 7]);
                const bf16x8 pf = __builtin_bit_cast(bf16x8, pw);
#pragma unroll
                for (int dt = 0; dt < 2; ++dt) { const LAS short* vp = VT + (32 * dt + q) * 264 + 32 * jt + 16 * ks + 4 * h;
                    const s16x4 lo = *(const LAS s16x4*)vp, hi = *(const LAS s16x4*)(vp + 8);
                    const bf16x8 vf = (bf16x8){lo[0], lo[1], lo[2], lo[3], hi[0], hi[1], hi[2], hi[3]};
                    O[dt] = __builtin_amdgcn_mfma_f32_32x32x16_bf16(vf, pf, O[dt], 0, 0, 0); } } }
#pragma unroll
        for (int dt = 0; dt < 2; ++dt)
#pragma unroll
            for (int g4 = 0; g4 < 4; ++g4) { u32x2 w; w.x = pk2(O[dt][4 * g4 + 0] * il, O[dt][4 * g4 + 1] * il); w.y = pk2(O[dt][4 * g4 + 2] * il, O[dt][4 * g4 + 3] * il);
                *(u32x2*)(qrow + 32 * dt + 8 * g4 + 4 * h) = w; }
    }
    __syncthreads();
}

__device__ __forceinline__ void conv8(const bf16* MQK, const float* cw, const float* cb, long trow, int s_in_seq, int cidx, float (&y)[8]) {
    const f32x4 b0 = *(const f32x4*)(cb + cidx), b1 = *(const f32x4*)(cb + cidx + 4);
    y[0] = b0.x; y[1] = b0.y; y[2] = b0.z; y[3] = b0.w; y[4] = b1.x; y[5] = b1.y; y[6] = b1.z; y[7] = b1.w;
#pragma unroll
    for (int j = 0; j < 4; ++j) { const int d = j - 3;
        if (s_in_seq + d >= 0) {
            const u32x4 u = *(const u32x4*)(MQK + (trow + d) * 512 + cidx);
            const f32x4 w0 = *(const f32x4*)(cw + j * 512 + cidx), w1 = *(const f32x4*)(cw + j * 512 + cidx + 4);
            y[0] += w0.x * bflo(u.x); y[1] += w0.y * bfhi(u.x); y[2] += w0.z * bflo(u.y); y[3] += w0.w * bfhi(u.y);
            y[4] += w1.x * bflo(u.z); y[5] += w1.y * bfhi(u.z); y[6] += w1.z * bflo(u.w); y[7] += w1.w * bfhi(u.w);
        } }
#pragma unroll
    for (int e = 0; e < 8; ++e) y[e] = siluf_(y[e]);
}

__device__ __forceinline__ void mprep_unit(const Args& a, LAS unsigned char* lds, int unit, int tid, int lane, int wave) {
    const int hh = unit & 3, c = (unit >> 2) & 63, b = unit >> 8;
    const long t0 = (long)b * SEQ_ + c * 64;
    const bf16* MQK = (const bf16*)(a.ws + WS_MQK); const bf16* MV = (const bf16*)(a.ws + WS_MV);
    const float* IGF = (const float*)(a.ws + WS_IGF); float* CHS = (float*)(a.ws + WS_CHS) + (size_t)unit * 256;
    bf16* UT = (bf16*)(a.ws + WS_XN) + (size_t)unit * 8192;
    LAS short* KwT = (LAS short*)lds;
    LAS short* VT = (LAS short*)(lds + 9216);
    LAS float* wsv = (LAS float*)(lds + 27648);
    if (wave == 0) {
        const float lf = IGF[(t0 + lane) * 8 + 4 + hh], ig = IGF[(t0 + lane) * 8 + hh];
        float bc = lf;
#pragma unroll
        for (int o = 1; o < 64; o <<= 1) { const float t = __shfl_up(bc, o); if (lane >= o) bc += t; }
        const float bl = __shfl(bc, 63);
        const float g = bl - bc + ig; const float loc = wave_max(g);
        wsv[lane] = __expf(g - loc);
        if (lane == 0) { CHS[64] = bl; CHS[65] = loc; }
    }
    __syncthreads();
    {   const int s = tid >> 3, ch = tid & 7;
        float y[8]; conv8(MQK, a.in[3], a.in[4], t0 + s, c * 64 + s, 256 + hh * 64 + ch * 8, y);
        const float wsc = wsv[s] * 0.125f;
#pragma unroll
        for (int e = 0; e < 8; ++e) KwT[(ch * 8 + e) * 72 + s] = (short)(pk2(y[e] * wsc, 0.f) & 0xffffu);
        const bf16* vsrc = MV + (t0 + s) * 512 + hh * 128 + ch * 16;
        const u32x4 v0 = *(const u32x4*)vsrc, v1 = *(const u32x4*)(vsrc + 8);
        LAS short* vt = VT + (ch * 16) * 72 + s;
        vt[0 * 72] = (short)(v0.x & 0xffff); vt[1 * 72] = (short)(v0.x >> 16); vt[2 * 72] = (short)(v0.y & 0xffff); vt[3 * 72] = (short)(v0.y >> 16);
        vt[4 * 72] = (short)(v0.z & 0xffff); vt[5 * 72] = (short)(v0.z >> 16); vt[6 * 72] = (short)(v0.w & 0xffff); vt[7 * 72] = (short)(v0.w >> 16);
        vt[8 * 72] = (short)(v1.x & 0xffff); vt[9 * 72] = (short)(v1.x >> 16); vt[10 * 72] = (short)(v1.y & 0xffff); vt[11 * 72] = (short)(v1.y >> 16);
        vt[12 * 72] = (short)(v1.z & 0xffff); vt[13 * 72] = (short)(v1.z >> 16); vt[14 * 72] = (short)(v1.w & 0xffff); vt[15 * 72] = (short)(v1.w >> 16);
    }
    __syncthreads();
    if (tid < 64) { float n = 0.f;
#pragma unroll 8
        for (int s = 0; s < 64; ++s) n += bf2f(KwT[tid * 72 + s]);
        CHS[tid] = n; }
    {   const int dkt = wave & 1, dvt = wave >> 1, q = lane & 31, h = lane >> 5;
        f32x16 acc = {};
#pragma unroll
        for (int ks = 0; ks < 4; ++ks) { const bf16x8 af = *(const LAS bf16x8*)(KwT + (32 * dkt + q) * 72 + 16 * ks + 8 * h); const bf16x8 bfr = *(const LAS bf16x8*)(VT + (32 * dvt + q) * 72 + 16 * ks + 8 * h);
            acc = __builtin_amdgcn_mfma_f32_32x32x16_bf16(af, bfr, acc, 0, 0, 0); }
        bf16* up = UT + (32 * dvt + q) * 64 + 32 * dkt + 4 * h;
#pragma unroll
        for (int g4 = 0; g4 < 4; ++g4) { u32x2 w; w.x = pk2(acc[4 * g4 + 0], acc[4 * g4 + 1]); w.y = pk2(acc[4 * g4 + 2], acc[4 * g4 + 3]); *(u32x2*)(up + 8 * g4) = w; }
    }
    __syncthreads();
}

__device__ __forceinline__ void phase3(const Args& a, int G, int tid) {
    unsigned* UT32 = (unsigned*)(a.ws + WS_XN); float* CHS = (float*)(a.ws + WS_CHS);
    for (int item = blockIdx.x * 512 + tid; item < 32 * 4096; item += G * 512) {
        const int bh = item >> 12, ep = item & 4095, b = bh >> 2, hh = bh & 3;
        float c0 = 0.f, c1 = 0.f, nst = 0.f, m = 0.f;
#pragma unroll 1
        for (int cb = 0; cb < 64; cb += 8) {
            unsigned u[8]; float bs[8], lc[8], nl[8];
#pragma unroll
            for (int k = 0; k < 8; ++k) { const int unit = ((b * 64 + cb + k) << 2) + hh; u[k] = UT32[(size_t)unit * 4096 + ep]; bs[k] = CHS[(size_t)unit * 256 + 64]; lc[k] = CHS[(size_t)unit * 256 + 65];
                nl[k] = (ep < 64) ? CHS[(size_t)unit * 256 + ep] : 0.f; }
#pragma unroll
            for (int k = 0; k < 8; ++k) { const int unit = ((b * 64 + cb + k) << 2) + hh;
                UT32[(size_t)unit * 4096 + ep] = pk2(c0, c1);
                if (ep < 64) CHS[(size_t)unit * 256 + 128 + ep] = nst;
                if (ep == 0) CHS[(size_t)unit * 256 + 66] = m;
                const float mn = fmaxf(bs[k] + m, lc[k]); const float wc = __expf(bs[k] + m - mn), sc = __expf(lc[k] - mn);
                c0 = wc * c0 + sc * bflo(u[k]); c1 = wc * c1 + sc * bfhi(u[k]); nst = wc * nst + sc * nl[k]; m = mn; }
        }
    }
}

__device__ __forceinline__ void mout_unit(const Args& a, LAS unsigned char* lds, int unit, int tid, int lane, int wave) {
    const int hh = unit & 3, c = (unit >> 2) & 63, b = unit >> 8;
    const long t0 = (long)b * SEQ_ + c * 64;
    const bf16* MQK = (const bf16*)(a.ws + WS_MQK); const bf16* MV = (const bf16*)(a.ws + WS_MV); bf16* MO = (bf16*)(a.ws + WS_MO);
    const float* IGF = (const float*)(a.ws + WS_IGF); const float* CHS = (const float*)(a.ws + WS_CHS) + (size_t)unit * 256;
    const bf16* UT = (const bf16*)(a.ws + WS_XN) + (size_t)unit * 8192;
    LAS short* QS = (LAS short*)lds;
    LAS short* QW = (LAS short*)(lds + 9216);
    LAS short* KS = (LAS short*)(lds + 18432);
    LAS short* VT = (LAS short*)(lds + 27648);
    LAS short* CT = (LAS short*)(lds + 46080);
    LAS float* alphav = (LAS float*)(lds + 64512); LAS float* ev = (LAS float*)(lds + 64768); LAS float* wav = (LAS float*)(lds + 65024);
    LAS float* emtv = (LAS float*)(lds + 65280); LAS float* npv = (LAS float*)(lds + 65536); LAS float* red = (LAS float*)(lds + 65792);
    if (wave == 0) {
        const float lf = IGF[(t0 + lane) * 8 + 4 + hh], ig = IGF[(t0 + lane) * 8 + hh];
        float bc = lf;
#pragma unroll
        for (int o = 1; o < 64; o <<= 1) { const float t = __shfl_up(bc, o); if (lane >= o) bc += t; }
        const float mp = CHS[66];
        const float e = ig - bc; float cm = e;
#pragma unroll
        for (int o = 1; o < 64; o <<= 1) { const float t = __shfl_up(cm, o); if (lane >= o) cm = fmaxf(cm, t); }
        const float mt = bc + fmaxf(mp, cm);
        alphav[lane] = bc - mt; ev[lane] = e; wav[lane] = __expf(bc + mp - mt); emtv[lane] = __expf(-mt);
        npv[lane] = CHS[128 + lane];
    }
    __syncthreads();
    {   const int s = tid >> 3, ch = tid & 7;
        float y[8];
        conv8(MQK, a.in[3], a.in[4], t0 + s, c * 64 + s, hh * 64 + ch * 8, y);
        const float wa = wav[s];
        u32x4 w; w.x = pk2(y[0], y[1]); w.y = pk2(y[2], y[3]); w.z = pk2(y[4], y[5]); w.w = pk2(y[6], y[7]);
        *(LAS u32x4*)(QS + s * 72 + ch * 8) = w;
        w.x = pk2(y[0] * wa, y[1] * wa); w.y = pk2(y[2] * wa, y[3] * wa); w.z = pk2(y[4] * wa, y[5] * wa); w.w = pk2(y[6] * wa, y[7] * wa);
        *(LAS u32x4*)(QW + s * 72 + ch * 8) = w;
        conv8(MQK, a.in[3], a.in[4], t0 + s, c * 64 + s, 256 + hh * 64 + ch * 8, y);
        w.x = pk2(y[0] * 0.125f, y[1] * 0.125f); w.y = pk2(y[2] * 0.125f, y[3] * 0.125f); w.z = pk2(y[4] * 0.125f, y[5] * 0.125f); w.w = pk2(y[6] * 0.125f, y[7] * 0.125f);
        *(LAS u32x4*)(KS + s * 72 + ch * 8) = w;
        const bf16* vsrc = MV + (t0 + s) * 512 + hh * 128 + ch * 16;
        const u32x4 v0 = *(const u32x4*)vsrc, v1 = *(const u32x4*)(vsrc + 8);
        LAS short* vt = VT + (ch * 16) * 72 + s;
        vt[0 * 72] = (short)(v0.x & 0xffff); vt[1 * 72] = (short)(v0.x >> 16); vt[2 * 72] = (short)(v0.y & 0xffff); vt[3 * 72] = (short)(v0.y >> 16);
        vt[4 * 72] = (short)(v0.z & 0xffff); vt[5 * 72] = (short)(v0.z >> 16); vt[6 * 72] = (short)(v0.w & 0xffff); vt[7 * 72] = (short)(v0.w >> 16);
        vt[8 * 72] = (short)(v1.x & 0xffff); vt[9 * 72] = (short)(v1.x >> 16); vt[10 * 72] = (short)(v1.y & 0xffff); vt[11 * 72] = (short)(v1.y >> 16);
        vt[12 * 72] = (short)(v1.z & 0xffff); vt[13 * 72] = (short)(v1.z >> 16); vt[14 * 72] = (short)(v1.w & 0xffff); vt[15 * 72] = (short)(v1.w >> 16);
#pragma unroll
        for (int i = 0; i < 2; ++i) { const int p = tid + 512 * i, row = p >> 3, cc = p & 7; *(LAS u32x4*)(CT + row * 72 + cc * 8) = *(const u32x4*)(UT + row * 64 + cc * 8); }
    }
    __syncthreads();
    const int tt = wave >> 2, dvt = wave & 3, q = lane & 31, h = lane >> 5, t = 32 * tt + q;
    float hb[16]; float rn;
    {
        bf16x8 qf[4];
#pragma unroll
        for (int ks = 0; ks < 4; ++ks) qf[ks] = *(const LAS bf16x8*)(QS + t * 72 + 16 * ks + 8 * h);
        f32x16 O = {}; float dsum = 0.f; const float al = alphav[t];
#pragma unroll
        for (int st = 0; st < 2; ++st) {
            if (st <= tt) {
                f32x16 Sx = {};
#pragma unroll
                for (int ks = 0; ks < 4; ++ks) { const bf16x8 kf = *(const LAS bf16x8*)(KS + (32 * st + q) * 72 + 16 * ks + 8 * h); Sx = __builtin_amdgcn_mfma_f32_32x32x16_bf16(kf, qf[ks], Sx, 0, 0, 0); }
#pragma unroll
                for (int rg = 0; rg < 16; ++rg) { const int kr = (rg & 3) + 8 * (rg >> 2) + 4 * h; const int s = 32 * st + kr;
                    const float p = (s <= t) ? Sx[rg] * __expf(al + ev[s]) : 0.f; Sx[rg] = p; dsum += p; }
#pragma unroll
                for (int ks = 0; ks < 2; ++ks) {
                    u32x4 pw; pw.x = pk2(Sx[8 * ks + 0], Sx[8 * ks + 1]); pw.y = pk2(Sx[8 * ks + 2], Sx[8 * ks + 3]); pw.z = pk2(Sx[8 * ks + 4], Sx[8 * ks + 5]); pw.w = pk2(Sx[8 * ks + 6], Sx[8 * ks + 7]);
                    const bf16x8 pf = __builtin_bit_cast(bf16x8, pw);
                    const LAS short* vp = VT + (32 * dvt + q) * 72 + 32 * st + 16 * ks + 4 * h;
                    const s16x4 lo = *(const LAS s16x4*)vp, hi = *(const LAS s16x4*)(vp + 8);
                    const bf16x8 vf = (bf16x8){lo[0], lo[1], lo[2], lo[3], hi[0], hi[1], hi[2], hi[3]};
                    O = __builtin_amdgcn_mfma_f32_32x32x16_bf16(vf, pf, O, 0, 0, 0); }
            } }
        float dn = 0.f;
#pragma unroll
        for (int ks = 0; ks < 4; ++ks) { const bf16x8 qw = *(const LAS bf16x8*)(QW + t * 72 + 16 * ks + 8 * h); const bf16x8 cf = *(const LAS bf16x8*)(CT + (32 * dvt + q) * 72 + 16 * ks + 8 * h);
            O = __builtin_amdgcn_mfma_f32_32x32x16_bf16(cf, qw, O, 0, 0, 0);
#pragma unroll
            for (int j = 0; j < 8; ++j) dn += bf2f(qw[j]) * npv[16 * ks + 8 * h + j]; }
        float den = dsum + dn; den += __shfl_xor(den, 32);
        const float inv = 1.0f / fmaxf(fabsf(den), emtv[t]);
        float ssq = 0.f;
#pragma unroll
        for (int rg = 0; rg < 16; ++rg) { hb[rg] = O[rg] * inv; ssq += hb[rg] * hb[rg]; }
        ssq += __shfl_xor(ssq, 32);
        if (h == 0) red[(tt * 4 + dvt) * 32 + q] = ssq;
    }
    __syncthreads();
    {   const float tot = (red[(tt * 4 + 0) * 32 + q] + red[(tt * 4 + 1) * 32 + q]) + (red[(tt * 4 + 2) * 32 + q] + red[(tt * 4 + 3) * 32 + q]);
        rn = 1.0f / sqrtf(tot * (1.f / 128.f) + EPS_);
        const float* nw = a.in[8] + hh * 128 + 32 * dvt + 4 * h;
        bf16* op = MO + (t0 + t) * 512 + hh * 128 + 32 * dvt + 4 * h;
#pragma unroll
        for (int g4 = 0; g4 < 4; ++g4) { const f32x4 w4 = *(const f32x4*)(nw + 8 * g4); const u32x2 mo = *(const u32x2*)(op + 8 * g4);
            u32x2 w; w.x = pk2(hb[4 * g4 + 0] * rn * w4.x * bflo(mo.x), hb[4 * g4 + 1] * rn * w4.y * bfhi(mo.x)); w.y = pk2(hb[4 * g4 + 2] * rn * w4.z * bflo(mo.y), hb[4 * g4 + 3] * rn * w4.w * bfhi(mo.y));
            *(u32x2*)(op + 8 * g4) = w; }
    }
    __syncthreads();
}

__device__ __forceinline__ void phase7(const Args& a, LAS unsigned char* lds, int vcu, int G, int tid, int lane, int wave) {
    const float* x1 = a.out; const float* nw = a.in[12];
    bf16* H2 = (bf16*)(a.ws + WS_XN); float* RSTD2 = (float*)(a.ws + WS_RSTD2); const bf16* WRg = (const bf16*)(a.ws + WS_WR);
    int* LIST = (int*)(a.ws + WS_LIST); float* SW = (float*)(a.ws + WS_SW); i32x4* TOKI = (i32x4*)(a.ws + WS_TOKI);
    unsigned* gcnt = (unsigned*)(a.ws + WS_CTL) + CW_GCNT;
    LAS short* WR = (LAS short*)lds;
    LAS float* lg = (LAS float*)(lds + 99072);
    LAS float* rsl = (LAS float*)(lds + 99072 + 24576);
    LAS int* hist = (LAS int*)(lds + 99072 + 24576 + 512);
    LAS int* basev = hist + 32;
    for (int p = tid; p < 48 * 128; p += 512) { const int n = p >> 7, cc = p & 127; *(LAS u32x4*)(WR + n * 1032 + cc * 8) = *(const u32x4*)(WRg + n * 1024 + cc * 8); }
    __syncthreads();
    const int r = lane & 15, g = lane >> 4;
    for (int it = vcu; it < T_ / 128; it += G) {
        if (tid < 32) hist[tid] = 0;
        __syncthreads();
        const int row = it * 128 + wave * 16 + r;
        f32x4 acc[3]; acc[0] = (f32x4){0.f, 0.f, 0.f, 0.f}; acc[1] = acc[0]; acc[2] = acc[0];
        float ssq = 0.f;
        const float* xr = x1 + (size_t)row * 1024 + 8 * g; bf16* hr = H2 + (size_t)row * 1024 + 8 * g;
#pragma unroll 4
        for (int s = 0; s < 32; ++s) {
            const f32x4 xa = *(const f32x4*)(xr + 32 * s), xb = *(const f32x4*)(xr + 32 * s + 4);
            const f32x4 wa = *(const f32x4*)(nw + 32 * s + 8 * g), wb = *(const f32x4*)(nw + 32 * s + 8 * g + 4);
            ssq += (xa.x * xa.x + xa.y * xa.y) + (xa.z * xa.z + xa.w * xa.w) + (xb.x * xb.x + xb.y * xb.y) + (xb.z * xb.z + xb.w * xb.w);
            u32x4 w; w.x = pk2(xa.x * wa.x, xa.y * wa.y); w.y = pk2(xa.z * wa.z, xa.w * wa.w); w.z = pk2(xb.x * wb.x, xb.y * wb.y); w.w = pk2(xb.z * wb.z, xb.w * wb.w);
            *(u32x4*)(hr + 32 * s) = w;
            const bf16x8 af = __builtin_bit_cast(bf16x8, w);
#pragma unroll
            for (int nt = 0; nt < 3; ++nt) { const bf16x8 bfr = *(const LAS bf16x8*)(WR + (16 * nt + r) * 1032 + 32 * s + 8 * g); acc[nt] = __builtin_amdgcn_mfma_f32_16x16x32_bf16(af, bfr, acc[nt], 0, 0, 0); }
        }
        ssq += __shfl_xor(ssq, 16); ssq += __shfl_xor(ssq, 32);
        const float rstd = 1.0f / sqrtf(ssq * (1.f / 1024.f) + EPS_);
        if (g == 0) { RSTD2[row] = rstd; rsl[wave * 16 + r] = rstd; }
#pragma unroll
        for (int nt = 0; nt < 3; ++nt)
#pragma unroll
            for (int rg = 0; rg < 4; ++rg) lg[(wave * 16 + 4 * g + rg) * 48 + 16 * nt + r] = acc[nt][rg];
        LDS_WAIT(); asm volatile("" ::: "memory");
        int e1 = 0, e2 = 0, lr1 = 0, lr2 = 0; float w1 = 0.f, w2 = 0.f;
        if (lane < 16) {
            const LAS float* lp = lg + (wave * 16 + lane) * 48; const float rs = rsl[wave * 16 + lane];
            float gl[4]; int gi = 0; float gm;
#pragma unroll
            for (int k = 0; k < 4; ++k) gl[k] = lp[k] * rs + a.in[14][k];
            gm = gl[0];
#pragma unroll
            for (int k = 1; k < 4; ++k) if (gl[k] > gm) { gm = gl[k]; gi = k; }
            float gs = 0.f;
#pragma unroll
            for (int k = 0; k < 4; ++k) gs += expf(gl[k] - gm);
            const float gp = 1.0f / gs;
            float v1 = -INFINITY, v2 = -INFINITY; int j1 = 0, j2 = 0;
#pragma unroll
            for (int j = 0; j < 8; ++j) { const float el = lp[4 + 8 * gi + j] * rs + a.in[16][8 * gi + j];
                if (el > v1) { v2 = v1; j2 = j1; v1 = el; j1 = j; } else if (el > v2) { v2 = el; j2 = j; } }
            const float ex = expf(v2 - v1); w1 = gp / (1.0f + ex); w2 = gp * ex / (1.0f + ex);
            e1 = 8 * gi + j1; e2 = 8 * gi + j2;
            lr1 = atomicAdd((int*)(hist + e1), 1); lr2 = atomicAdd((int*)(hist + e2), 1);
        }
        __syncthreads();
        if (tid < 32) { const int n = hist[tid]; basev[tid] = n > 0 ? (int)atomicAdd(gcnt + tid, (unsigned)n) : 0; }
        __syncthreads();
        if (lane < 16) { const int tok = it * 128 + wave * 16 + lane; const int r1 = basev[e1] + lr1, r2 = basev[e2] + lr2;
            LIST[(size_t)e1 * T_ + r1] = tok; LIST[(size_t)e2 * T_ + r2] = tok; SW[(size_t)e1 * T_ + r1] = w1; SW[(size_t)e2 * T_ + r2] = w2;
            TOKI[tok] = (i32x4){e1, r1, e2, r2}; }
        __syncthreads();
    }
}

__device__ __forceinline__ void moe_tables(const Args& a, LAS unsigned char* lds, int tid) {
    LAS int* cum = (LAS int*)(lds + TAB_OFF); LAS int* cnt = cum + 64;
    const unsigned* gcnt = (const unsigned*)(a.ws + WS_CTL) + CW_GCNT;
    if (tid == 0) { int c = 0; for (int e = 0; e < NEXP; ++e) { const int n = (int)__hip_atomic_load(gcnt + e, __ATOMIC_RELAXED, __HIP_MEMORY_SCOPE_AGENT); cnt[e] = n; cum[e] = c; c += (n + 255) >> 8; } cum[NEXP] = c; }
    __syncthreads();
}

__device__ __forceinline__ void phase10(const Args& a, LAS unsigned char* lds, int vcu, int G, int lane, int wave) {
    const LAS int* cum = (const LAS int*)(lds + TAB_OFF);
    float* out = a.out; const bf16* YS = (const bf16*)(a.ws + WS_YS); const i32x4* TOKI = (const i32x4*)(a.ws + WS_TOKI); const float* nw = a.in[20];
    f32x4 nwv[4];
#pragma unroll
    for (int j = 0; j < 4; ++j) nwv[j] = ((const f32x4*)nw)[lane + 64 * j];
    const int gw = vcu * NWAVES + wave, NGW = G * NWAVES;
    for (int m = gw; m < T_; m += NGW) {
        const i32x4 ti = TOKI[m];
        const size_t s1 = (size_t)cum[ti.x] * 256 + ti.y, s2 = (size_t)cum[ti.z] * 256 + ti.w;
        f32x4* xr = (f32x4*)(out + (size_t)m * 1024) + lane;
        const u32x2* y1 = (const u32x2*)(YS + s1 * 1024) + lane; const u32x2* y2 = (const u32x2*)(YS + s2 * 1024) + lane;
        f32x4 v[4]; float s = 0.f;
#pragma unroll
        for (int j = 0; j < 4; ++j) { v[j] = xr[64 * j]; const u32x2 p1 = y1[64 * j], p2 = y2[64 * j];
            v[j].x += bflo(p1.x) + bflo(p2.x); v[j].y += bfhi(p1.x) + bfhi(p2.x); v[j].z += bflo(p1.y) + bflo(p2.y); v[j].w += bfhi(p1.y) + bfhi(p2.y);
            s += (v[j].x * v[j].x + v[j].y * v[j].y) + (v[j].z * v[j].z + v[j].w * v[j].w); }
        const float rstd = 1.0f / sqrtf(wave_sum(s) * (1.f / 1024.f) + EPS_);
#pragma unroll
        for (int j = 0; j < 4; ++j) xr[64 * j] = v[j] * rstd * nwv[j];
    }
}

__global__ void __launch_bounds__(NWAVES * 64, 2) mega_fwd(Args args) {
    extern __shared__ __attribute__((aligned(16))) unsigned char lds_raw[];
    LAS unsigned char* lds = (LAS unsigned char*)lds_raw;
    const int tid = threadIdx.x, lane = tid & 63, wave = __builtin_amdgcn_readfirstlane(tid >> 6);
    const int G = gridDim.x, bx = blockIdx.x;
    const int vcu = (G % 8 == 0) ? (bx % 8) * (G / 8) + bx / 8 : bx;
    unsigned char* ws = args.ws;
    unsigned* ctl = (unsigned*)(ws + WS_CTL);
    for (int u = tid; u < (LDS_BYTES - LDSCTL_OFF) / 4; u += NWAVES * 64) ((LAS unsigned*)(lds + LDSCTL_OFF))[u] = 0u;
    __syncthreads();
    const int lo = args.ph_lo, hi = args.ph_hi;
    const bool multi = (hi - lo) > 1;
    XcdBarrier bar; bar.bar = ctl + CW_BAR; bar.x = 0; bar.st = (volatile LAS unsigned*)(lds + MISC_OFF) + 8;
    if (multi) bar = xcd_barrier_post(ctl + CW_BAR, (volatile LAS unsigned*)(lds + MISC_OFF) + 8);
#define IN(k) (((PH_MASK >> (k)) & 1) && lo <= (k) && (k) < hi)
#if PROBE_PH >= 0 && PROBE_PH < 100
    unsigned long long tp0 = 0, tp1 = 0;
#define SEAM(k) do { if (IN(k) && IN((k) + 1)) xcd_barrier(bar); if ((k) == PROBE_PH) tp1 = __builtin_amdgcn_s_memrealtime(); if ((k) + 1 == PROBE_PH) tp0 = __builtin_amdgcn_s_memrealtime(); } while (0)
    if (PROBE_PH == 0) tp0 = __builtin_amdgcn_s_memrealtime();
#else
#define SEAM(k) do { if (IN(k) && IN((k) + 1)) xcd_barrier(bar); } while (0)
#endif

    if (IN(0)) { phase0(args, lds, vcu, G, tid, lane, wave); SEAM(0); }

    if (IN(1)) {
        DenseSched S{(const char*)(ws + WS_XN), (const char*)(ws + WS_WIN), 1024, 1024, T_ / 256, NIN / 256, G, bx};
        EpiProj E{(bf16*)(ws + WS_ATT), (bf16*)(ws + WS_MQK), (bf16*)(ws + WS_MV), (bf16*)(ws + WS_MO), (bf16*)(ws + WS_GATES)};
        g8::gemm_phase<EpiProj, DenseSched, true>(lds, 1024, 1024, S, E);
        SEAM(1);
    }
    if (IN(2)) {
        for (int u = vcu; u < NB_ * 32 * 2; u += G) attn_unit(args, lds, u >> 6, (u >> 1) & 31, u & 1, tid, lane, wave);
        for (int u = vcu; u < 2048; u += G) mprep_unit(args, lds, u, tid, lane, wave);
        SEAM(2);
    }
    if (IN(3)) { phase3(args, G, tid); SEAM(3); }
    if (IN(4)) { for (int u = vcu; u < 2048; u += G) mout_unit(args, lds, u, tid, lane, wave); SEAM(4); }
    if (IN(5)) {
        MixSched S{(const char*)(ws + WS_ATT), (const char*)(ws + WS_MO), (const char*)(ws + WS_WAO), (const char*)(ws + WS_WMO), 768, 512, T_ / 256, 4, G, bx};
        EpiMix E{(bf16*)(ws + WS_GATES)};
        g8::gemm_phase<EpiMix, MixSched, true>(lds, 512, 512, S, E);
        SEAM(5);
    }
    if (IN(6)) {
        DenseSched S{(const char*)(ws + WS_GATES), (const char*)(ws + WS_WOUT), 2048, 1024, T_ / 256, 4, G, bx};
        EpiOut E{args.in[0], args.out};
        g8::gemm_phase<EpiOut, DenseSched, true>(lds, 1024, 1024, S, E);
        SEAM(6);
    }
    if (IN(7)) { phase7(args, lds, vcu, G, tid, lane, wave); SEAM(7); }
    if (IN(8) || IN(9) || IN(10)) moe_tables(args, lds, tid);
    if (IN(8)) {
        const LAS int* cum = (const LAS int*)(lds + TAB_OFF); const LAS int* cnt = cum + 64;
        MoeSched S{cum, cnt, (const char*)(ws + WS_XN), (const char*)(ws + WS_WGU), (const int*)(ws + WS_LIST), G, vcu, true, 1024, 1024};
        EpiG1 E{(bf16*)(ws + WS_HID), (const float*)(ws + WS_RSTD2), (const int*)(ws + WS_LIST), cnt};
        g8::gemm_phase<EpiG1, MoeSched, true>(lds, 1024, 1024, S, E);
        SEAM(8);
    }
    if (IN(9)) {
        const LAS int* cum = (const LAS int*)(lds + TAB_OFF); const LAS int* cnt = cum + 64;
        MoeSched S{cum, cnt, (const char*)(ws + WS_HID), (const char*)(ws + WS_WDN), (const int*)(ws + WS_LIST), G, vcu, false, 512, 1024};
        EpiG2 E{(bf16*)(ws + WS_YS), (const float*)(ws + WS_SW), cnt};
        g8::gemm_phase<EpiG2, MoeSched, true>(lds, 512, 512, S, E);
        SEAM(9);
    }
    if (IN(10)) phase10(args, lds, vcu, G, lane, wave);
#if PROBE_PH >= 0 && PROBE_PH < 100
    if (PROBE_PH == 10) { asm volatile("s_waitcnt vmcnt(0)" ::: "memory"); __syncthreads(); tp1 = __builtin_amdgcn_s_memrealtime(); }
    if (bx == 0 && tid == 0) { const unsigned long long d = (tp1 - tp0) * PROBE_AMP; const unsigned long long te = __builtin_amdgcn_s_memrealtime(); while (__builtin_amdgcn_s_memrealtime() - te < d) __builtin_amdgcn_s_sleep(8); }
#endif
#undef IN
#undef SEAM
}

extern "C" void kernel_launch(void* const* d_in, const int* in_sizes, int n_in, void* d_out, int out_size, void* d_ws, size_t ws_size, hipStream_t stream) {
    static int grid = 0;
    if (grid == 0) {
        if (n_in != 21 || in_sizes[0] != T_ * D_ || out_size != T_ * D_ || ws_size < WS_END) { fprintf(stderr, "kernel_launch: unexpected shapes / workspace (n_in %d, ws %zu, need %zu)\n", n_in, ws_size, (size_t)WS_END); grid = -1; return; }
        int dev = 0, cus = 0, per_cu = 0;
        if (hipGetDevice(&dev) != hipSuccess || hipDeviceGetAttribute(&cus, hipDeviceAttributeMultiprocessorCount, dev) != hipSuccess) { grid = -1; return; }
        if (hipFuncSetAttribute((const void*)mega_fwd, hipFuncAttributeMaxDynamicSharedMemorySize, LDS_BYTES) != hipSuccess) { fprintf(stderr, "kernel_launch: hipFuncSetAttribute failed\n"); grid = -1; return; }
        if (hipOccupancyMaxActiveBlocksPerMultiprocessor(&per_cu, (const void*)mega_fwd, NWAVES * 64, LDS_BYTES) != hipSuccess || per_cu < 1) { fprintf(stderr, "kernel_launch: occupancy query reports %d blocks per CU\n", per_cu); (void)hipGetLastError(); grid = -1; return; }
        grid = cus;
    }
    if (grid < 0) return;
    (void)hipMemsetAsync((char*)d_ws + WS_CTL, 0, CTL_ZERO_BYTES, stream);
    Args a{};
    for (int i = 0; i < 21; ++i) a.in[i] = (const float*)d_in[i];
    a.out = (float*)d_out; a.ws = (unsigned char*)d_ws;
#if MK_FUSED
    a.ph_lo = 0; a.ph_hi = NPH;
    void* kargs[] = {&a};
    hipError_t e = hipLaunchCooperativeKernel((const void*)mega_fwd, dim3(grid), dim3(NWAVES * 64), kargs, LDS_BYTES, stream);
    if (e != hipSuccess) fprintf(stderr, "kernel_launch: cooperative launch failed: %s (grid %d)\n", hipGetErrorString(e), grid);
#else
    for (int p = 0; p < NPH; ++p) { a.ph_lo = p; a.ph_hi = p + 1; hipLaunchKernelGGL(mega_fwd, dim3(grid), dim3(NWAVES * 64), LDS_BYTES, stream, a); }
#endif
}
```

```cpp
#include <hip/hip_runtime.h>
#include <cstdio>
#include <cstdint>

#define LAS __attribute__((address_space(3)))
#define GAS __attribute__((address_space(1)))
typedef unsigned short bf16;
typedef short bf16x8 __attribute__((ext_vector_type(8)));
typedef short s16x4 __attribute__((ext_vector_type(4)));
typedef float f32x4 __attribute__((ext_vector_type(4)));
typedef float f32x16 __attribute__((ext_vector_type(16)));
typedef unsigned u32x4 __attribute__((ext_vector_type(4)));
typedef unsigned u32x2 __attribute__((ext_vector_type(2)));
typedef int i32x4 __attribute__((ext_vector_type(4)));
typedef float f32x2_t __attribute__((ext_vector_type(2)));
typedef __bf16 bf16x2_t __attribute__((ext_vector_type(2)));

#ifndef PROBE_PH
#define PROBE_PH -1
#endif
#ifndef PROBE_AMP
#define PROBE_AMP 4
#endif
#ifndef PH_MASK
#define PH_MASK 0x7ff
#endif
#ifndef MK_FUSED
#define MK_FUSED 1
#endif

constexpr int T_ = 32768, D_ = 1024, SEQ_ = 4096, NB_ = 8;
constexpr int NIN = 4352;
constexpr int NEXP = 32;
constexpr float EPS_ = 1e-6f;
constexpr float LOG2E = 1.4426950408889634f;
constexpr float QSCALE = 0.125f * LOG2E;
constexpr int NWAVES = 8;
constexpr int NPH = 11;

constexpr size_t MiB = 1u << 20;
constexpr size_t WS_CTL = 0, CTL_ZERO_BYTES = 1 * MiB;
constexpr size_t WS_IGF = 1 * MiB;
constexpr size_t WS_CHS = 2 * MiB;
constexpr size_t WS_TOKI = 4 * MiB;
constexpr size_t WS_RSTD2 = 4 * MiB + 512 * 1024;
constexpr size_t WS_WR = 4 * MiB + 768 * 1024;
constexpr size_t WS_LIST = 5 * MiB;
constexpr size_t WS_SW = 9 * MiB;
constexpr size_t WS_WIN = 13 * MiB;
constexpr size_t WS_WAO = 22 * MiB, WS_WMO = 23 * MiB, WS_WOUT = 24 * MiB;
constexpr size_t WS_WGU = 26 * MiB;
constexpr size_t WS_WDN = 90 * MiB;
constexpr size_t WS_XN = 122 * MiB;
constexpr size_t WS_ATT = 186 * MiB;
constexpr size_t WS_MQK = 234 * MiB;
constexpr size_t WS_MV = 266 * MiB;
constexpr size_t WS_MO = 298 * MiB;
constexpr size_t WS_GATES = 330 * MiB;
constexpr size_t WS_HID = 186 * MiB;
constexpr size_t WS_YS = 258 * MiB;
constexpr size_t WS_END = 458 * MiB;
constexpr int CW_TMO = 0, CW_BAR = 4096, CW_GCNT = 16384;

constexpr int RING_BYTES = 131072;
constexpr int LDS_BYTES = 163840;
constexpr int LDSCTL_OFF = LDS_BYTES - 1024, MISC_OFF = LDSCTL_OFF;
constexpr int TAB_OFF = LDSCTL_OFF + 256;
constexpr int STG_OFF = 7 * 16384;
constexpr int STG_ROWB = 528, STG_BUF = 32 * STG_ROWB;

__device__ __forceinline__ unsigned pk2(float lo, float hi) { f32x2_t v = {lo, hi}; bf16x2_t b = __builtin_convertvector(v, bf16x2_t); return __builtin_bit_cast(unsigned, b); }
__device__ __forceinline__ float bflo(unsigned u) { return __uint_as_float(u << 16); }
__device__ __forceinline__ float bfhi(unsigned u) { return __uint_as_float(u & 0xffff0000u); }
__device__ __forceinline__ float bf2f(short s) { return __uint_as_float(((unsigned)(unsigned short)s) << 16); }
__device__ __forceinline__ float wave_sum(float v) {
#pragma unroll
    for (int o = 1; o < 64; o <<= 1) v += __shfl_xor(v, o);
    return v;
}
__device__ __forceinline__ float wave_max(float v) {
#pragma unroll
    for (int o = 1; o < 64; o <<= 1) v = fmaxf(v, __shfl_xor(v, o));
    return v;
}
__device__ __forceinline__ float sigmoidf_(float v) { return __builtin_amdgcn_rcpf(1.0f + __expf(-v)); }
__device__ __forceinline__ float siluf_(float v) { return v * __builtin_amdgcn_rcpf(1.0f + __expf(-v)); }
#define LDS_WAIT() asm volatile("s_waitcnt lgkmcnt(0)" ::: "memory")

namespace g8 {
constexpr int BM = 256, BK = 64, HALF = 128, HTB = HALF * BK * 2, STAGE_BYTES = 8 * HTB, NXCD = 8, WGM = 8;
__host__ __device__ __forceinline__ int lds_byte(int r, int c) { const int st = (r >> 4) * 2 + (c >> 5), rr = r & 15, cc = c & 31, ob = rr * 64 + cc * 2; return st * 1024 + (ob ^ (((ob >> 9) & 1) << 5)); }
__host__ __device__ __forceinline__ void stage_rc(int b, int& R, int& C) { const int st = b / 1024, sb = b % 1024, swz = sb ^ (((sb >> 9) & 1) << 5); R = (st >> 1) * 16 + swz / 64; C = (st & 1) * 32 + (swz % 64) / 2; }
__host__ __device__ __forceinline__ int perm32(int rho) { const int n = rho >> 4, i = rho & 15; return 8 * (i >> 2) + 4 * n + (i & 3); }

struct GU { const char* A; const char* B; int pm, pn, x0, x1; };

__device__ __forceinline__ void tile_of(int L, int nM, int nN, int& pm, int& pn) {
    const int nwg = nM * nN; int wgid = L; { const int q = nwg / NXCD, r = nwg % NXCD, xcd = wgid % NXCD, off = wgid / NXCD; wgid = (xcd < r ? xcd * (q + 1) : r * (q + 1) + (xcd - r) * q) + off; }
    const int nig = WGM * nN, gid = wgid / nig, fm = gid * WGM, gsz = (nM - fm) < WGM ? (nM - fm) : WGM;
    pm = fm + ((wgid % nig) % gsz); pn = (wgid % nig) / gsz;
}

template <class Epi, class Sched, bool ALIGN_EPI>
__device__ __forceinline__ void gemm_phase(LAS unsigned char* lds, const int K, const int ldb, const Sched& S, const Epi& E) {
    const int tid = threadIdx.x, wid = __builtin_amdgcn_readfirstlane(tid >> 6), lane = tid & 63, wr = wid >> 2, wc = wid & 3, fr = lane & 15, fq = lane >> 4;
    const int nt = K / BK;
    int Rr[2], Cc[2]; unsigned voffB[2];
#pragma unroll
    for (int i = 0; i < 2; ++i) { int R, C; stage_rc(tid * 16 + i * 8192, R, C); Rr[i] = R; Cc[i] = C; const int Rb = Epi::PERM ? ((R & ~31) + perm32(R & 31)) : R; voffB[i] = (unsigned)(Rb * ldb + C) * 2u; }
    const size_t kstep = (size_t)(BK * 2);
    const size_t hstepB = (size_t)HALF * ldb * 2;
    const unsigned ldsw = (unsigned)wid * 1024u;
    const int aoff = lds_byte(wr * 64 + fr, fq * 8), boff = lds_byte(wc * 32 + fr, fq * 8);
#define G8_SA(b, h) ((((b) * 2 + (h)) == 3 ? 7 : ((b) * 2 + (h))) * HTB)
#define G8_SB(b, h) ((3 + (b) * 2 + (h)) * HTB)
#define G8_STAGE(bufoff, gbase, voff) do { _Pragma("unroll") for (int _i = 0; _i < 2; ++_i) \
        __builtin_amdgcn_global_load_lds((const unsigned*)((const char*)(gbase) + (voff)[_i]), (LAS unsigned*)(lds + (bufoff) + ldsw + _i * 8192), 16, 0, 0); } while (0)
#define G8_LDA(dst, b, h) do { _Pragma("unroll") for (int m = 0; m < 4; ++m) _Pragma("unroll") for (int k = 0; k < 2; ++k) dst[m][k] = *(const LAS bf16x8*)(lds + G8_SA(b, h) + aoff + m * 2048 + k * 1024); } while (0)
#define G8_LDB(dst, b, h) do { _Pragma("unroll") for (int n = 0; n < 2; ++n) _Pragma("unroll") for (int k = 0; k < 2; ++k) dst[n][k] = *(const LAS bf16x8*)(lds + G8_SB(b, h) + boff + n * 2048 + k * 1024); } while (0)
#define G8_MMA(ai, bj, At, Bt) do { __builtin_amdgcn_s_setprio(1); _Pragma("unroll") for (int m = 0; m < 4; ++m) _Pragma("unroll") for (int n = 0; n < 2; ++n) _Pragma("unroll") for (int k = 0; k < 2; ++k) \
        acc[ai][bj][m][n] = __builtin_amdgcn_mfma_f32_16x16x32_bf16(Bt[n][k], At[m][k], acc[ai][bj][m][n], 0, 0, 0); __builtin_amdgcn_s_setprio(0); } while (0)
#define G8_WAIT_V(n) asm volatile("s_waitcnt vmcnt(" #n ")" ::: "memory")
#define G8_WAIT_L(n) asm volatile("s_waitcnt lgkmcnt(" #n ")" ::: "memory")
#define G8_BAR __builtin_amdgcn_s_barrier()
#define G8_SCHED __builtin_amdgcn_sched_barrier(0)
    GU cur, nxt; int ui = 0;
    if (!S.next(0, cur)) return;
    f32x4 acc[2][2][4][2];
#pragma unroll
    for (int a = 0; a < 2; ++a)
#pragma unroll
        for (int b = 0; b < 2; ++b)
#pragma unroll
            for (int m = 0; m < 4; ++m)
#pragma unroll
                for (int n = 0; n < 2; ++n) acc[a][b][m][n] = (f32x4){0.f, 0.f, 0.f, 0.f};
    bf16x8 At[4][2], B0[2][2], B1[2][2];
    unsigned vc0[2], vc1[2], vn0[2], vn1[2];
    S.aoff(cur, Rr, Cc, vc0, vc1);
    const char* cA = cur.A; const char* cB = cur.B;
    G8_STAGE(G8_SB(0, 0), cB, voffB); G8_STAGE(G8_SB(0, 1), cB + hstepB, voffB); G8_STAGE(G8_SA(0, 0), cA, vc0); G8_STAGE(G8_SA(0, 1), cA, vc1);
    if (wr == 1) G8_BAR;
    G8_WAIT_V(2); G8_BAR;
    G8_STAGE(G8_SB(1, 0), cB + kstep, voffB); G8_STAGE(G8_SA(1, 0), cA + kstep, vc0); G8_STAGE(G8_SB(1, 1), cB + hstepB + kstep, voffB);
    G8_WAIT_V(6); G8_BAR;
    for (;;) {
        const bool has_next = S.next(ui + 1, nxt);
        const char* nA = has_next ? nxt.A : cA; const char* nB = has_next ? nxt.B : cB;
        if (has_next) S.aoff(nxt, Rr, Cc, vn0, vn1); else { vn0[0] = vc0[0]; vn0[1] = vc0[1]; vn1[0] = vc1[0]; vn1[1] = vc1[1]; }
        for (int t = 0; t < nt; t += 2) {
            const bool last = (t == nt - 2);
            const char* a1 = cA + (size_t)(t + 1) * kstep;
            const char* a2 = last ? nA : cA + (size_t)(t + 2) * kstep; const char* b2 = last ? nB : cB + (size_t)(t + 2) * kstep;
            const char* a3 = a2 + kstep; const char* b3 = b2 + kstep;
            unsigned w0[2], w1[2]; w0[0] = last ? vn0[0] : vc0[0]; w0[1] = last ? vn0[1] : vc0[1]; w1[0] = last ? vn1[0] : vc1[0]; w1[1] = last ? vn1[1] : vc1[1];
            G8_LDB(B0, 0, 0); G8_LDB(B1, 0, 1); G8_SCHED; G8_LDA(At, 0, 0); G8_STAGE(G8_SA(1, 1), a1, vc1);
            G8_WAIT_V(8); G8_WAIT_L(0); G8_BAR; G8_MMA(0, 0, At, B0); G8_MMA(0, 1, At, B1); G8_BAR; G8_SCHED;
            G8_LDA(At, 0, 1); G8_STAGE(G8_SB(0, 0), b2, voffB); G8_STAGE(G8_SB(0, 1), b2 + hstepB, voffB); G8_STAGE(G8_SA(0, 0), a2, w0);
            G8_WAIT_V(8); G8_WAIT_L(0); G8_BAR; G8_MMA(1, 0, At, B0); G8_MMA(1, 1, At, B1); G8_BAR; G8_SCHED;
            G8_LDB(B0, 1, 0); G8_LDB(B1, 1, 1); G8_SCHED; G8_LDA(At, 1, 0); G8_STAGE(G8_SA(0, 1), a2, w1);
            G8_WAIT_V(8); G8_WAIT_L(0); G8_BAR; G8_MMA(0, 0, At, B0); G8_MMA(0, 1, At, B1); G8_BAR; G8_SCHED;
            G8_LDA(At, 1, 1); G8_STAGE(G8_SB(1, 0), b3, voffB); G8_STAGE(G8_SB(1, 1), b3 + hstepB, voffB); G8_STAGE(G8_SA(1, 0), a3, w0);
            G8_WAIT_V(8); G8_WAIT_L(0); G8_BAR; G8_MMA(1, 0, At, B0); G8_MMA(1, 1, At, B1); G8_BAR; G8_SCHED;
        }
        if constexpr (ALIGN_EPI) { if (wr == 0) G8_BAR; }
        E(acc, cur, wr, wc, fr, fq, lds);
        if (!E.keep(cur)) {
#pragma unroll
            for (int a = 0; a < 2; ++a)
#pragma unroll
                for (int b = 0; b < 2; ++b)
#pragma unroll
                    for (int m = 0; m < 4; ++m)
#pragma unroll
                        for (int n = 0; n < 2; ++n) acc[a][b][m][n] = (f32x4){0.f, 0.f, 0.f, 0.f};
        }
        if (!has_next) break;
        cur = nxt; cA = nA; cB = nB; ++ui;
        vc0[0] = vn0[0]; vc0[1] = vn0[1]; vc1[0] = vn1[0]; vc1[1] = vn1[1];
        if constexpr (ALIGN_EPI) { if (wr == 1) G8_BAR; }
    }
    G8_WAIT_V(0);
    if constexpr (!ALIGN_EPI) { if (wr == 0) G8_BAR; }
    G8_BAR;
#undef G8_SA
#undef G8_SB
#undef G8_STAGE
#undef G8_LDA
#undef G8_LDB
#undef G8_MMA
#undef G8_WAIT_V
#undef G8_WAIT_L
#undef G8_BAR
#undef G8_SCHED
}
}

struct DenseSched {
    const char* A; const char* B; int lda, ldb, nM, nN, G, c;
    __device__ __forceinline__ bool next(int i, g8::GU& u) const {
        const long L = (long)i * G + c; if (L >= (long)nM * nN) return false;
        g8::tile_of((int)L, nM, nN, u.pm, u.pn); u.x0 = 0; u.x1 = 0;
        u.A = A + (size_t)u.pm * 256 * lda * 2; u.B = B + (size_t)u.pn * 256 * ldb * 2; return true;
    }
    __device__ __forceinline__ void aoff(const g8::GU&, const int (&R)[2], const int (&C)[2], unsigned (&v0)[2], unsigned (&v1)[2]) const {
#pragma unroll
        for (int i = 0; i < 2; ++i) { v0[i] = (unsigned)(R[i] * lda + C[i]) * 2u; v1[i] = (unsigned)((R[i] + 128) * lda + C[i]) * 2u; }
    }
};
struct MixSched {
    const char* A0; const char* A1; const char* B0; const char* B1; int lda0, lda1, nM, nN, G, c;
    __device__ __forceinline__ bool next(int i, g8::GU& u) const {
        const long L = (long)(i >> 1) * G + c; if (L >= (long)nM * nN) return false;
        g8::tile_of((int)L, nM, nN, u.pm, u.pn); const int part = i & 1; u.x0 = part; u.x1 = 0;
        u.A = (part ? A1 : A0) + (size_t)u.pm * 256 * (part ? lda1 : lda0) * 2; u.B = (part ? B1 : B0) + (size_t)u.pn * 256 * 512 * 2; return true;
    }
    __device__ __forceinline__ void aoff(const g8::GU& u, const int (&R)[2], const int (&C)[2], unsigned (&v0)[2], unsigned (&v1)[2]) const {
        const int lda = u.x0 ? lda1 : lda0;
#pragma unroll
        for (int i = 0; i < 2; ++i) { v0[i] = (unsigned)(R[i] * lda + C[i]) * 2u; v1[i] = (unsigned)((R[i] + 128) * lda + C[i]) * 2u; }
    }
};
struct MoeSched {
    const LAS int* cum; const LAS int* cnt; const char* A; const char* B; const int* list; int G, c; bool gather; int ldb, nbrows;
    __device__ __forceinline__ bool next(int i, g8::GU& u) const {
        const long L = (long)i * G + c; const int total = cum[NEXP] * 4; if (L >= total) return false;
        const int blk = (int)L >> 2; u.pn = (int)L & 3;
        int e = 0;
#pragma unroll 1
        for (int k = 16; k >= 1; k >>= 1) if (cum[e + k] <= blk) e += k;
        u.x0 = e; u.x1 = blk - cum[e]; u.pm = blk;
        u.A = gather ? A : A + (size_t)blk * 256 * 512 * 2;
        u.B = B + ((size_t)e * nbrows + (size_t)u.pn * 256) * ldb * 2; return true;
    }
    __device__ __forceinline__ void aoff(const g8::GU& u, const int (&R)[2], const int (&C)[2], unsigned (&v0)[2], unsigned (&v1)[2]) const {
        if (gather) {
            const int n = cnt[u.x0]; const int* l = list + (size_t)u.x0 * T_ + u.x1 * 256;
#pragma unroll
            for (int i = 0; i < 2; ++i) { const int r0 = R[i], r1 = R[i] + 128;
                const int t0 = (u.x1 * 256 + r0 < n) ? l[r0] : 0, t1 = (u.x1 * 256 + r1 < n) ? l[r1] : 0;
                v0[i] = (unsigned)(t0 * 1024 + C[i]) * 2u; v1[i] = (unsigned)(t1 * 1024 + C[i]) * 2u; }
        } else {
#pragma unroll
            for (int i = 0; i < 2; ++i) { v0[i] = (unsigned)(R[i] * 512 + C[i]) * 2u; v1[i] = (unsigned)((R[i] + 128) * 512 + C[i]) * 2u; }
        }
    }
};

typedef f32x4 acc_t[2][2][4][2];
#define STG_SYNC() do { asm volatile("s_waitcnt lgkmcnt(0)" ::: "memory"); __builtin_amdgcn_s_barrier(); asm volatile("" ::: "memory"); } while (0)
__device__ __forceinline__ LAS unsigned char* stg_buf(LAS unsigned char* lds, int step) { return lds + STG_OFF + (step & 1) * STG_BUF; }
__device__ __forceinline__ void stg_put2(LAS unsigned char* buf, int wr, int wc, int fr, int fq, const u32x4& w0, const u32x4& w1) {
    LAS unsigned char* p = buf + (16 * wr + fr) * STG_ROWB + (32 * wc + 8 * fq) * 2; *(LAS u32x4*)p = w0; *(LAS u32x4*)(p + 256) = w1; }
__device__ __forceinline__ void stg_get2(const LAS unsigned char* buf, int wr, int wc, int fr, int fq, u32x4& w0, u32x4& w1) {
    const LAS unsigned char* p = buf + (16 * wr + fr) * STG_ROWB + (32 * wc + 8 * fq) * 2; w0 = *(const LAS u32x4*)p; w1 = *(const LAS u32x4*)(p + 256); }
__device__ __forceinline__ int stg_grow(int ai, int m, int rl) { return 128 * ai + 64 * (rl >> 4) + 16 * m + (rl & 15); }
__device__ __forceinline__ u32x4 pack8(const f32x4& v0, const f32x4& v1) { u32x4 w; w.x = pk2(v0[0], v0[1]); w.y = pk2(v0[2], v0[3]); w.z = pk2(v1[0], v1[1]); w.w = pk2(v1[2], v1[3]); return w; }

struct EpiProj {
    static constexpr bool PERM = true;
    bf16 *att, *mqk, *mv, *mo, *gates;
    __device__ __forceinline__ bool keep(const g8::GU&) const { return false; }
    __device__ __forceinline__ void operator()(acc_t& acc, const g8::GU& u, int wr, int wc, int fr, int fq, LAS unsigned char* lds) const {
        const int pn = u.pn; int tid = threadIdx.x; asm volatile("" : "+v"(tid));
        const bool gate = pn >= 9;
        bf16* base; int ldc, colt, act = 0; float sc = 1.f;
        if (pn < 3) { base = att; ldc = 768; colt = pn * 256; if (pn < 2) sc = QSCALE; }
        else if (pn < 5) { base = mqk; ldc = 512; colt = (pn - 3) * 256; }
        else if (pn < 7) { base = mv; ldc = 512; colt = (pn - 5) * 256; }
        else if (pn < 9) { base = mo; ldc = 512; colt = (pn - 7) * 256; act = 1; }
        else { base = gates; ldc = 2048; colt = (pn - 9) * 128; }
#pragma unroll
        for (int ai = 0; ai < 2; ++ai)
#pragma unroll
            for (int m = 0; m < 4; ++m) {
                u32x4 w0, w1;
                if (gate) {
                    f32x4 r0, r1, s0, s1;
#pragma unroll
                    for (int e = 0; e < 4; ++e) {
                        const float ea0 = __expf(-acc[ai][0][m][0][e]), eb0 = __expf(-acc[ai][1][m][0][e]), ea1 = __expf(-acc[ai][0][m][1][e]), eb1 = __expf(-acc[ai][1][m][1][e]);
                        r0[e] = (1.0f + eb0) * __builtin_amdgcn_rcpf(1.0f + ea0); s0[e] = __builtin_amdgcn_rcpf(1.0f + eb0);
                        r1[e] = (1.0f + eb1) * __builtin_amdgcn_rcpf(1.0f + ea1); s1[e] = __builtin_amdgcn_rcpf(1.0f + eb1); }
                    w0 = pack8(r0, r1); w1 = pack8(s0, s1);
                } else {
                    f32x4 a0 = acc[ai][0][m][0], a1 = acc[ai][0][m][1], b0 = acc[ai][1][m][0], b1 = acc[ai][1][m][1];
                    if (act) {
#pragma unroll
                        for (int e = 0; e < 4; ++e) { a0[e] = sigmoidf_(a0[e]); a1[e] = sigmoidf_(a1[e]); b0[e] = sigmoidf_(b0[e]); b1[e] = sigmoidf_(b1[e]); } }
                    else { a0 = a0 * sc; a1 = a1 * sc; b0 = b0 * sc; b1 = b1 * sc; }
                    w0 = pack8(a0, a1); w1 = pack8(b0, b1);
                }
                LAS unsigned char* buf = stg_buf(lds, ai * 4 + m);
                stg_put2(buf, wr, wc, fr, fq, w0, w1);
                STG_SYNC();
#pragma unroll
                for (int i = 0; i < 2; ++i) { const int p = tid + 512 * i, rl = p >> 5, ch = p & 31;
                    const u32x4 v = *(const LAS u32x4*)(buf + rl * STG_ROWB + ch * 16);
                    const int col = gate ? (ch < 16 ? colt + 8 * ch : 1024 + colt + 8 * (ch - 16)) : colt + 8 * ch;
                    *(u32x4*)(base + (size_t)(u.pm * 256 + stg_grow(ai, m, rl)) * ldc + col) = v; }
            }
        STG_SYNC();
    }
};
struct EpiMix {
    static constexpr bool PERM = true;
    bf16* gates;
    __device__ __forceinline__ bool keep(const g8::GU& u) const { return u.x0 == 0; }
    __device__ __forceinline__ void operator()(acc_t& acc, const g8::GU& u, int wr, int wc, int fr, int fq, LAS unsigned char* lds) const {
        int tid = threadIdx.x; asm volatile("" : "+v"(tid)); const bool fin = u.x0 != 0;
        bf16* gt = gates + (size_t)(u.pm * 256) * 2048 + u.pn * 256;
        if (!fin) {
#pragma unroll
            for (int ai = 0; ai < 2; ++ai)
#pragma unroll
                for (int m = 0; m < 4; ++m) {
                    LAS unsigned char* buf = stg_buf(lds, ai * 4 + m);
#pragma unroll
                    for (int i = 0; i < 2; ++i) { const int p = tid + 512 * i, rl = p >> 5, ch = p & 31;
                        *(LAS u32x4*)(buf + rl * STG_ROWB + ch * 16) = *(const u32x4*)(gt + (size_t)stg_grow(ai, m, rl) * 2048 + 8 * ch); }
                    STG_SYNC();
                    u32x4 g0, g1; stg_get2(buf, wr, wc, fr, fq, g0, g1);
                    f32x4 &a0 = acc[ai][0][m][0], &a1 = acc[ai][0][m][1], &b0 = acc[ai][1][m][0], &b1 = acc[ai][1][m][1];
                    a0[0] *= bflo(g0.x); a0[1] *= bfhi(g0.x); a0[2] *= bflo(g0.y); a0[3] *= bfhi(g0.y); a1[0] *= bflo(g0.z); a1[1] *= bfhi(g0.z); a1[2] *= bflo(g0.w); a1[3] *= bfhi(g0.w);
                    b0[0] *= bflo(g1.x); b0[1] *= bfhi(g1.x); b0[2] *= bflo(g1.y); b0[3] *= bfhi(g1.y); b1[0] *= bflo(g1.z); b1[1] *= bfhi(g1.z); b1[2] *= bflo(g1.w); b1[3] *= bfhi(g1.w);
                }
            STG_SYNC();
        } else {
#pragma unroll
            for (int ai = 0; ai < 2; ++ai)
#pragma unroll
                for (int m = 0; m < 4; ++m) {
                    LAS unsigned char* buf = stg_buf(lds, ai * 4 + m);
                    stg_put2(buf, wr, wc, fr, fq, pack8(acc[ai][0][m][0], acc[ai][0][m][1]), pack8(acc[ai][1][m][0], acc[ai][1][m][1]));
                    STG_SYNC();
#pragma unroll
                    for (int i = 0; i < 2; ++i) { const int p = tid + 512 * i, rl = p >> 5, ch = p & 31;
                        bf16* gp = gt + (size_t)stg_grow(ai, m, rl) * 2048 + 8 * ch;
                        const u32x4 g = *(const u32x4*)(gp + 1024); const u32x4 v = *(const LAS u32x4*)(buf + rl * STG_ROWB + ch * 16);
                        u32x4 w; w.x = pk2(bflo(v.x) * bflo(g.x), bfhi(v.x) * bfhi(g.x)); w.y = pk2(bflo(v.y) * bflo(g.y), bfhi(v.y) * bfhi(g.y));
                        w.z = pk2(bflo(v.z) * bflo(g.z), bfhi(v.z) * bfhi(g.z)); w.w = pk2(bflo(v.w) * bflo(g.w), bfhi(v.w) * bfhi(g.w));
                        *(u32x4*)gp = w; }
                }
            STG_SYNC();
        }
    }
};
struct EpiOut {
    static constexpr bool PERM = false;
    const float* x; float* out;
    __device__ __forceinline__ bool keep(const g8::GU&) const { return false; }
    __device__ __forceinline__ void operator()(acc_t& acc, const g8::GU& u, int wr, int wc, int fr, int fq, LAS unsigned char* lds) const {
        int tid = threadIdx.x; asm volatile("" : "+v"(tid));
#pragma unroll
        for (int ai = 0; ai < 2; ++ai)
#pragma unroll
            for (int m = 0; m < 4; ++m)
#pragma unroll
                for (int bj = 0; bj < 2; ++bj) {
                    LAS unsigned char* buf = stg_buf(lds, (ai * 4 + m) * 2 + bj);
                    LAS unsigned char* pp = buf + (16 * wr + fr) * STG_ROWB + (32 * wc + 4 * fq) * 4;
                    *(LAS f32x4*)pp = acc[ai][bj][m][0]; *(LAS f32x4*)(pp + 64) = acc[ai][bj][m][1];
                    f32x4 xv[2];
#pragma unroll
                    for (int i = 0; i < 2; ++i) { const int p = tid + 512 * i, rl = p >> 5, ch = p & 31; xv[i] = *(const f32x4*)(x + (size_t)(u.pm * 256 + stg_grow(ai, m, rl)) * 1024 + u.pn * 256 + bj * 128 + 4 * ch); }
                    STG_SYNC();
#pragma unroll
                    for (int i = 0; i < 2; ++i) { const int p = tid + 512 * i, rl = p >> 5, ch = p & 31;
                        const f32x4 v = *(const LAS f32x4*)(buf + rl * STG_ROWB + ch * 16);
                        *(f32x4*)(out + (size_t)(u.pm * 256 + stg_grow(ai, m, rl)) * 1024 + u.pn * 256 + bj * 128 + 4 * ch) = xv[i] + v; }
                }
        STG_SYNC();
    }
};
struct EpiG1 {
    static constexpr bool PERM = true;
    bf16* hid; const float* rstd2; const int* list; const LAS int* cnt;
    __device__ __forceinline__ bool keep(const g8::GU&) const { return false; }
    __device__ __forceinline__ void operator()(acc_t& acc, const g8::GU& u, int wr, int wc, int fr, int fq, LAS unsigned char* lds) const {
        int tid = threadIdx.x; asm volatile("" : "+v"(tid)); const int n = cnt[u.x0]; const int* l = list + (size_t)u.x0 * T_ + u.x1 * 256;
        const int rl0 = wr * 64 + fr;
#pragma unroll
        for (int ai = 0; ai < 2; ++ai)
#pragma unroll
            for (int m = 0; m < 4; ++m) { const int rl = rl0 + ai * 128 + m * 16; float rs = 0.f;
                if (u.x1 * 256 + rl < n) rs = rstd2[l[rl]];
                const f32x4 g0 = acc[ai][0][m][0] * rs, g1 = acc[ai][0][m][1] * rs, u0 = acc[ai][1][m][0] * rs, u1 = acc[ai][1][m][1] * rs;
                f32x4 h0, h1;
#pragma unroll
                for (int e = 0; e < 4; ++e) { h0[e] = siluf_(g0[e]) * u0[e]; h1[e] = siluf_(g1[e]) * u1[e]; }
                LAS unsigned char* buf = stg_buf(lds, ai * 4 + m);
                *(LAS u32x4*)(buf + (16 * wr + fr) * STG_ROWB + (32 * wc + 8 * fq) * 2) = pack8(h0, h1);
                STG_SYNC();
                { const int prl = tid >> 4, ch = tid & 15;
                  *(u32x4*)(hid + (size_t)(u.pm * 256 + stg_grow(ai, m, prl)) * 512 + u.pn * 128 + 8 * ch) = *(const LAS u32x4*)(buf + prl * STG_ROWB + ch * 16); }
            }
        STG_SYNC();
    }
};
struct EpiG2 {
    static constexpr bool PERM = true;
    bf16* ys; const float* sw; const LAS int* cnt;
    __device__ __forceinline__ bool keep(const g8::GU&) const { return false; }
    __device__ __forceinline__ void operator()(acc_t& acc, const g8::GU& u, int wr, int wc, int fr, int fq, LAS unsigned char* lds) const {
        int tid = threadIdx.x; asm volatile("" : "+v"(tid)); const int n = cnt[u.x0]; const float* s = sw + (size_t)u.x0 * T_ + u.x1 * 256;
        const int rl0 = wr * 64 + fr;
#pragma unroll
        for (int ai = 0; ai < 2; ++ai)
#pragma unroll
            for (int m = 0; m < 4; ++m) { const int rl = rl0 + ai * 128 + m * 16; float wgt = 0.f;
                if (u.x1 * 256 + rl < n) wgt = s[rl];
                LAS unsigned char* buf = stg_buf(lds, ai * 4 + m);
                stg_put2(buf, wr, wc, fr, fq, pack8(acc[ai][0][m][0] * wgt, acc[ai][0][m][1] * wgt), pack8(acc[ai][1][m][0] * wgt, acc[ai][1][m][1] * wgt));
                STG_SYNC();
#pragma unroll
                for (int i = 0; i < 2; ++i) { const int p = tid + 512 * i, prl = p >> 5, ch = p & 31;
                    *(u32x4*)(ys + (size_t)(u.pm * 256 + stg_grow(ai, m, prl)) * 1024 + u.pn * 256 + 8 * ch) = *(const LAS u32x4*)(buf + prl * STG_ROWB + ch * 16); }
            }
        STG_SYNC();
    }
};

#define XB_TMO      128
#define XB_XCNT(j)  (256  + 64 * (j))
#define XB_XSUB(j)  (1280 + 64 * (j))
#define XB_XGEN(j)  (2304 + 64 * (j))
#define XB_TOP      3328
#define XB_TOPGEN   3392
#define XCD_BAR_WORDS 3456
#define XB_SPIN_CAP (1u << 18)
__device__ __forceinline__ unsigned xb_ld(unsigned* p)              { return __hip_atomic_load(p, __ATOMIC_RELAXED, __HIP_MEMORY_SCOPE_AGENT); }
__device__ __forceinline__ unsigned xb_add(unsigned* p, unsigned v) { return __hip_atomic_fetch_add(p, v, __ATOMIC_RELAXED, __HIP_MEMORY_SCOPE_AGENT); }
__device__ __forceinline__ unsigned xb_xcc_id() { return (unsigned)__builtin_amdgcn_s_getreg((3 << 11) | 20) & 0xFu; }
#define XB_SPIN(cond, bar) do { unsigned _sp = 0; while (cond) { __builtin_amdgcn_s_sleep(1); \
    if ((++_sp & 255u) == 0u) { if (xb_ld(&(bar)[XB_TMO])) break; if (_sp > XB_SPIN_CAP) { atomicAdd(&(bar)[XB_TMO], 1u); break; } } } } while (0)
struct XcdBarrier { unsigned* bar; unsigned x; volatile LAS unsigned* st; };
__device__ __forceinline__ XcdBarrier xcd_barrier_post(unsigned* bar, volatile LAS unsigned* st) {
    XcdBarrier b; b.bar = bar; b.x = xb_xcc_id(); b.st = st;
    if (threadIdx.x == 0) (void)xb_add(&bar[XB_XCNT(b.x)], 1u);
    return b;
}
__device__ __forceinline__ void xcd_barrier_complete(unsigned* bar, unsigned x, unsigned& nloc, unsigned& nx) {
    const unsigned G = gridDim.x * gridDim.y * gridDim.z;
    unsigned sum, cnt, mine, sp = 0u;
    for (;;) {
        sum = 0u; cnt = 0u; mine = 0u;
#pragma unroll
        for (unsigned j = 0; j < 16; ++j) { const unsigned c = xb_ld(&bar[XB_XCNT(j)]); sum += c; cnt += (c > 0u) ? 1u : 0u; mine = (j == x) ? c : mine; }
        if (sum == G) break;
        __builtin_amdgcn_s_sleep(1);
        if ((++sp & 255u) == 0u) { if (xb_ld(&bar[XB_TMO])) break; if (sp > XB_SPIN_CAP) { atomicAdd(&bar[XB_TMO], 1u); break; } }
    }
    nloc = mine > 0u ? mine : 1u; nx = cnt > 0u ? cnt : 1u;
}
__device__ __forceinline__ void xcd_barrier(const XcdBarrier& b) {
    asm volatile("s_waitcnt vmcnt(0)" ::: "memory");
    __syncthreads();
    if (threadIdx.x == 0) {
        unsigned* bar = b.bar;
        __builtin_amdgcn_s_waitcnt(0);
        unsigned nloc = b.st[0], nx = b.st[1];
        if (nloc == 0u) { xcd_barrier_complete(bar, b.x, nloc, nx); b.st[0] = nloc; b.st[1] = nx; }
        const unsigned old = xb_add(&bar[XB_XSUB(b.x)], 1u);
        const unsigned gen = old / nloc;
        if (old + 1u == (gen + 1u) * nloc) {
            __builtin_amdgcn_fence(__ATOMIC_RELEASE, "agent");
            asm volatile("s_waitcnt vmcnt(0)" ::: "memory");
            const unsigned og = xb_add(&bar[XB_TOP], 1u);
            const unsigned tg = og / nx;
            if (og + 1u == (tg + 1u) * nx) xb_add(&bar[XB_TOPGEN], 1u);
            else XB_SPIN(xb_ld(&bar[XB_TOPGEN]) == tg, bar);
            __builtin_amdgcn_fence(__ATOMIC_ACQUIRE, "agent");
            xb_add(&bar[XB_XGEN(b.x)], 1u);
            asm volatile("s_waitcnt vmcnt(0)" ::: "memory");
        } else {
            XB_SPIN(xb_ld(&bar[XB_XGEN(b.x)]) == gen, bar);
            __builtin_amdgcn_fence(__ATOMIC_ACQUIRE, "agent");
            asm volatile("s_waitcnt vmcnt(0)" ::: "memory");
        }
    }
    __syncthreads();
}

struct Args { const float* in[21]; float* out; unsigned char* ws; int ph_lo, ph_hi; };

__device__ __forceinline__ void p0_transpose_item(const float* W, int ldw, int srccol0, int k0, bf16* WT, int ldt, int destrow0, int lane) {
    const int kk = lane >> 3, n4 = lane & 7;
    const float* src = W + (size_t)(k0 + 8 * kk) * ldw + srccol0 + 4 * n4;
    f32x4 v[8];
#pragma unroll
    for (int i = 0; i < 8; ++i) v[i] = *(const f32x4*)(src + (size_t)i * ldw);
    bf16* dst = WT + (size_t)(destrow0 + 4 * n4) * ldt + k0 + 8 * kk;
#pragma unroll
    for (int c = 0; c < 4; ++c) { u32x4 o; o.x = pk2(v[0][c], v[1][c]); o.y = pk2(v[2][c], v[3][c]); o.z = pk2(v[4][c], v[5][c]); o.w = pk2(v[6][c], v[7][c]);
        *(u32x4*)(dst + (size_t)c * ldt) = o; }
}

__device__ __forceinline__ void phase0(const Args& a, LAS unsigned char* lds, int vcu, int G, int tid, int lane, int wave) {
    unsigned char* ws = a.ws;
    const float* x = a.in[0]; const float* nw = a.in[1]; const float* w_in = a.in[2];
    LAS float* WGF = (LAS float*)(lds + 69632);
#if PROBE_PH >= 100
    unsigned long long sp0 = __builtin_amdgcn_s_memrealtime(), sp1 = 0, sp2 = 0, sp3 = 0;
#endif
    {   f32x4 g0[2], g1[2]; float nk[2];
#pragma unroll
        for (int i = 0; i < 2; ++i) { const int k = tid + 512 * i; const float* src = w_in + (size_t)k * 4360 + 2304; g0[i] = *(const f32x4*)src; g1[i] = *(const f32x4*)(src + 4); nk[i] = nw[k]; }
#pragma unroll
        for (int i = 0; i < 2; ++i) { const int k = tid + 512 * i;
#pragma unroll
            for (int g = 0; g < 4; ++g) { WGF[g * 1024 + k] = nk[i] * g0[i][g]; WGF[(4 + g) * 1024 + k] = nk[i] * g1[i][g]; } } }
    __syncthreads();
    const int gw = vcu * NWAVES + wave, NGW = G * NWAVES;
#if PROBE_PH >= 100
    sp1 = __builtin_amdgcn_s_memrealtime();
#endif
    {
        f32x4 nwv[4];
#pragma unroll
        for (int j = 0; j < 4; ++j) nwv[j] = ((const f32x4*)nw)[lane + 64 * j];
        float big[4], bfg[4];
#pragma unroll
        for (int h = 0; h < 4; ++h) { big[h] = a.in[5][h]; bfg[h] = a.in[6][h]; }
        bf16* XN = (bf16*)(ws + WS_XN); float* IGF = (float*)(ws + WS_IGF);
        const bool hi32 = (lane & 32) != 0, hi16 = (lane & 16) != 0, hi8 = (lane & 8) != 0; const int gsel = lane >> 3;
        f32x4 v[4][4], vn[4][4];
#pragma unroll
        for (int r = 0; r < 4; ++r) { const int m = gw + r * NGW; const int mm = m < T_ ? m : gw;
#pragma unroll
            for (int j = 0; j < 4; ++j) v[r][j] = ((const f32x4*)(x + (size_t)mm * 1024) + lane)[64 * j]; }
        for (int m0 = gw; m0 < T_; m0 += 4 * NGW) {
#pragma unroll
            for (int r = 0; r < 4; ++r) { const int m = m0 + (4 + r) * NGW; const int mm = m < T_ ? m : gw;
#pragma unroll
                for (int j = 0; j < 4; ++j) vn[r][j] = ((const f32x4*)(x + (size_t)mm * 1024) + lane)[64 * j]; }
#pragma unroll
            for (int r = 0; r < 4; ++r) { const int m = m0 + r * NGW;
                if (m < T_) {
                    float s = 0.f;
#pragma unroll
                    for (int j = 0; j < 4; ++j) s += (v[r][j].x * v[r][j].x + v[r][j].y * v[r][j].y) + (v[r][j].z * v[r][j].z + v[r][j].w * v[r][j].w);
                    const float rstd = 1.0f / sqrtf(wave_sum(s) * (1.f / 1024.f) + EPS_);
                    unsigned long long* o8 = (unsigned long long*)(XN + (size_t)m * 1024) + lane;
#pragma unroll
                    for (int j = 0; j < 4; ++j) { const f32x4 y = v[r][j] * rstd * nwv[j]; o8[64 * j] = (unsigned long long)pk2(y.x, y.y) | ((unsigned long long)pk2(y.z, y.w) << 32); }
                    float pg[8];
#pragma unroll
                    for (int g = 0; g < 8; ++g) { float p = 0.f;
#pragma unroll
                        for (int j = 0; j < 4; ++j) { const f32x4 w4 = *(const LAS f32x4*)(WGF + g * 1024 + 256 * j + 4 * lane); p += (v[r][j].x * w4.x + v[r][j].y * w4.y) + (v[r][j].z * w4.z + v[r][j].w * w4.w); }
                        pg[g] = p; }
                    float a4[4], a2[2], a1;
#pragma unroll
                    for (int i = 0; i < 4; ++i) { const float keep = hi32 ? pg[4 + i] : pg[i], send = hi32 ? pg[i] : pg[4 + i]; a4[i] = keep + __shfl_xor(send, 32); }
#pragma unroll
                    for (int i = 0; i < 2; ++i) { const float keep = hi16 ? a4[2 + i] : a4[i], send = hi16 ? a4[i] : a4[2 + i]; a2[i] = keep + __shfl_xor(send, 16); }
                    { const float keep = hi8 ? a2[1] : a2[0], send = hi8 ? a2[0] : a2[1]; a1 = keep + __shfl_xor(send, 8); }
                    a1 += __shfl_xor(a1, 4); a1 += __shfl_xor(a1, 2); a1 += __shfl_xor(a1, 1);
                    if ((lane & 7) == 0) { const float z0 = a1 * rstd;
                        float o;
                        if (gsel < 4) o = z0 + big[gsel & 3]; else { const float z = z0 + bfg[gsel & 3]; o = fminf(z, 0.f) - log1pf(expf(-fabsf(z))); }
                        IGF[(size_t)m * 8 + gsel] = o; }
                }
                asm volatile("" ::: "memory"); __builtin_amdgcn_sched_barrier(0); }
#pragma unroll
            for (int r = 0; r < 4; ++r)
#pragma unroll
                for (int j = 0; j < 4; ++j) v[r][j] = vn[r][j];
        }
    }
#if PROBE_PH >= 100
    asm volatile("s_waitcnt vmcnt(0)" ::: "memory"); __syncthreads(); sp2 = __builtin_amdgcn_s_memrealtime();
#endif
    {
        bf16* Win = (bf16*)(ws + WS_WIN); bf16* Wao = (bf16*)(ws + WS_WAO); bf16* Wmo = (bf16*)(ws + WS_WMO); bf16* Wout = (bf16*)(ws + WS_WOUT);
        bf16* Wgu = (bf16*)(ws + WS_WGU); bf16* Wdn = (bf16*)(ws + WS_WDN);
        constexpr int I_IN = 16 * 136, I_AO = 8 * 32, I_OUT = 16 * 32, I_GU = 32 * 16 * 32, I_DN = 32 * 8 * 32;
        constexpr int NITEMS = I_IN + 2 * I_AO + I_OUT + I_GU + I_DN;
        for (int it = gw; it < NITEMS; it += NGW) {
            int r = it;
            if (r < I_IN) { const int kb = r / 136, nb = r % 136, d0 = nb * 32; int sc0 = d0;
                if (d0 >= 2304) { const int q = d0 - 2304, j = q >> 8, rr = q & 255; sc0 = (rr < 128 ? 2312 : 3336) + 128 * j + (rr & 127); }
                p0_transpose_item(w_in, 4360, sc0, kb * 64, Win, 1024, d0, lane); continue; } r -= I_IN;
            if (r < I_AO) { const int kb = r / 32, nb = r % 32; p0_transpose_item(a.in[9], 1024, nb * 32, kb * 64, Wao, 512, nb * 32, lane); continue; } r -= I_AO;
            if (r < I_AO) { const int kb = r / 32, nb = r % 32; p0_transpose_item(a.in[10], 1024, nb * 32, kb * 64, Wmo, 512, nb * 32, lane); continue; } r -= I_AO;
            if (r < I_OUT) { const int kb = r / 32, nb = r % 32; p0_transpose_item(a.in[11], 1024, nb * 32, kb * 64, Wout, 1024, nb * 32, lane); continue; } r -= I_OUT;
            if (r < I_GU) { const int e = r / 512, q = r % 512, kb = q / 32, nb = q % 32, d0 = nb * 32, tt = d0 >> 8, j = d0 & 255;
                const float* src = (j < 128 ? a.in[17] : a.in[18]) + (size_t)e * 1024 * 512;
                p0_transpose_item(src, 512, 128 * tt + (j & 127), kb * 64, Wgu + (size_t)e * 1024 * 1024, 1024, d0, lane); continue; } r -= I_GU;
            { const int e = r / 256, q = r % 256, kb = q / 32, nb = q % 32;
                p0_transpose_item(a.in[19] + (size_t)e * 512 * 1024, 1024, nb * 32, kb * 64, Wdn + (size_t)e * 1024 * 512, 512, nb * 32, lane); }
        }
        bf16* WR = (bf16*)(ws + WS_WR);
        for (int i = (vcu * 512 + tid); i < 48 * 1024; i += G * 512) { const int n = i >> 10, k = i & 1023; float v = 0.f;
            if (n < 4) v = a.in[13][k * 4 + n]; else if (n < 36) v = a.in[15][k * 32 + (n - 4)];
            WR[i] = (bf16)(pk2(v, 0.f) & 0xffffu); }
    }
#if PROBE_PH >= 100
    asm volatile("s_waitcnt vmcnt(0)" ::: "memory"); __syncthreads(); sp3 = __builtin_amdgcn_s_memrealtime();
    if (blockIdx.x == 0 && tid == 0) { const unsigned long long d = (PROBE_PH == 100 ? sp2 - sp1 : PROBE_PH == 101 ? sp3 - sp2 : sp1 - sp0) * PROBE_AMP; const unsigned long long te = __builtin_amdgcn_s_memrealtime(); while (__builtin_amdgcn_s_memrealtime() - te < d) __builtin_amdgcn_s_sleep(8); }
#endif
}

__device__ __forceinline__ void attn_unit(const Args& a, LAS unsigned char* lds, int b, int blk, int kvh, int tid, int lane, int wave) {
    bf16* ATT = (bf16*)(a.ws + WS_ATT);
    LAS short* Ks = (LAS short*)lds;
    LAS short* VT = (LAS short*)(lds + 36864);
    const long t0 = (long)b * SEQ_ + blk * 128;
#pragma unroll
    for (int i = 0; i < 4; ++i) { const int p = tid + 512 * i, row = p >> 3, ch = p & 7;
        u32x4 kv = (u32x4){0u, 0u, 0u, 0u}, vv = (u32x4){0u, 0u, 0u, 0u};
        if (blk > 0 || row >= 128) { const bf16* src = ATT + (t0 - 128 + row) * 768; kv = *(const u32x4*)(src + 512 + kvh * 64 + ch * 8); vv = *(const u32x4*)(src + 640 + kvh * 64 + ch * 8); }
        *(LAS u32x4*)(Ks + row * 72 + ch * 8) = kv;
        LAS short* vt = VT + (ch * 8) * 264 + row;
        vt[0 * 264] = (short)(vv.x & 0xffff); vt[1 * 264] = (short)(vv.x >> 16); vt[2 * 264] = (short)(vv.y & 0xffff); vt[3 * 264] = (short)(vv.y >> 16);
        vt[4 * 264] = (short)(vv.z & 0xffff); vt[5 * 264] = (short)(vv.z >> 16); vt[6 * 264] = (short)(vv.w & 0xffff); vt[7 * 264] = (short)(vv.w >> 16); }
    __syncthreads();
    const int q = lane & 31, h = lane >> 5;
#pragma unroll 1
    for (int gi = 0; gi < 2; ++gi) {
        const int g16 = wave * 2 + gi, g = g16 >> 2, r = g16 & 3, hq = kvh * 4 + g;
        const int i = 32 * r + q;
        bf16* qrow = ATT + (t0 + i) * 768 + hq * 64;
        bf16x8 qf[4];
#pragma unroll
        for (int s = 0; s < 4; ++s) qf[s] = *(const bf16x8*)(qrow + 16 * s + 8 * h);
        const float sink2 = a.in[7][hq] * LOG2E;
        f32x16 S[5];
#pragma unroll
        for (int tt = 0; tt < 5; ++tt) { const int jt = r + tt; f32x16 c = {};
#pragma unroll
            for (int s = 0; s < 4; ++s) { const bf16x8 kf = *(const LAS bf16x8*)(Ks + (32 * jt + q) * 72 + 16 * s + 8 * h); c = __builtin_amdgcn_mfma_f32_32x32x16_bf16(kf, qf[s], c, 0, 0, 0); }
            S[tt] = c; }
        float mx = sink2;
#pragma unroll
        for (int tt = 0; tt < 5; ++tt) { const bool tv = (blk > 0) || (r + tt >= 4);
#pragma unroll
            for (int rg = 0; rg < 16; ++rg) { const int kr = (rg & 3) + 8 * (rg >> 2) + 4 * h;
                const bool ok = tv && (tt == 0 ? (kr > q) : (tt == 4 ? (kr <= q) : true));
                const float sv = ok ? S[tt][rg] : -INFINITY; S[tt][rg] = sv; mx = fmaxf(mx, sv); } }
        mx = fmaxf(mx, __shfl_xor(mx, 32));
        float l = 0.f;
#pragma unroll
        for (int tt = 0; tt < 5; ++tt)
#pragma unroll
            for (int rg = 0; rg < 16; ++rg) { const float p = __builtin_amdgcn_exp2f(S[tt][rg] - mx); S[tt][rg] = p; l += p; }
        l += __shfl_xor(l, 32);
        l += __builtin_amdgcn_exp2f(sink2 - mx);
        const float il = 1.0f / l;
        f32x16 O[2]; O[0] = (f32x16){}; O[1] = (f32x16){};
#pragma unroll
        for (int tt = 0; tt < 5; ++tt) { const int jt = r + tt;
#pragma unroll
            for (int ks = 0; ks < 2; ++ks) {
                u32x4 pw; pw.x = pk2(S[tt][8 * ks + 0], S[tt][8 * ks + 1]); pw.y = pk2(S[tt][8 * ks + 2], S[tt][8 * ks + 3]); pw.z = pk2(S[tt][8 * ks + 4], S[tt][8 * ks + 5]); pw.w = pk2(S[tt][8 * ks + 6], S[tt][8 * ks + 7]);
                const bf16x8 pf = __builtin_bit_cast(bf16x8, pw);
#pragma unroll
                for (int dt = 0; dt < 2; ++dt) { const LAS short* vp = VT + (32 * dt + q) * 264 + 32 * jt + 16 * ks + 4 * h;
                    const s16x4 lo = *(const LAS s16x4*)vp, hi = *(const LAS s16x4*)(vp + 8);
                    const bf16x8 vf = (bf16x8){lo[0], lo[1], lo[2], lo[3], hi[0], hi[1], hi[2], hi[3]};
                    O[dt] = __builtin_amdgcn_mfma_f32_32x32x16_bf16(vf, pf, O[dt], 0, 0, 0); } } }
#pragma unroll
        for (int dt = 0; dt < 2; ++dt)
#pragma unroll
            for (int g4 = 0; g4 < 4; ++g4) { u32x2 w; w.x = pk2(O[dt][4 * g4 + 0] * il, O[dt][4 * g4 + 1] * il); w.y = pk2(O[dt][4 * g4 + 2] * il, O[dt][4 * g4 + 3] * il);
                *(u32x2*)(qrow + 32 * dt + 8 * g4 + 4 * h) = w; }
    }
    __syncthreads();
}

__device__ __forceinline__ void conv8(const bf16* MQK, const float* cw, const float* cb, long trow, int s_in_seq, int cidx, float (&y)[8]) {
    const f32x4 b0 = *(const f32x4*)(cb + cidx), b1 = *(const f32x4*)(cb + cidx + 4);
    y[0] = b0.x; y[1] = b0.y; y[2] = b0.z; y[3] = b0.w; y[4] = b1.x; y[5] = b1.y; y[6] = b1.z; y[7] = b1.w;
#pragma unroll
    for (int j = 0; j < 4; ++j) { const int d = j - 3;
        if (s_in_seq + d >= 0) {
            const u32x4 u = *(const u32x4*)(MQK + (trow + d) * 512 + cidx);
            const f32x4 w0 = *(const f32x4*)(cw + j * 512 + cidx), w1 = *(const f32x4*)(cw + j * 512 + cidx + 4);
            y[0] += w0.x * bflo(u.x); y[1] += w0.y * bfhi(u.x); y[2] += w0.z * bflo(u.y); y[3] += w0.w * bfhi(u.y);
            y[4] += w1.x * bflo(u.z); y[5] += w1.y * bfhi(u.z); y[6] += w1.z * bflo(u.w); y[7] += w1.w * bfhi(u.w);
        } }
#pragma unroll
    for (int e = 0; e < 8; ++e) y[e] = siluf_(y[e]);
}

__device__ __forceinline__ void mprep_unit(const Args& a, LAS unsigned char* lds, int unit, int tid, int lane, int wave) {
    const int hh = unit & 3, c = (unit >> 2) & 63, b = unit >> 8;
    const long t0 = (long)b * SEQ_ + c * 64;
    const bf16* MQK = (const bf16*)(a.ws + WS_MQK); const bf16* MV = (const bf16*)(a.ws + WS_MV);
    const float* IGF = (const float*)(a.ws + WS_IGF); float* CHS = (float*)(a.ws + WS_CHS) + (size_t)unit * 256;
    bf16* UT = (bf16*)(a.ws + WS_XN) + (size_t)unit * 8192;
    LAS short* KwT = (LAS short*)lds;
    LAS short* VT = (LAS short*)(lds + 9216);
    LAS float* wsv = (LAS float*)(lds + 27648);
    if (wave == 0) {
        const float lf = IGF[(t0 + lane) * 8 + 4 + hh], ig = IGF[(t0 + lane) * 8 + hh];
        float bc = lf;
#pragma unroll
        for (int o = 1; o < 64; o <<= 1) { const float t = __shfl_up(bc, o); if (lane >= o) bc += t; }
        const float bl = __shfl(bc, 63);
        const float g = bl - bc + ig; const float loc = wave_max(g);
        wsv[lane] = __expf(g - loc);
        if (lane == 0) { CHS[64] = bl; CHS[65] = loc; }
    }
    __syncthreads();
    {   const int s = tid >> 3, ch = tid & 7;
        float y[8]; conv8(MQK, a.in[3], a.in[4], t0 + s, c * 64 + s, 256 + hh * 64 + ch * 8, y);
        const float wsc = wsv[s] * 0.125f;
#pragma unroll
        for (int e = 0; e < 8; ++e) KwT[(ch * 8 + e) * 72 + s] = (short)(pk2(y[e] * wsc, 0.f) & 0xffffu);
        const bf16* vsrc = MV + (t0 + s) * 512 + hh * 128 + ch * 16;
        const u32x4 v0 = *(const u32x4*)vsrc, v1 = *(const u32x4*)(vsrc + 8);
        LAS short* vt = VT + (ch * 16) * 72 + s;
        vt[0 * 72] = (short)(v0.x & 0xffff); vt[1 * 72] = (short)(v0.x >> 16); vt[2 * 72] = (short)(v0.y & 0xffff); vt[3 * 72] = (short)(v0.y >> 16);
        vt[4 * 72] = (short)(v0.z & 0xffff); vt[5 * 72] = (short)(v0.z >> 16); vt[6 * 72] = (short)(v0.w & 0xffff); vt[7 * 72] = (short)(v0.w >> 16);
        vt[8 * 72] = (short)(v1.x & 0xffff); vt[9 * 72] = (short)(v1.x >> 16); vt[10 * 72] = (short)(v1.y & 0xffff); vt[11 * 72] = (short)(v1.y >> 16);
        vt[12 * 72] = (short)(v1.z & 0xffff); vt[13 * 72] = (short)(v1.z >> 16); vt[14 * 72] = (short)(v1.w & 0xffff); vt[15 * 72] = (short)(v1.w >> 16);
    }
    __syncthreads();
    if (tid < 64) { float n = 0.f;
#pragma unroll 8
        for (int s = 0; s < 64; ++s) n += bf2f(KwT[tid * 72 + s]);
        CHS[tid] = n; }
    {   const int dkt = wave & 1, dvt = wave >> 1, q = lane & 31, h = lane >> 5;
        f32x16 acc = {};
#pragma unroll
        for (int ks = 0; ks < 4; ++ks) { const bf16x8 af = *(const LAS bf16x8*)(KwT + (32 * dkt + q) * 72 + 16 * ks + 8 * h); const bf16x8 bfr = *(const LAS bf16x8*)(VT + (32 * dvt + q) * 72 + 16 * ks + 8 * h);
            acc = __builtin_amdgcn_mfma_f32_32x32x16_bf16(af, bfr, acc, 0, 0, 0); }
        bf16* up = UT + (32 * dvt + q) * 64 + 32 * dkt + 4 * h;
#pragma unroll
        for (int g4 = 0; g4 < 4; ++g4) { u32x2 w; w.x = pk2(acc[4 * g4 + 0], acc[4 * g4 + 1]); w.y = pk2(acc[4 * g4 + 2], acc[4 * g4 + 3]); *(u32x2*)(up + 8 * g4) = w; }
    }
    __syncthreads();
}

__device__ __forceinline__ void phase3(const Args& a, int G, int tid) {
    unsigned* UT32 = (unsigned*)(a.ws + WS_XN); float* CHS = (float*)(a.ws + WS_CHS);
    for (int item = blockIdx.x * 512 + tid; item < 32 * 4096; item += G * 512) {
        const int bh = item >> 12, ep = item & 4095, b = bh >> 2, hh = bh & 3;
        float c0 = 0.f, c1 = 0.f, nst = 0.f, m = 0.f;
#pragma unroll 1
        for (int cb = 0; cb < 64; cb += 8) {
            unsigned u[8]; float bs[8], lc[8], nl[8];
#pragma unroll
            for (int k = 0; k < 8; ++k) { const int unit = ((b * 64 + cb + k) << 2) + hh; u[k] = UT32[(size_t)unit * 4096 + ep]; bs[k] = CHS[(size_t)unit * 256 + 64]; lc[k] = CHS[(size_t)unit * 256 + 65];
                nl[k] = (ep < 64) ? CHS[(size_t)unit * 256 + ep] : 0.f; }
#pragma unroll
            for (int k = 0; k < 8; ++k) { const int unit = ((b * 64 + cb + k) << 2) + hh;
                UT32[(size_t)unit * 4096 + ep] = pk2(c0, c1);
                if (ep < 64) CHS[(size_t)unit * 256 + 128 + ep] = nst;
                if (ep == 0) CHS[(size_t)unit * 256 + 66] = m;
                const float mn = fmaxf(bs[k] + m, lc[k]); const float wc = __expf(bs[k] + m - mn), sc = __expf(lc[k] - mn);
                c0 = wc * c0 + sc * bflo(u[k]); c1 = wc * c1 + sc * bfhi(u[k]); nst = wc * nst + sc * nl[k]; m = mn; }
        }
    }
}

struct MoutLoad { u32x4 q[4], k[4]; u32x4 v0, v1, c0, c1; u32x2 mo[4]; float lf, ig, mp, np; };
__device__ __forceinline__ void mout_load(const Args& a, int unit, int tid, int lane, int wave, MoutLoad& L) {
    const int hh = unit & 3, c = (unit >> 2) & 63, b = unit >> 8;
    const long t0 = (long)b * SEQ_ + c * 64;
    const bf16* MQK = (const bf16*)(a.ws + WS_MQK); const bf16* MV = (const bf16*)(a.ws + WS_MV); const bf16* MO = (const bf16*)(a.ws + WS_MO);
    const float* IGF = (const float*)(a.ws + WS_IGF); const float* CHS = (const float*)(a.ws + WS_CHS) + (size_t)unit * 256;
    const bf16* UT = (const bf16*)(a.ws + WS_XN) + (size_t)unit * 8192;
    const int s = tid >> 3, ch = tid & 7;
#pragma unroll
    for (int j = 0; j < 4; ++j) { const int d = j - 3; const bool ok = (c * 64 + s + d) >= 0; const bf16* src = MQK + (t0 + s + (ok ? d : 0)) * 512 + hh * 64 + ch * 8;
        L.q[j] = *(const u32x4*)src; L.k[j] = *(const u32x4*)(src + 256); }
    const bf16* vsrc = MV + (t0 + s) * 512 + hh * 128 + ch * 16; L.v0 = *(const u32x4*)vsrc; L.v1 = *(const u32x4*)(vsrc + 8);
    L.c0 = *(const u32x4*)(UT + (tid >> 3) * 64 + (tid & 7) * 8); L.c1 = *(const u32x4*)(UT + ((tid + 512) >> 3) * 64 + (tid & 7) * 8);
    const int tt = wave >> 2, dvt = wave & 3, q = lane & 31, h = lane >> 5;
    const bf16* op = MO + (t0 + 32 * tt + q) * 512 + hh * 128 + 32 * dvt + 4 * h;
#pragma unroll
    for (int g4 = 0; g4 < 4; ++g4) L.mo[g4] = *(const u32x2*)(op + 8 * g4);
    L.lf = IGF[(t0 + lane) * 8 + 4 + hh]; L.ig = IGF[(t0 + lane) * 8 + hh]; L.mp = CHS[66]; L.np = CHS[128 + lane];
}
__device__ __forceinline__ void conv_acc8(const u32x4 (&u)[4], const LAS float* cwt, const LAS float* cbt, int c8, int nvalid  , float (&y)[8]) {
    const f32x4 b0 = *(const LAS f32x4*)(cbt + c8), b1 = *(const LAS f32x4*)(cbt + c8 + 4);
    y[0] = b0.x; y[1] = b0.y; y[2] = b0.z; y[3] = b0.w; y[4] = b1.x; y[5] = b1.y; y[6] = b1.z; y[7] = b1.w;
#pragma unroll
    for (int j = 0; j < 4; ++j) { const float msk = (j >= 4 - nvalid) ? 1.f : 0.f; const f32x4 w0 = *(const LAS f32x4*)(cwt + j * 128 + c8) * msk, w1 = *(const LAS f32x4*)(cwt + j * 128 + c8 + 4) * msk;
        y[0] += w0.x * bflo(u[j].x); y[1] += w0.y * bfhi(u[j].x); y[2] += w0.z * bflo(u[j].y); y[3] += w0.w * bfhi(u[j].y);
        y[4] += w1.x * bflo(u[j].z); y[5] += w1.y * bfhi(u[j].z); y[6] += w1.z * bflo(u[j].w); y[7] += w1.w * bfhi(u[j].w); }
#pragma unroll
    for (int e = 0; e < 8; ++e) y[e] = siluf_(y[e]);
}
__device__ __forceinline__ void phase4(const Args& a, LAS unsigned char* lds, int vcu, int G, int tid, int lane, int wave) {
    LAS short* QS = (LAS short*)lds;
    LAS short* QW = (LAS short*)(lds + 9216);
    LAS short* KS = (LAS short*)(lds + 18432);
    LAS short* VT = (LAS short*)(lds + 27648);
    LAS short* CT = (LAS short*)(lds + 46080);
    LAS float* alphav = (LAS float*)(lds + 64512); LAS float* ev = (LAS float*)(lds + 64768);
    LAS float* emtv = (LAS float*)(lds + 65280); LAS float* npv = (LAS float*)(lds + 65536); LAS float* red = (LAS float*)(lds + 65792);
    LAS float* cwt = (LAS float*)(lds + 67584);
    LAS float* cbt = (LAS float*)(lds + 69632);
    bf16* MO = (bf16*)(a.ws + WS_MO);
    const int tt = wave >> 2, dvt = wave & 3, q = lane & 31, h = lane >> 5, t = 32 * tt + q;
    int u = vcu; if (u >= 2048) return;
    int hh_tab = -1; f32x4 nwr[4];
    MoutLoad pre; mout_load(a, u, tid, lane, wave, pre);
    for (; u < 2048; u += G) {
        const int hh = u & 3, c = (u >> 2) & 63, b = u >> 8; const long t0 = (long)b * SEQ_ + c * 64;
        if (hh != hh_tab) {
            __syncthreads();
            { const int j = tid >> 7, cc = tid & 127; cwt[tid] = a.in[3][j * 512 + (cc < 64 ? hh * 64 + cc : 256 + hh * 64 + (cc - 64))]; }
            if (tid < 128) cbt[tid] = a.in[4][tid < 64 ? hh * 64 + tid : 256 + hh * 64 + (tid - 64)];
#pragma unroll
            for (int g4 = 0; g4 < 4; ++g4) nwr[g4] = *(const f32x4*)(a.in[8] + hh * 128 + 32 * dvt + 4 * h + 8 * g4);
            hh_tab = hh; __syncthreads();
        }
        const MoutLoad cur = pre;
        if (u + G < 2048) mout_load(a, u + G, tid, lane, wave, pre);
        float bc = cur.lf;
#pragma unroll
        for (int o = 1; o < 64; o <<= 1) { const float x = __shfl_up(bc, o); if (lane >= o) bc += x; }
        const float e = cur.ig - bc; float cm = e;
#pragma unroll
        for (int o = 1; o < 64; o <<= 1) { const float x = __shfl_up(cm, o); if (lane >= o) cm = fmaxf(cm, x); }
        const float mt = bc + fmaxf(cur.mp, cm);
        const float wa_l = __expf(bc + cur.mp - mt);
        if (wave == 0) { alphav[lane] = bc - mt; ev[lane] = e; emtv[lane] = __expf(-mt); npv[lane] = cur.np; }
        {   const int s = tid >> 3, ch = tid & 7;
            const float wa = __shfl(wa_l, s & 63);
            float y[8];
            const int nvalid = min(4, c * 64 + s + 1);
            conv_acc8(cur.q, cwt, cbt, ch * 8, nvalid, y);
            u32x4 w; w.x = pk2(y[0], y[1]); w.y = pk2(y[2], y[3]); w.z = pk2(y[4], y[5]); w.w = pk2(y[6], y[7]);
            *(LAS u32x4*)(QS + s * 72 + ch * 8) = w;
            w.x = pk2(y[0] * wa, y[1] * wa); w.y = pk2(y[2] * wa, y[3] * wa); w.z = pk2(y[4] * wa, y[5] * wa); w.w = pk2(y[6] * wa, y[7] * wa);
            *(LAS u32x4*)(QW + s * 72 + ch * 8) = w;
            conv_acc8(cur.k, cwt, cbt, 64 + ch * 8, nvalid, y);
            w.x = pk2(y[0] * 0.125f, y[1] * 0.125f); w.y = pk2(y[2] * 0.125f, y[3] * 0.125f); w.z = pk2(y[4] * 0.125f, y[5] * 0.125f); w.w = pk2(y[6] * 0.125f, y[7] * 0.125f);
            *(LAS u32x4*)(KS + s * 72 + ch * 8) = w;
            const u32x4 v0 = cur.v0, v1 = cur.v1;
            LAS short* vt = VT + (ch * 16) * 72 + s;
            vt[0 * 72] = (short)(v0.x & 0xffff); vt[1 * 72] = (short)(v0.x >> 16); vt[2 * 72] = (short)(v0.y & 0xffff); vt[3 * 72] = (short)(v0.y >> 16);
            vt[4 * 72] = (short)(v0.z & 0xffff); vt[5 * 72] = (short)(v0.z >> 16); vt[6 * 72] = (short)(v0.w & 0xffff); vt[7 * 72] = (short)(v0.w >> 16);
            vt[8 * 72] = (short)(v1.x & 0xffff); vt[9 * 72] = (short)(v1.x >> 16); vt[10 * 72] = (short)(v1.y & 0xffff); vt[11 * 72] = (short)(v1.y >> 16);
            vt[12 * 72] = (short)(v1.z & 0xffff); vt[13 * 72] = (short)(v1.z >> 16); vt[14 * 72] = (short)(v1.w & 0xffff); vt[15 * 72] = (short)(v1.w >> 16);
            *(LAS u32x4*)(CT + (tid >> 3) * 72 + (tid & 7) * 8) = cur.c0; *(LAS u32x4*)(CT + ((tid + 512) >> 3) * 72 + (tid & 7) * 8) = cur.c1;
        }
        __syncthreads();
        float hb[16];
        {
            bf16x8 qf[4];
#pragma unroll
            for (int ks = 0; ks < 4; ++ks) qf[ks] = *(const LAS bf16x8*)(QS + t * 72 + 16 * ks + 8 * h);
            f32x16 O = {}; float dsum = 0.f; const float al = alphav[t];
#pragma unroll
            for (int st = 0; st < 2; ++st) {
                if (st <= tt) {
                    f32x16 Sx = {};
#pragma unroll
                    for (int ks = 0; ks < 4; ++ks) { const bf16x8 kf = *(const LAS bf16x8*)(KS + (32 * st + q) * 72 + 16 * ks + 8 * h); Sx = __builtin_amdgcn_mfma_f32_32x32x16_bf16(kf, qf[ks], Sx, 0, 0, 0); }
#pragma unroll
                    for (int rg = 0; rg < 16; ++rg) { const int kr = (rg & 3) + 8 * (rg >> 2) + 4 * h; const int s = 32 * st + kr;
                        const float p = (s <= t) ? Sx[rg] * __expf(al + ev[s]) : 0.f; Sx[rg] = p; dsum += p; }
#pragma unroll
                    for (int ks = 0; ks < 2; ++ks) {
                        u32x4 pw; pw.x = pk2(Sx[8 * ks + 0], Sx[8 * ks + 1]); pw.y = pk2(Sx[8 * ks + 2], Sx[8 * ks + 3]); pw.z = pk2(Sx[8 * ks + 4], Sx[8 * ks + 5]); pw.w = pk2(Sx[8 * ks + 6], Sx[8 * ks + 7]);
                        const bf16x8 pf = __builtin_bit_cast(bf16x8, pw);
                        const LAS short* vp = VT + (32 * dvt + q) * 72 + 32 * st + 16 * ks + 4 * h;
                        const s16x4 lo = *(const LAS s16x4*)vp, hi = *(const LAS s16x4*)(vp + 8);
                        const bf16x8 vf = (bf16x8){lo[0], lo[1], lo[2], lo[3], hi[0], hi[1], hi[2], hi[3]};
                        O = __builtin_amdgcn_mfma_f32_32x32x16_bf16(vf, pf, O, 0, 0, 0); }
                } }
            float dn = 0.f;
#pragma unroll
            for (int ks = 0; ks < 4; ++ks) { const bf16x8 qw = *(const LAS bf16x8*)(QW + t * 72 + 16 * ks + 8 * h); const bf16x8 cf = *(const LAS bf16x8*)(CT + (32 * dvt + q) * 72 + 16 * ks + 8 * h);
                O = __builtin_amdgcn_mfma_f32_32x32x16_bf16(cf, qw, O, 0, 0, 0);
#pragma unroll
                for (int j = 0; j < 8; ++j) dn += bf2f(qw[j]) * npv[16 * ks + 8 * h + j]; }
            float den = dsum + dn; den += __shfl_xor(den, 32);
            const float inv = __builtin_amdgcn_rcpf(fmaxf(fabsf(den), emtv[t]));
            float ssq = 0.f;
#pragma unroll
            for (int rg = 0; rg < 16; ++rg) { hb[rg] = O[rg] * inv; ssq += hb[rg] * hb[rg]; }
            ssq += __shfl_xor(ssq, 32);
            if (h == 0) red[(tt * 4 + dvt) * 32 + q] = ssq;
        }
        __syncthreads();
        {   const float tot = (red[(tt * 4 + 0) * 32 + q] + red[(tt * 4 + 1) * 32 + q]) + (red[(tt * 4 + 2) * 32 + q] + red[(tt * 4 + 3) * 32 + q]);
            const float rn = 1.0f / sqrtf(tot * (1.f / 128.f) + EPS_);
            bf16* op = MO + (t0 + t) * 512 + hh * 128 + 32 * dvt + 4 * h;
#pragma unroll
            for (int g4 = 0; g4 < 4; ++g4) { const f32x4 w4 = nwr[g4]; const u32x2 mo = cur.mo[g4];
                u32x2 w; w.x = pk2(hb[4 * g4 + 0] * rn * w4.x * bflo(mo.x), hb[4 * g4 + 1] * rn * w4.y * bfhi(mo.x)); w.y = pk2(hb[4 * g4 + 2] * rn * w4.z * bflo(mo.y), hb[4 * g4 + 3] * rn * w4.w * bfhi(mo.y));
                *(u32x2*)(op + 8 * g4) = w; }
        }
    }
    __syncthreads();
}

__device__ __forceinline__ void phase7(const Args& a, LAS unsigned char* lds, int vcu, int G, int tid, int lane, int wave) {
    const float* x1 = a.out; const float* nw = a.in[12];
    bf16* H2 = (bf16*)(a.ws + WS_XN); float* RSTD2 = (float*)(a.ws + WS_RSTD2); const bf16* WRg = (const bf16*)(a.ws + WS_WR);
    int* LIST = (int*)(a.ws + WS_LIST); float* SW = (float*)(a.ws + WS_SW); i32x4* TOKI = (i32x4*)(a.ws + WS_TOKI);
    unsigned* gcnt = (unsigned*)(a.ws + WS_CTL) + CW_GCNT;
    LAS short* WR = (LAS short*)lds;
    LAS float* lg = (LAS float*)(lds + 99072);
    LAS float* rsl = (LAS float*)(lds + 99072 + 24576);
    LAS int* hist = (LAS int*)(lds + 99072 + 24576 + 512);
    LAS int* basev = hist + 32;
    for (int p = tid; p < 48 * 128; p += 512) { const int n = p >> 7, cc = p & 127; *(LAS u32x4*)(WR + n * 1032 + cc * 8) = *(const u32x4*)(WRg + n * 1024 + cc * 8); }
    __syncthreads();
    const int r = lane & 15, g = lane >> 4;
    for (int it = vcu; it < T_ / 128; it += G) {
        if (tid < 32) hist[tid] = 0;
        __syncthreads();
        const int row = it * 128 + wave * 16 + r;
        f32x4 acc[3]; acc[0] = (f32x4){0.f, 0.f, 0.f, 0.f}; acc[1] = acc[0]; acc[2] = acc[0];
        float ssq = 0.f;
        const float* xr = x1 + (size_t)row * 1024 + 8 * g; bf16* hr = H2 + (size_t)row * 1024 + 8 * g;
#pragma unroll 4
        for (int s = 0; s < 32; ++s) {
            const f32x4 xa = *(const f32x4*)(xr + 32 * s), xb = *(const f32x4*)(xr + 32 * s + 4);
            const f32x4 wa = *(const f32x4*)(nw + 32 * s + 8 * g), wb = *(const f32x4*)(nw + 32 * s + 8 * g + 4);
            ssq += (xa.x * xa.x + xa.y * xa.y) + (xa.z * xa.z + xa.w * xa.w) + (xb.x * xb.x + xb.y * xb.y) + (xb.z * xb.z + xb.w * xb.w);
            u32x4 w; w.x = pk2(xa.x * wa.x, xa.y * wa.y); w.y = pk2(xa.z * wa.z, xa.w * wa.w); w.z = pk2(xb.x * wb.x, xb.y * wb.y); w.w = pk2(xb.z * wb.z, xb.w * wb.w);
            *(u32x4*)(hr + 32 * s) = w;
            const bf16x8 af = __builtin_bit_cast(bf16x8, w);
#pragma unroll
            for (int nt = 0; nt < 3; ++nt) { const bf16x8 bfr = *(const LAS bf16x8*)(WR + (16 * nt + r) * 1032 + 32 * s + 8 * g); acc[nt] = __builtin_amdgcn_mfma_f32_16x16x32_bf16(af, bfr, acc[nt], 0, 0, 0); }
        }
        ssq += __shfl_xor(ssq, 16); ssq += __shfl_xor(ssq, 32);
        const float rstd = 1.0f / sqrtf(ssq * (1.f / 1024.f) + EPS_);
        if (g == 0) { RSTD2[row] = rstd; rsl[wave * 16 + r] = rstd; }
#pragma unroll
        for (int nt = 0; nt < 3; ++nt)
#pragma unroll
            for (int rg = 0; rg < 4; ++rg) lg[(wave * 16 + 4 * g + rg) * 48 + 16 * nt + r] = acc[nt][rg];
        LDS_WAIT(); asm volatile("" ::: "memory");
        int e1 = 0, e2 = 0, lr1 = 0, lr2 = 0; float w1 = 0.f, w2 = 0.f;
        if (lane < 16) {
            const LAS float* lp = lg + (wave * 16 + lane) * 48; const float rs = rsl[wave * 16 + lane];
            float gl[4]; int gi = 0; float gm;
#pragma unroll
            for (int k = 0; k < 4; ++k) gl[k] = lp[k] * rs + a.in[14][k];
            gm = gl[0];
#pragma unroll
            for (int k = 1; k < 4; ++k) if (gl[k] > gm) { gm = gl[k]; gi = k; }
            float gs = 0.f;
#pragma unroll
            for (int k = 0; k < 4; ++k) gs += expf(gl[k] - gm);
            const float gp = 1.0f / gs;
            float v1 = -INFINITY, v2 = -INFINITY; int j1 = 0, j2 = 0;
#pragma unroll
            for (int j = 0; j < 8; ++j) { const float el = lp[4 + 8 * gi + j] * rs + a.in[16][8 * gi + j];
                if (el > v1) { v2 = v1; j2 = j1; v1 = el; j1 = j; } else if (el > v2) { v2 = el; j2 = j; } }
            const float ex = expf(v2 - v1); w1 = gp / (1.0f + ex); w2 = gp * ex / (1.0f + ex);
            e1 = 8 * gi + j1; e2 = 8 * gi + j2;
            lr1 = atomicAdd((int*)(hist + e1), 1); lr2 = atomicAdd((int*)(hist + e2), 1);
        }
        __syncthreads();
        if (tid < 32) { const int n = hist[tid]; basev[tid] = n > 0 ? (int)atomicAdd(gcnt + tid, (unsigned)n) : 0; }
        __syncthreads();
        if (lane < 16) { const int tok = it * 128 + wave * 16 + lane; const int r1 = basev[e1] + lr1, r2 = basev[e2] + lr2;
            LIST[(size_t)e1 * T_ + r1] = tok; LIST[(size_t)e2 * T_ + r2] = tok; SW[(size_t)e1 * T_ + r1] = w1; SW[(size_t)e2 * T_ + r2] = w2;
            TOKI[tok] = (i32x4){e1, r1, e2, r2}; }
        __syncthreads();
    }
}

__device__ __forceinline__ void moe_tables(const Args& a, LAS unsigned char* lds, int tid) {
    LAS int* cum = (LAS int*)(lds + TAB_OFF); LAS int* cnt = cum + 64;
    const unsigned* gcnt = (const unsigned*)(a.ws + WS_CTL) + CW_GCNT;
    if (tid == 0) { int c = 0; for (int e = 0; e < NEXP; ++e) { const int n = (int)__hip_atomic_load(gcnt + e, __ATOMIC_RELAXED, __HIP_MEMORY_SCOPE_AGENT); cnt[e] = n; cum[e] = c; c += (n + 255) >> 8; } cum[NEXP] = c; }
    __syncthreads();
}

__device__ __forceinline__ void phase10(const Args& a, LAS unsigned char* lds, int vcu, int G, int lane, int wave) {
    const LAS int* cum = (const LAS int*)(lds + TAB_OFF);
    float* out = a.out; const bf16* YS = (const bf16*)(a.ws + WS_YS); const i32x4* TOKI = (const i32x4*)(a.ws + WS_TOKI); const float* nw = a.in[20];
    f32x4 nwv[4];
#pragma unroll
    for (int j = 0; j < 4; ++j) nwv[j] = ((const f32x4*)nw)[lane + 64 * j];
    const int gw = vcu * NWAVES + wave, NGW = G * NWAVES;
    for (int m = gw; m < T_; m += NGW) {
        const i32x4 ti = TOKI[m];
        const size_t s1 = (size_t)cum[ti.x] * 256 + ti.y, s2 = (size_t)cum[ti.z] * 256 + ti.w;
        f32x4* xr = (f32x4*)(out + (size_t)m * 1024) + lane;
        const u32x2* y1 = (const u32x2*)(YS + s1 * 1024) + lane; const u32x2* y2 = (const u32x2*)(YS + s2 * 1024) + lane;
        f32x4 v[4]; float s = 0.f;
#pragma unroll
        for (int j = 0; j < 4; ++j) { v[j] = xr[64 * j]; const u32x2 p1 = y1[64 * j], p2 = y2[64 * j];
            v[j].x += bflo(p1.x) + bflo(p2.x); v[j].y += bfhi(p1.x) + bfhi(p2.x); v[j].z += bflo(p1.y) + bflo(p2.y); v[j].w += bfhi(p1.y) + bfhi(p2.y);
            s += (v[j].x * v[j].x + v[j].y * v[j].y) + (v[j].z * v[j].z + v[j].w * v[j].w); }
        const float rstd = 1.0f / sqrtf(wave_sum(s) * (1.f / 1024.f) + EPS_);
#pragma unroll
        for (int j = 0; j < 4; ++j) xr[64 * j] = v[j] * rstd * nwv[j];
    }
}

__global__ void __launch_bounds__(NWAVES * 64, 2) mega_fwd(Args args) {
    extern __shared__ __attribute__((aligned(16))) unsigned char lds_raw[];
    LAS unsigned char* lds = (LAS unsigned char*)lds_raw;
    const int tid = threadIdx.x, lane = tid & 63, wave = __builtin_amdgcn_readfirstlane(tid >> 6);
    const int G = gridDim.x, bx = blockIdx.x;
    const int vcu = (G % 8 == 0) ? (bx % 8) * (G / 8) + bx / 8 : bx;
    unsigned char* ws = args.ws;
    unsigned* ctl = (unsigned*)(ws + WS_CTL);
    for (int u = tid; u < (LDS_BYTES - LDSCTL_OFF) / 4; u += NWAVES * 64) ((LAS unsigned*)(lds + LDSCTL_OFF))[u] = 0u;
    __syncthreads();
    const int lo = args.ph_lo, hi = args.ph_hi;
    const bool multi = (hi - lo) > 1;
    XcdBarrier bar; bar.bar = ctl + CW_BAR; bar.x = 0; bar.st = (volatile LAS unsigned*)(lds + MISC_OFF) + 8;
    if (multi) bar = xcd_barrier_post(ctl + CW_BAR, (volatile LAS unsigned*)(lds + MISC_OFF) + 8);
#define IN(k) (((PH_MASK >> (k)) & 1) && lo <= (k) && (k) < hi)
#if PROBE_PH >= 0 && PROBE_PH < 100
    unsigned long long tp0 = 0, tp1 = 0;
#define SEAM(k) do { if (IN(k) && IN((k) + 1)) xcd_barrier(bar); if ((k) == PROBE_PH) tp1 = __builtin_amdgcn_s_memrealtime(); if ((k) + 1 == PROBE_PH) tp0 = __builtin_amdgcn_s_memrealtime(); } while (0)
    if (PROBE_PH == 0) tp0 = __builtin_amdgcn_s_memrealtime();
#else
#define SEAM(k) do { if (IN(k) && IN((k) + 1)) xcd_barrier(bar); } while (0)
#endif

    if (IN(0)) { phase0(args, lds, vcu, G, tid, lane, wave); SEAM(0); }

    if (IN(1)) {
        DenseSched S{(const char*)(ws + WS_XN), (const char*)(ws + WS_WIN), 1024, 1024, T_ / 256, NIN / 256, G, bx};
        EpiProj E{(bf16*)(ws + WS_ATT), (bf16*)(ws + WS_MQK), (bf16*)(ws + WS_MV), (bf16*)(ws + WS_MO), (bf16*)(ws + WS_GATES)};
        g8::gemm_phase<EpiProj, DenseSched, true>(lds, 1024, 1024, S, E);
        SEAM(1);
    }
    if (IN(2)) {
        for (int u = vcu; u < NB_ * 32 * 2; u += G) attn_unit(args, lds, u >> 6, (u >> 1) & 31, u & 1, tid, lane, wave);
        for (int u = vcu; u < 2048; u += G) mprep_unit(args, lds, u, tid, lane, wave);
        SEAM(2);
    }
    if (IN(3)) { phase3(args, G, tid); SEAM(3); }
    if (IN(4)) { phase4(args, lds, vcu, G, tid, lane, wave); SEAM(4); }
    if (IN(5)) {
        MixSched S{(const char*)(ws + WS_ATT), (const char*)(ws + WS_MO), (const char*)(ws + WS_WAO), (const char*)(ws + WS_WMO), 768, 512, T_ / 256, 4, G, bx};
        EpiMix E{(bf16*)(ws + WS_GATES)};
        g8::gemm_phase<EpiMix, MixSched, true>(lds, 512, 512, S, E);
        SEAM(5);
    }
    if (IN(6)) {
        DenseSched S{(const char*)(ws + WS_GATES), (const char*)(ws + WS_WOUT), 2048, 1024, T_ / 256, 4, G, bx};
        EpiOut E{args.in[0], args.out};
        g8::gemm_phase<EpiOut, DenseSched, true>(lds, 1024, 1024, S, E);
        SEAM(6);
    }
    if (IN(7)) { phase7(args, lds, vcu, G, tid, lane, wave); SEAM(7); }
    if (IN(8) || IN(9) || IN(10)) moe_tables(args, lds, tid);
    if (IN(8)) {
        const LAS int* cum = (const LAS int*)(lds + TAB_OFF); const LAS int* cnt = cum + 64;
        MoeSched S{cum, cnt, (const char*)(ws + WS_XN), (const char*)(ws + WS_WGU), (const int*)(ws + WS_LIST), G, vcu, true, 1024, 1024};
        EpiG1 E{(bf16*)(ws + WS_HID), (const float*)(ws + WS_RSTD2), (const int*)(ws + WS_LIST), cnt};
        g8::gemm_phase<EpiG1, MoeSched, true>(lds, 1024, 1024, S, E);
        SEAM(8);
    }
    if (IN(9)) {
        const LAS int* cum = (const LAS int*)(lds + TAB_OFF); const LAS int* cnt = cum + 64;
        MoeSched S{cum, cnt, (const char*)(ws + WS_HID), (const char*)(ws + WS_WDN), (const int*)(ws + WS_LIST), G, vcu, false, 512, 1024};
        EpiG2 E{(bf16*)(ws + WS_YS), (const float*)(ws + WS_SW), cnt};
        g8::gemm_phase<EpiG2, MoeSched, true>(lds, 512, 512, S, E);
        SEAM(9);
    }
    if (IN(10)) phase10(args, lds, vcu, G, lane, wave);
#if PROBE_PH >= 0 && PROBE_PH < 100
    if (PROBE_PH == 10) { asm volatile("s_waitcnt vmcnt(0)" ::: "memory"); __syncthreads(); tp1 = __builtin_amdgcn_s_memrealtime(); }
    if (bx == 0 && tid == 0) { const unsigned long long d = (tp1 - tp0) * PROBE_AMP; const unsigned long long te = __builtin_amdgcn_s_memrealtime(); while (__builtin_amdgcn_s_memrealtime() - te < d) __builtin_amdgcn_s_sleep(8); }
#endif
#undef IN
#undef SEAM
}

extern "C" void kernel_launch(void* const* d_in, const int* in_sizes, int n_in, void* d_out, int out_size, void* d_ws, size_t ws_size, hipStream_t stream) {
    static int grid = 0;
    if (grid == 0) {
        if (n_in != 21 || in_sizes[0] != T_ * D_ || out_size != T_ * D_ || ws_size < WS_END) { fprintf(stderr, "kernel_launch: unexpected shapes / workspace (n_in %d, ws %zu, need %zu)\n", n_in, ws_size, (size_t)WS_END); grid = -1; return; }
        int dev = 0, cus = 0, per_cu = 0;
        if (hipGetDevice(&dev) != hipSuccess || hipDeviceGetAttribute(&cus, hipDeviceAttributeMultiprocessorCount, dev) != hipSuccess) { grid = -1; return; }
        if (hipFuncSetAttribute((const void*)mega_fwd, hipFuncAttributeMaxDynamicSharedMemorySize, LDS_BYTES) != hipSuccess) { fprintf(stderr, "kernel_launch: hipFuncSetAttribute failed\n"); grid = -1; return; }
        if (hipOccupancyMaxActiveBlocksPerMultiprocessor(&per_cu, (const void*)mega_fwd, NWAVES * 64, LDS_BYTES) != hipSuccess || per_cu < 1) { fprintf(stderr, "kernel_launch: occupancy query reports %d blocks per CU\n", per_cu); (void)hipGetLastError(); grid = -1; return; }
        grid = cus;
    }
    if (grid < 0) return;
    (void)hipMemsetAsync((char*)d_ws + WS_CTL, 0, CTL_ZERO_BYTES, stream);
    Args a{};
    for (int i = 0; i < 21; ++i) a.in[i] = (const float*)d_in[i];
    a.out = (float*)d_out; a.ws = (unsigned char*)d_ws;
#if MK_FUSED
    a.ph_lo = 0; a.ph_hi = NPH;
    void* kargs[] = {&a};
    hipError_t e = hipLaunchCooperativeKernel((const void*)mega_fwd, dim3(grid), dim3(NWAVES * 64), kargs, LDS_BYTES, stream);
    if (e != hipSuccess) fprintf(stderr, "kernel_launch: cooperative launch failed: %s (grid %d)\n", hipGetErrorString(e), grid);
#else
    for (int p = 0; p < NPH; ++p) { a.ph_lo = p; a.ph_hi = p + 1; hipLaunchKernelGGL(mega_fwd, dim3(grid), dim3(NWAVES * 64), LDS_BYTES, stream, a); }
#endif
}
```

```cpp
#include <hip/hip_runtime.h>
#include <cstdio>
#include <cstdint>

#define LAS __attribute__((address_space(3)))
#define GAS __attribute__((address_space(1)))
typedef unsigned short bf16;
typedef short bf16x8 __attribute__((ext_vector_type(8)));
typedef short s16x4 __attribute__((ext_vector_type(4)));
typedef float f32x4 __attribute__((ext_vector_type(4)));
typedef float f32x16 __attribute__((ext_vector_type(16)));
typedef unsigned u32x4 __attribute__((ext_vector_type(4)));
typedef unsigned u32x2 __attribute__((ext_vector_type(2)));
typedef int i32x4 __attribute__((ext_vector_type(4)));
typedef float f32x2_t __attribute__((ext_vector_type(2)));
typedef __bf16 bf16x2_t __attribute__((ext_vector_type(2)));

#ifndef PROBE_PH
#define PROBE_PH -1
#endif
#ifndef PROBE_AMP
#define PROBE_AMP 4
#endif
#ifndef PH_MASK
#define PH_MASK 0x7ff
#endif
#ifndef MK_FUSED
#define MK_FUSED 1
#endif

constexpr int T_ = 32768, D_ = 1024, SEQ_ = 4096, NB_ = 8;
constexpr int NIN = 4352;
constexpr int NEXP = 32;
constexpr float EPS_ = 1e-6f;
constexpr float LOG2E = 1.4426950408889634f;
constexpr float QSCALE = 0.125f * LOG2E;
constexpr int NWAVES = 8;
constexpr int NPH = 11;

constexpr size_t MiB = 1u << 20;
constexpr size_t WS_CTL = 0, CTL_ZERO_BYTES = 1 * MiB;
constexpr size_t WS_IGF = 1 * MiB;
constexpr size_t WS_CHS = 2 * MiB;
constexpr size_t WS_TOKI = 4 * MiB;
constexpr size_t WS_RSTD2 = 4 * MiB + 512 * 1024;
constexpr size_t WS_WR = 4 * MiB + 768 * 1024;
constexpr size_t WS_LIST = 5 * MiB;
constexpr size_t WS_SW = 9 * MiB;
constexpr size_t WS_WIN = 13 * MiB;
constexpr size_t WS_WAO = 22 * MiB, WS_WMO = 23 * MiB, WS_WOUT = 24 * MiB;
constexpr size_t WS_WGU = 26 * MiB;
constexpr size_t WS_WDN = 90 * MiB;
constexpr size_t WS_XN = 122 * MiB;
constexpr size_t WS_ATT = 186 * MiB;
constexpr size_t WS_MQK = 234 * MiB;
constexpr size_t WS_MV = 266 * MiB;
constexpr size_t WS_MO = 298 * MiB;
constexpr size_t WS_GATES = 330 * MiB;
constexpr size_t WS_HID = 186 * MiB;
constexpr size_t WS_YS = 258 * MiB;
constexpr size_t WS_END = 458 * MiB;
constexpr int CW_TMO = 0, CW_BAR = 4096, CW_GCNT = 16384;

constexpr int RING_BYTES = 131072;
constexpr int LDS_BYTES = 163840;
constexpr int LDSCTL_OFF = LDS_BYTES - 1024, MISC_OFF = LDSCTL_OFF;
constexpr int TAB_OFF = LDSCTL_OFF + 256;
constexpr int STG_OFF = 7 * 16384;
constexpr int STG_ROWB = 528, STG_BUF = 32 * STG_ROWB;

__device__ __forceinline__ unsigned pk2(float lo, float hi) { f32x2_t v = {lo, hi}; bf16x2_t b = __builtin_convertvector(v, bf16x2_t); return __builtin_bit_cast(unsigned, b); }
__device__ __forceinline__ float bflo(unsigned u) { return __uint_as_float(u << 16); }
__device__ __forceinline__ float bfhi(unsigned u) { return __uint_as_float(u & 0xffff0000u); }
__device__ __forceinline__ float bf2f(short s) { return __uint_as_float(((unsigned)(unsigned short)s) << 16); }
__device__ __forceinline__ float wave_sum(float v) {
#pragma unroll
    for (int o = 1; o < 64; o <<= 1) v += __shfl_xor(v, o);
    return v;
}
__device__ __forceinline__ float wave_max(float v) {
#pragma unroll
    for (int o = 1; o < 64; o <<= 1) v = fmaxf(v, __shfl_xor(v, o));
    return v;
}
__device__ __forceinline__ float sigmoidf_(float v) { return __builtin_amdgcn_rcpf(1.0f + __expf(-v)); }
__device__ __forceinline__ float siluf_(float v) { return v * __builtin_amdgcn_rcpf(1.0f + __expf(-v)); }
#define LDS_WAIT() asm volatile("s_waitcnt lgkmcnt(0)" ::: "memory")
#ifndef WT_STORES
#define WT_STORES 0
#endif
__device__ __forceinline__ void st16(void* p, const u32x4& v) {
#if WT_STORES
    asm volatile("global_store_dwordx4 %0, %1, off sc1\n\ts_nop 1" :: "v"(p), "v"(v) : "memory");
#else
    *(u32x4*)p = v;
#endif
}
__device__ __forceinline__ void st16f(void* p, const f32x4& v) { st16(p, __builtin_bit_cast(u32x4, v)); }
__device__ __forceinline__ void st8(void* p, const u32x2& v) {
#if WT_STORES
    asm volatile("global_store_dwordx2 %0, %1, off sc1\n\ts_nop 1" :: "v"(p), "v"(v) : "memory");
#else
    *(u32x2*)p = v;
#endif
}

namespace g8 {
constexpr int BM = 256, BK = 64, HALF = 128, HTB = HALF * BK * 2, STAGE_BYTES = 8 * HTB, NXCD = 8, WGM = 8;
__host__ __device__ __forceinline__ int lds_byte(int r, int c) { const int st = (r >> 4) * 2 + (c >> 5), rr = r & 15, cc = c & 31, ob = rr * 64 + cc * 2; return st * 1024 + (ob ^ (((ob >> 9) & 1) << 5)); }
__host__ __device__ __forceinline__ void stage_rc(int b, int& R, int& C) { const int st = b / 1024, sb = b % 1024, swz = sb ^ (((sb >> 9) & 1) << 5); R = (st >> 1) * 16 + swz / 64; C = (st & 1) * 32 + (swz % 64) / 2; }
__host__ __device__ __forceinline__ int perm32(int rho) { const int n = rho >> 4, i = rho & 15; return 8 * (i >> 2) + 4 * n + (i & 3); }

struct GU { const char* A; const char* B; int pm, pn, x0, x1; };

__device__ __forceinline__ void tile_of(int L, int nM, int nN, int& pm, int& pn) {
    const int nwg = nM * nN; int wgid = L; { const int q = nwg / NXCD, r = nwg % NXCD, xcd = wgid % NXCD, off = wgid / NXCD; wgid = (xcd < r ? xcd * (q + 1) : r * (q + 1) + (xcd - r) * q) + off; }
    const int nig = WGM * nN, gid = wgid / nig, fm = gid * WGM, gsz = (nM - fm) < WGM ? (nM - fm) : WGM;
    pm = fm + ((wgid % nig) % gsz); pn = (wgid % nig) / gsz;
}

#if PROBE_PH == 310
#endif
template <class Epi, class Sched, bool ALIGN_EPI>
__device__ __forceinline__ void gemm_phase(LAS unsigned char* lds, const int K, const int ldb, const Sched& S, const Epi& E) {
    const int tid = threadIdx.x, wid = __builtin_amdgcn_readfirstlane(tid >> 6), lane = tid & 63, wr = wid >> 2, wc = wid & 3, fr = lane & 15, fq = lane >> 4;
    const int nt = K / BK;
    int Rr[2], Cc[2]; unsigned voffB[2];
#pragma unroll
    for (int i = 0; i < 2; ++i) { int R, C; stage_rc(tid * 16 + i * 8192, R, C); Rr[i] = R; Cc[i] = C; const int Rb = Epi::PERM ? ((R & ~31) + perm32(R & 31)) : R; voffB[i] = (unsigned)(Rb * ldb + C) * 2u; }
    const size_t kstep = (size_t)(BK * 2);
    const size_t hstepB = (size_t)HALF * ldb * 2;
    const unsigned ldsw = (unsigned)wid * 1024u;
    const int aoff = lds_byte(wr * 64 + fr, fq * 8), boff = lds_byte(wc * 32 + fr, fq * 8);
#define G8_SA(b, h) ((((b) * 2 + (h)) == 3 ? 7 : ((b) * 2 + (h))) * HTB)
#define G8_SB(b, h) ((3 + (b) * 2 + (h)) * HTB)
#define G8_STAGE(bufoff, gbase, voff) do { _Pragma("unroll") for (int _i = 0; _i < 2; ++_i) \
        __builtin_amdgcn_global_load_lds((const unsigned*)((const char*)(gbase) + (voff)[_i]), (LAS unsigned*)(lds + (bufoff) + ldsw + _i * 8192), 16, 0, 0); } while (0)
#define G8_LDA(dst, b, h) do { _Pragma("unroll") for (int m = 0; m < 4; ++m) _Pragma("unroll") for (int k = 0; k < 2; ++k) dst[m][k] = *(const LAS bf16x8*)(lds + G8_SA(b, h) + aoff + m * 2048 + k * 1024); } while (0)
#define G8_LDB(dst, b, h) do { _Pragma("unroll") for (int n = 0; n < 2; ++n) _Pragma("unroll") for (int k = 0; k < 2; ++k) dst[n][k] = *(const LAS bf16x8*)(lds + G8_SB(b, h) + boff + n * 2048 + k * 1024); } while (0)
#define G8_MMA(ai, bj, At, Bt) do { __builtin_amdgcn_s_setprio(1); _Pragma("unroll") for (int m = 0; m < 4; ++m) _Pragma("unroll") for (int n = 0; n < 2; ++n) _Pragma("unroll") for (int k = 0; k < 2; ++k) \
        acc[ai][bj][m][n] = __builtin_amdgcn_mfma_f32_16x16x32_bf16(Bt[n][k], At[m][k], acc[ai][bj][m][n], 0, 0, 0); __builtin_amdgcn_s_setprio(0); } while (0)
#define G8_WAIT_V(n) asm volatile("s_waitcnt vmcnt(" #n ")" ::: "memory")
#define G8_WAIT_L(n) asm volatile("s_waitcnt lgkmcnt(" #n ")" ::: "memory")
#define G8_BAR __builtin_amdgcn_s_barrier()
#define G8_SCHED __builtin_amdgcn_sched_barrier(0)
#if PROBE_PH == 310
    unsigned long long g8_epi_time = 0;
#endif
    GU cur, nxt; int ui = 0;
    if (!S.next(0, cur)) return;
    f32x4 acc[2][2][4][2];
#pragma unroll
    for (int a = 0; a < 2; ++a)
#pragma unroll
        for (int b = 0; b < 2; ++b)
#pragma unroll
            for (int m = 0; m < 4; ++m)
#pragma unroll
                for (int n = 0; n < 2; ++n) acc[a][b][m][n] = (f32x4){0.f, 0.f, 0.f, 0.f};
    bf16x8 At[4][2], B0[2][2], B1[2][2];
    unsigned vc0[2], vc1[2], vn0[2], vn1[2];
    S.aoff(cur, Rr, Cc, vc0, vc1);
    const char* cA = cur.A; const char* cB = cur.B;
    G8_STAGE(G8_SB(0, 0), cB, voffB); G8_STAGE(G8_SB(0, 1), cB + hstepB, voffB); G8_STAGE(G8_SA(0, 0), cA, vc0); G8_STAGE(G8_SA(0, 1), cA, vc1);
    if (wr == 1) G8_BAR;
    G8_WAIT_V(2); G8_BAR;
    G8_STAGE(G8_SB(1, 0), cB + kstep, voffB); G8_STAGE(G8_SA(1, 0), cA + kstep, vc0); G8_STAGE(G8_SB(1, 1), cB + hstepB + kstep, voffB);
    G8_WAIT_V(6); G8_BAR;
    for (;;) {
        const bool has_next = S.next(ui + 1, nxt);
        const char* nA = has_next ? nxt.A : cA; const char* nB = has_next ? nxt.B : cB;
        if (has_next) S.aoff(nxt, Rr, Cc, vn0, vn1); else { vn0[0] = vc0[0]; vn0[1] = vc0[1]; vn1[0] = vc1[0]; vn1[1] = vc1[1]; }
        for (int t = 0; t < nt; t += 2) {
            const bool last = (t == nt - 2);
            const char* a1 = cA + (size_t)(t + 1) * kstep;
            const char* a2 = last ? nA : cA + (size_t)(t + 2) * kstep; const char* b2 = last ? nB : cB + (size_t)(t + 2) * kstep;
            const char* a3 = a2 + kstep; const char* b3 = b2 + kstep;
            unsigned w0[2], w1[2]; w0[0] = last ? vn0[0] : vc0[0]; w0[1] = last ? vn0[1] : vc0[1]; w1[0] = last ? vn1[0] : vc1[0]; w1[1] = last ? vn1[1] : vc1[1];
            G8_LDB(B0, 0, 0); G8_LDB(B1, 0, 1); G8_SCHED; G8_LDA(At, 0, 0); G8_STAGE(G8_SA(1, 1), a1, vc1);
            G8_WAIT_V(8); G8_WAIT_L(0); G8_BAR; G8_MMA(0, 0, At, B0); G8_MMA(0, 1, At, B1); G8_BAR; G8_SCHED;
            G8_LDA(At, 0, 1); G8_STAGE(G8_SB(0, 0), b2, voffB); G8_STAGE(G8_SB(0, 1), b2 + hstepB, voffB); G8_STAGE(G8_SA(0, 0), a2, w0);
            G8_WAIT_V(8); G8_WAIT_L(0); G8_BAR; G8_MMA(1, 0, At, B0); G8_MMA(1, 1, At, B1); G8_BAR; G8_SCHED;
            G8_LDB(B0, 1, 0); G8_LDB(B1, 1, 1); G8_SCHED; G8_LDA(At, 1, 0); G8_STAGE(G8_SA(0, 1), a2, w1);
            G8_WAIT_V(8); G8_WAIT_L(0); G8_BAR; G8_MMA(0, 0, At, B0); G8_MMA(0, 1, At, B1); G8_BAR; G8_SCHED;
            G8_LDA(At, 1, 1); G8_STAGE(G8_SB(1, 0), b3, voffB); G8_STAGE(G8_SB(1, 1), b3 + hstepB, voffB); G8_STAGE(G8_SA(1, 0), a3, w0);
            G8_WAIT_V(8); G8_WAIT_L(0); G8_BAR; G8_MMA(1, 0, At, B0); G8_MMA(1, 1, At, B1); G8_BAR; G8_SCHED;
        }
#if PROBE_PH == 310
        const unsigned long long _te0 = __builtin_amdgcn_s_memrealtime();
#endif
        if constexpr (ALIGN_EPI) { if (wr == 0) G8_BAR; }
        E(acc, cur, wr, wc, fr, fq, lds);
#if PROBE_PH == 310
        if (Epi::PERM && sizeof(Epi) == sizeof(void*) * 5) g8_epi_time += __builtin_amdgcn_s_memrealtime() - _te0;
#endif
        if (!E.keep(cur)) {
#pragma unroll
            for (int a = 0; a < 2; ++a)
#pragma unroll
                for (int b = 0; b < 2; ++b)
#pragma unroll
                    for (int m = 0; m < 4; ++m)
#pragma unroll
                        for (int n = 0; n < 2; ++n) acc[a][b][m][n] = (f32x4){0.f, 0.f, 0.f, 0.f};
        }
        if (!has_next) break;
        cur = nxt; cA = nA; cB = nB; ++ui;
        vc0[0] = vn0[0]; vc0[1] = vn0[1]; vc1[0] = vn1[0]; vc1[1] = vn1[1];
        if constexpr (ALIGN_EPI) { if (wr == 1) G8_BAR; }
    }
    G8_WAIT_V(0);
    if constexpr (!ALIGN_EPI) { if (wr == 0) G8_BAR; }
    G8_BAR;
#if PROBE_PH == 310
    if (Epi::PERM && sizeof(Epi) == sizeof(void*) * 5 && blockIdx.x == 0 && tid == 0) { const unsigned long long d = g8_epi_time * PROBE_AMP; const unsigned long long te = __builtin_amdgcn_s_memrealtime(); while (__builtin_amdgcn_s_memrealtime() - te < d) __builtin_amdgcn_s_sleep(8); }
#endif
#undef G8_SA
#undef G8_SB
#undef G8_STAGE
#undef G8_LDA
#undef G8_LDB
#undef G8_MMA
#undef G8_WAIT_V
#undef G8_WAIT_L
#undef G8_BAR
#undef G8_SCHED
}
}

struct DenseSched {
    const char* A; const char* B; int lda, ldb, nM, nN, G, c;
    __device__ __forceinline__ bool next(int i, g8::GU& u) const {
        const long L = (long)i * G + c; if (L >= (long)nM * nN) return false;
        g8::tile_of((int)L, nM, nN, u.pm, u.pn); u.x0 = 0; u.x1 = 0;
        u.A = A + (size_t)u.pm * 256 * lda * 2; u.B = B + (size_t)u.pn * 256 * ldb * 2; return true;
    }
    __device__ __forceinline__ void aoff(const g8::GU&, const int (&R)[2], const int (&C)[2], unsigned (&v0)[2], unsigned (&v1)[2]) const {
#pragma unroll
        for (int i = 0; i < 2; ++i) { v0[i] = (unsigned)(R[i] * lda + C[i]) * 2u; v1[i] = (unsigned)((R[i] + 128) * lda + C[i]) * 2u; }
    }
};
struct MixSched {
    const char* A0; const char* A1; const char* B0; const char* B1; int lda0, lda1, nM, nN, G, c;
    __device__ __forceinline__ bool next(int i, g8::GU& u) const {
        const long L = (long)(i >> 1) * G + c; if (L >= (long)nM * nN) return false;
        g8::tile_of((int)L, nM, nN, u.pm, u.pn); const int part = i & 1; u.x0 = part; u.x1 = 0;
        u.A = (part ? A1 : A0) + (size_t)u.pm * 256 * (part ? lda1 : lda0) * 2; u.B = (part ? B1 : B0) + (size_t)u.pn * 256 * 512 * 2; return true;
    }
    __device__ __forceinline__ void aoff(const g8::GU& u, const int (&R)[2], const int (&C)[2], unsigned (&v0)[2], unsigned (&v1)[2]) const {
        const int lda = u.x0 ? lda1 : lda0;
#pragma unroll
        for (int i = 0; i < 2; ++i) { v0[i] = (unsigned)(R[i] * lda + C[i]) * 2u; v1[i] = (unsigned)((R[i] + 128) * lda + C[i]) * 2u; }
    }
};
struct MoeSched {
    const LAS int* cum; const LAS int* cnt; const char* A; const char* B; const int* list; int G, c; bool gather; int ldb, nbrows;
    __device__ __forceinline__ bool next(int i, g8::GU& u) const {
        const long L = (long)i * G + c; const int total = cum[NEXP] * 4; if (L >= total) return false;
        const int blk = (int)L >> 2; u.pn = (int)L & 3;
        int e = 0;
#pragma unroll 1
        for (int k = 16; k >= 1; k >>= 1) if (cum[e + k] <= blk) e += k;
        u.x0 = e; u.x1 = blk - cum[e]; u.pm = blk;
        u.A = gather ? A : A + (size_t)blk * 256 * 512 * 2;
        u.B = B + ((size_t)e * nbrows + (size_t)u.pn * 256) * ldb * 2; return true;
    }
    __device__ __forceinline__ void aoff(const g8::GU& u, const int (&R)[2], const int (&C)[2], unsigned (&v0)[2], unsigned (&v1)[2]) const {
        if (gather) {
            const int n = cnt[u.x0]; const int* l = list + (size_t)u.x0 * T_ + u.x1 * 256;
#pragma unroll
            for (int i = 0; i < 2; ++i) { const int r0 = R[i], r1 = R[i] + 128;
                const int t0 = (u.x1 * 256 + r0 < n) ? l[r0] : 0, t1 = (u.x1 * 256 + r1 < n) ? l[r1] : 0;
                v0[i] = (unsigned)(t0 * 1024 + C[i]) * 2u; v1[i] = (unsigned)(t1 * 1024 + C[i]) * 2u; }
        } else {
#pragma unroll
            for (int i = 0; i < 2; ++i) { v0[i] = (unsigned)(R[i] * 512 + C[i]) * 2u; v1[i] = (unsigned)((R[i] + 128) * 512 + C[i]) * 2u; }
        }
    }
};

typedef f32x4 acc_t[2][2][4][2];
#define STG_SYNC() do { asm volatile("s_waitcnt lgkmcnt(0)" ::: "memory"); __builtin_amdgcn_s_barrier(); asm volatile("" ::: "memory"); } while (0)
__device__ __forceinline__ LAS unsigned char* stg_buf(LAS unsigned char* lds, int step) { return lds + STG_OFF + (step & 1) * STG_BUF; }
__device__ __forceinline__ void stg_put2(LAS unsigned char* buf, int wr, int wc, int fr, int fq, const u32x4& w0, const u32x4& w1) {
    LAS unsigned char* p = buf + (16 * wr + fr) * STG_ROWB + (32 * wc + 8 * fq) * 2; *(LAS u32x4*)p = w0; *(LAS u32x4*)(p + 256) = w1; }
__device__ __forceinline__ void stg_get2(const LAS unsigned char* buf, int wr, int wc, int fr, int fq, u32x4& w0, u32x4& w1) {
    const LAS unsigned char* p = buf + (16 * wr + fr) * STG_ROWB + (32 * wc + 8 * fq) * 2; w0 = *(const LAS u32x4*)p; w1 = *(const LAS u32x4*)(p + 256); }
__device__ __forceinline__ int stg_grow(int ai, int m, int rl) { return 128 * ai + 64 * (rl >> 4) + 16 * m + (rl & 15); }
__device__ __forceinline__ u32x4 pack8(const f32x4& v0, const f32x4& v1) { u32x4 w; w.x = pk2(v0[0], v0[1]); w.y = pk2(v0[2], v0[3]); w.z = pk2(v1[0], v1[1]); w.w = pk2(v1[2], v1[3]); return w; }

struct EpiProj {
    static constexpr bool PERM = true;
    bf16 *att, *mqk, *mv, *mo, *gates;
    __device__ __forceinline__ bool keep(const g8::GU&) const { return false; }
    __device__ __forceinline__ void operator()(acc_t& acc, const g8::GU& u, int wr, int wc, int fr, int fq, LAS unsigned char* lds) const {
        const int pn = u.pn; int tid = threadIdx.x; asm volatile("" : "+v"(tid));
        const bool gate = pn >= 9;
        bf16* base; int ldc, colt, act = 0; float sc = 1.f;
        if (pn < 3) { base = att; ldc = 768; colt = pn * 256; if (pn < 2) sc = QSCALE; }
        else if (pn < 5) { base = mqk; ldc = 512; colt = (pn - 3) * 256; }
        else if (pn < 7) { base = mv; ldc = 512; colt = (pn - 5) * 256; }
        else if (pn < 9) { base = mo; ldc = 512; colt = (pn - 7) * 256; act = 1; }
        else { base = gates; ldc = 2048; colt = (pn - 9) * 128; }
#pragma unroll
        for (int ai = 0; ai < 2; ++ai)
#pragma unroll
            for (int m = 0; m < 4; ++m) {
                u32x4 w0, w1;
                if (gate) {
                    f32x4 r0, r1, s0, s1;
#pragma unroll
                    for (int e = 0; e < 4; ++e) {
                        const float ea0 = __expf(-acc[ai][0][m][0][e]), eb0 = __expf(-acc[ai][1][m][0][e]), ea1 = __expf(-acc[ai][0][m][1][e]), eb1 = __expf(-acc[ai][1][m][1][e]);
                        r0[e] = (1.0f + eb0) * __builtin_amdgcn_rcpf(1.0f + ea0); s0[e] = __builtin_amdgcn_rcpf(1.0f + eb0);
                        r1[e] = (1.0f + eb1) * __builtin_amdgcn_rcpf(1.0f + ea1); s1[e] = __builtin_amdgcn_rcpf(1.0f + eb1); }
                    w0 = pack8(r0, r1); w1 = pack8(s0, s1);
                } else {
                    f32x4 a0 = acc[ai][0][m][0], a1 = acc[ai][0][m][1], b0 = acc[ai][1][m][0], b1 = acc[ai][1][m][1];
                    if (act) {
#pragma unroll
                        for (int e = 0; e < 4; ++e) { a0[e] = sigmoidf_(a0[e]); a1[e] = sigmoidf_(a1[e]); b0[e] = sigmoidf_(b0[e]); b1[e] = sigmoidf_(b1[e]); } }
                    else { a0 = a0 * sc; a1 = a1 * sc; b0 = b0 * sc; b1 = b1 * sc; }
                    w0 = pack8(a0, a1); w1 = pack8(b0, b1);
                }
                LAS unsigned char* buf = stg_buf(lds, ai * 4 + m);
                stg_put2(buf, wr, wc, fr, fq, w0, w1);
                STG_SYNC();
#pragma unroll
                for (int i = 0; i < 2; ++i) { const int p = tid + 512 * i, rl = p >> 5, ch = p & 31;
                    const u32x4 v = *(const LAS u32x4*)(buf + rl * STG_ROWB + ch * 16);
                    const int col = gate ? (ch < 16 ? colt + 8 * ch : 1024 + colt + 8 * (ch - 16)) : colt + 8 * ch;
                    st16(base + (size_t)(u.pm * 256 + stg_grow(ai, m, rl)) * ldc + col, v); }
            }
        STG_SYNC();
    }
};
struct EpiMix {
    static constexpr bool PERM = true;
    bf16* gates;
    __device__ __forceinline__ bool keep(const g8::GU& u) const { return u.x0 == 0; }
    __device__ __forceinline__ void operator()(acc_t& acc, const g8::GU& u, int wr, int wc, int fr, int fq, LAS unsigned char* lds) const {
        int tid = threadIdx.x; asm volatile("" : "+v"(tid)); const bool fin = u.x0 != 0;
        bf16* gt = gates + (size_t)(u.pm * 256) * 2048 + u.pn * 256;
        if (!fin) {
#pragma unroll
            for (int ai = 0; ai < 2; ++ai)
#pragma unroll
                for (int m = 0; m < 4; ++m) {
                    LAS unsigned char* buf = stg_buf(lds, ai * 4 + m);
#pragma unroll
                    for (int i = 0; i < 2; ++i) { const int p = tid + 512 * i, rl = p >> 5, ch = p & 31;
                        *(LAS u32x4*)(buf + rl * STG_ROWB + ch * 16) = *(const u32x4*)(gt + (size_t)stg_grow(ai, m, rl) * 2048 + 8 * ch); }
                    STG_SYNC();
                    u32x4 g0, g1; stg_get2(buf, wr, wc, fr, fq, g0, g1);
                    f32x4 &a0 = acc[ai][0][m][0], &a1 = acc[ai][0][m][1], &b0 = acc[ai][1][m][0], &b1 = acc[ai][1][m][1];
                    a0[0] *= bflo(g0.x); a0[1] *= bfhi(g0.x); a0[2] *= bflo(g0.y); a0[3] *= bfhi(g0.y); a1[0] *= bflo(g0.z); a1[1] *= bfhi(g0.z); a1[2] *= bflo(g0.w); a1[3] *= bfhi(g0.w);
                    b0[0] *= bflo(g1.x); b0[1] *= bfhi(g1.x); b0[2] *= bflo(g1.y); b0[3] *= bfhi(g1.y); b1[0] *= bflo(g1.z); b1[1] *= bfhi(g1.z); b1[2] *= bflo(g1.w); b1[3] *= bfhi(g1.w);
                }
            STG_SYNC();
        } else {
#pragma unroll
            for (int ai = 0; ai < 2; ++ai)
#pragma unroll
                for (int m = 0; m < 4; ++m) {
                    LAS unsigned char* buf = stg_buf(lds, ai * 4 + m);
                    stg_put2(buf, wr, wc, fr, fq, pack8(acc[ai][0][m][0], acc[ai][0][m][1]), pack8(acc[ai][1][m][0], acc[ai][1][m][1]));
                    STG_SYNC();
#pragma unroll
                    for (int i = 0; i < 2; ++i) { const int p = tid + 512 * i, rl = p >> 5, ch = p & 31;
                        bf16* gp = gt + (size_t)stg_grow(ai, m, rl) * 2048 + 8 * ch;
                        const u32x4 g = *(const u32x4*)(gp + 1024); const u32x4 v = *(const LAS u32x4*)(buf + rl * STG_ROWB + ch * 16);
                        u32x4 w; w.x = pk2(bflo(v.x) * bflo(g.x), bfhi(v.x) * bfhi(g.x)); w.y = pk2(bflo(v.y) * bflo(g.y), bfhi(v.y) * bfhi(g.y));
                        w.z = pk2(bflo(v.z) * bflo(g.z), bfhi(v.z) * bfhi(g.z)); w.w = pk2(bflo(v.w) * bflo(g.w), bfhi(v.w) * bfhi(g.w));
                        st16(gp, w); }
                }
            STG_SYNC();
        }
    }
};
struct EpiOut {
    static constexpr bool PERM = false;
    const float* x; float* out;
    __device__ __forceinline__ bool keep(const g8::GU&) const { return false; }
    __device__ __forceinline__ void operator()(acc_t& acc, const g8::GU& u, int wr, int wc, int fr, int fq, LAS unsigned char* lds) const {
        int tid = threadIdx.x; asm volatile("" : "+v"(tid));
#pragma unroll
        for (int ai = 0; ai < 2; ++ai)
#pragma unroll
            for (int m = 0; m < 4; ++m)
#pragma unroll
                for (int bj = 0; bj < 2; ++bj) {
                    LAS unsigned char* buf = stg_buf(lds, (ai * 4 + m) * 2 + bj);
                    LAS unsigned char* pp = buf + (16 * wr + fr) * STG_ROWB + (32 * wc + 4 * fq) * 4;
                    *(LAS f32x4*)pp = acc[ai][bj][m][0]; *(LAS f32x4*)(pp + 64) = acc[ai][bj][m][1];
                    f32x4 xv[2];
#pragma unroll
                    for (int i = 0; i < 2; ++i) { const int p = tid + 512 * i, rl = p >> 5, ch = p & 31; xv[i] = *(const f32x4*)(x + (size_t)(u.pm * 256 + stg_grow(ai, m, rl)) * 1024 + u.pn * 256 + bj * 128 + 4 * ch); }
                    STG_SYNC();
#pragma unroll
                    for (int i = 0; i < 2; ++i) { const int p = tid + 512 * i, rl = p >> 5, ch = p & 31;
                        const f32x4 v = *(const LAS f32x4*)(buf + rl * STG_ROWB + ch * 16);
                        st16f(out + (size_t)(u.pm * 256 + stg_grow(ai, m, rl)) * 1024 + u.pn * 256 + bj * 128 + 4 * ch, xv[i] + v); }
                }
        STG_SYNC();
    }
};
struct EpiG1 {
    static constexpr bool PERM = true;
    bf16* hid; const float* rstd2; const int* list; const LAS int* cnt;
    __device__ __forceinline__ bool keep(const g8::GU&) const { return false; }
    __device__ __forceinline__ void operator()(acc_t& acc, const g8::GU& u, int wr, int wc, int fr, int fq, LAS unsigned char* lds) const {
        int tid = threadIdx.x; asm volatile("" : "+v"(tid)); const int n = cnt[u.x0]; const int* l = list + (size_t)u.x0 * T_ + u.x1 * 256;
        const int rl0 = wr * 64 + fr;
#pragma unroll
        for (int ai = 0; ai < 2; ++ai)
#pragma unroll
            for (int m = 0; m < 4; ++m) { const int rl = rl0 + ai * 128 + m * 16; float rs = 0.f;
                if (u.x1 * 256 + rl < n) rs = rstd2[l[rl]];
                const f32x4 g0 = acc[ai][0][m][0] * rs, g1 = acc[ai][0][m][1] * rs, u0 = acc[ai][1][m][0] * rs, u1 = acc[ai][1][m][1] * rs;
                f32x4 h0, h1;
#pragma unroll
                for (int e = 0; e < 4; ++e) { h0[e] = siluf_(g0[e]) * u0[e]; h1[e] = siluf_(g1[e]) * u1[e]; }
                LAS unsigned char* buf = stg_buf(lds, ai * 4 + m);
                *(LAS u32x4*)(buf + (16 * wr + fr) * STG_ROWB + (32 * wc + 8 * fq) * 2) = pack8(h0, h1);
                STG_SYNC();
                { const int prl = tid >> 4, ch = tid & 15;
                  const u32x4 v = *(const LAS u32x4*)(buf + prl * STG_ROWB + ch * 16); st16(hid + (size_t)(u.pm * 256 + stg_grow(ai, m, prl)) * 512 + u.pn * 128 + 8 * ch, v); }
            }
        STG_SYNC();
    }
};
struct EpiG2 {
    static constexpr bool PERM = true;
    bf16* ys; const float* sw; const LAS int* cnt;
    __device__ __forceinline__ bool keep(const g8::GU&) const { return false; }
    __device__ __forceinline__ void operator()(acc_t& acc, const g8::GU& u, int wr, int wc, int fr, int fq, LAS unsigned char* lds) const {
        int tid = threadIdx.x; asm volatile("" : "+v"(tid)); const int n = cnt[u.x0]; const float* s = sw + (size_t)u.x0 * T_ + u.x1 * 256;
        const int rl0 = wr * 64 + fr;
#pragma unroll
        for (int ai = 0; ai < 2; ++ai)
#pragma unroll
            for (int m = 0; m < 4; ++m) { const int rl = rl0 + ai * 128 + m * 16; float wgt = 0.f;
                if (u.x1 * 256 + rl < n) wgt = s[rl];
                LAS unsigned char* buf = stg_buf(lds, ai * 4 + m);
                stg_put2(buf, wr, wc, fr, fq, pack8(acc[ai][0][m][0] * wgt, acc[ai][0][m][1] * wgt), pack8(acc[ai][1][m][0] * wgt, acc[ai][1][m][1] * wgt));
                STG_SYNC();
#pragma unroll
                for (int i = 0; i < 2; ++i) { const int p = tid + 512 * i, prl = p >> 5, ch = p & 31;
                    const u32x4 v = *(const LAS u32x4*)(buf + prl * STG_ROWB + ch * 16); st16(ys + (size_t)(u.pm * 256 + stg_grow(ai, m, prl)) * 1024 + u.pn * 256 + 8 * ch, v); }
            }
        STG_SYNC();
    }
};

#define XB_TMO      128
#define XB_XCNT(j)  (256  + 64 * (j))
#define XB_XSUB(j)  (1280 + 64 * (j))
#define XB_XGEN(j)  (2304 + 64 * (j))
#define XB_TOP      3328
#define XB_TOPGEN   3392
#define XCD_BAR_WORDS 3456
#define XB_SPIN_CAP (1u << 18)
__device__ __forceinline__ unsigned xb_ld(unsigned* p)              { return __hip_atomic_load(p, __ATOMIC_RELAXED, __HIP_MEMORY_SCOPE_AGENT); }
__device__ __forceinline__ unsigned xb_add(unsigned* p, unsigned v) { return __hip_atomic_fetch_add(p, v, __ATOMIC_RELAXED, __HIP_MEMORY_SCOPE_AGENT); }
__device__ __forceinline__ unsigned xb_xcc_id() { return (unsigned)__builtin_amdgcn_s_getreg((3 << 11) | 20) & 0xFu; }
#define XB_SPIN(cond, bar) do { unsigned _sp = 0; while (cond) { __builtin_amdgcn_s_sleep(1); \
    if ((++_sp & 255u) == 0u) { if (xb_ld(&(bar)[XB_TMO])) break; if (_sp > XB_SPIN_CAP) { atomicAdd(&(bar)[XB_TMO], 1u); break; } } } } while (0)
struct XcdBarrier { unsigned* bar; unsigned x; volatile LAS unsigned* st; };
__device__ __forceinline__ XcdBarrier xcd_barrier_post(unsigned* bar, volatile LAS unsigned* st) {
    XcdBarrier b; b.bar = bar; b.x = xb_xcc_id(); b.st = st;
    if (threadIdx.x == 0) (void)xb_add(&bar[XB_XCNT(b.x)], 1u);
    return b;
}
__device__ __forceinline__ void xcd_barrier_complete(unsigned* bar, unsigned x, unsigned& nloc, unsigned& nx) {
    const unsigned G = gridDim.x * gridDim.y * gridDim.z;
    unsigned sum, cnt, mine, sp = 0u;
    for (;;) {
        sum = 0u; cnt = 0u; mine = 0u;
#pragma unroll
        for (unsigned j = 0; j < 16; ++j) { const unsigned c = xb_ld(&bar[XB_XCNT(j)]); sum += c; cnt += (c > 0u) ? 1u : 0u; mine = (j == x) ? c : mine; }
        if (sum == G) break;
        __builtin_amdgcn_s_sleep(1);
        if ((++sp & 255u) == 0u) { if (xb_ld(&bar[XB_TMO])) break; if (sp > XB_SPIN_CAP) { atomicAdd(&bar[XB_TMO], 1u); break; } }
    }
    nloc = mine > 0u ? mine : 1u; nx = cnt > 0u ? cnt : 1u;
}
__device__ __forceinline__ void xcd_barrier(const XcdBarrier& b) {
    asm volatile("s_waitcnt vmcnt(0)" ::: "memory");
    __syncthreads();
    if (threadIdx.x == 0) {
        unsigned* bar = b.bar;
        __builtin_amdgcn_s_waitcnt(0);
        unsigned nloc = b.st[0], nx = b.st[1];
        if (nloc == 0u) { xcd_barrier_complete(bar, b.x, nloc, nx); b.st[0] = nloc; b.st[1] = nx; }
        const unsigned old = xb_add(&bar[XB_XSUB(b.x)], 1u);
        const unsigned gen = old / nloc;
        if (old + 1u == (gen + 1u) * nloc) {
            __builtin_amdgcn_fence(__ATOMIC_RELEASE, "agent");
            asm volatile("s_waitcnt vmcnt(0)" ::: "memory");
            const unsigned og = xb_add(&bar[XB_TOP], 1u);
            const unsigned tg = og / nx;
            if (og + 1u == (tg + 1u) * nx) xb_add(&bar[XB_TOPGEN], 1u);
            else XB_SPIN(xb_ld(&bar[XB_TOPGEN]) == tg, bar);
            __builtin_amdgcn_fence(__ATOMIC_ACQUIRE, "agent");
            xb_add(&bar[XB_XGEN(b.x)], 1u);
            asm volatile("s_waitcnt vmcnt(0)" ::: "memory");
        } else {
            XB_SPIN(xb_ld(&bar[XB_XGEN(b.x)]) == gen, bar);
            __builtin_amdgcn_fence(__ATOMIC_ACQUIRE, "agent");
            asm volatile("s_waitcnt vmcnt(0)" ::: "memory");
        }
    }
    __syncthreads();
}

struct Args { const float* in[21]; float* out; unsigned char* ws; int ph_lo, ph_hi; };

__device__ __forceinline__ void p0_transpose_item(const float* W, int ldw, int srccol0, int k0, bf16* WT, int ldt, int destrow0, int lane) {
    const int kk = lane >> 3, n4 = lane & 7;
    const float* src = W + (size_t)(k0 + 8 * kk) * ldw + srccol0 + 4 * n4;
    f32x4 v[8];
#pragma unroll
    for (int i = 0; i < 8; ++i) v[i] = *(const f32x4*)(src + (size_t)i * ldw);
    bf16* dst = WT + (size_t)(destrow0 + 4 * n4) * ldt + k0 + 8 * kk;
#pragma unroll
    for (int c = 0; c < 4; ++c) { u32x4 o; o.x = pk2(v[0][c], v[1][c]); o.y = pk2(v[2][c], v[3][c]); o.z = pk2(v[4][c], v[5][c]); o.w = pk2(v[6][c], v[7][c]);
        *(u32x4*)(dst + (size_t)c * ldt) = o; }
}

constexpr int I_GU = 32 * 16 * 32, I_DN = 32 * 8 * 32, I_EXP = I_GU + I_DN;
#ifndef DEFER_PER_WAVE
#define DEFER_PER_WAVE 16
#endif
__device__ __forceinline__ void expert_copy_item(const Args& a, int r, int lane) {
    bf16* Wgu = (bf16*)(a.ws + WS_WGU); bf16* Wdn = (bf16*)(a.ws + WS_WDN);
    if (r < I_GU) { const int e = r / 512, q = r % 512, kb = q / 32, nb = q % 32, d0 = nb * 32, tt = d0 >> 8, j = d0 & 255;
        const float* src = (j < 128 ? a.in[17] : a.in[18]) + (size_t)e * 1024 * 512;
        p0_transpose_item(src, 512, 128 * tt + (j & 127), kb * 64, Wgu + (size_t)e * 1024 * 1024, 1024, d0, lane); }
    else { r -= I_GU; const int e = r / 256, q = r % 256, kb = q / 32, nb = q % 32;
        p0_transpose_item(a.in[19] + (size_t)e * 512 * 1024, 1024, nb * 32, kb * 64, Wdn + (size_t)e * 1024 * 512, 512, nb * 32, lane); }
}
__device__ __forceinline__ int deferred_items(int G) { const int nunits = (T_ / 256) * (NIN / 256), rem = nunits % G; return rem == 0 ? 0 : min(I_EXP, (G - rem) * NWAVES * DEFER_PER_WAVE); }
__device__ __forceinline__ void phase0(const Args& a, LAS unsigned char* lds, int vcu, int G, int tid, int lane, int wave) {
    unsigned char* ws = a.ws;
    const float* x = a.in[0]; const float* nw = a.in[1]; const float* w_in = a.in[2];
    LAS float* WGF = (LAS float*)(lds + 69632);
#if PROBE_PH >= 100 && PROBE_PH < 110
    unsigned long long sp0 = __builtin_amdgcn_s_memrealtime(), sp1 = 0, sp2 = 0, sp3 = 0;
#endif
    {   f32x4 g0[2], g1[2]; float nk[2];
#pragma unroll
        for (int i = 0; i < 2; ++i) { const int k = tid + 512 * i; const float* src = w_in + (size_t)k * 4360 + 2304; g0[i] = *(const f32x4*)src; g1[i] = *(const f32x4*)(src + 4); nk[i] = nw[k]; }
#pragma unroll
        for (int i = 0; i < 2; ++i) { const int k = tid + 512 * i;
#pragma unroll
            for (int g = 0; g < 4; ++g) { WGF[g * 1024 + k] = nk[i] * g0[i][g]; WGF[(4 + g) * 1024 + k] = nk[i] * g1[i][g]; } } }
    __syncthreads();
    const int gw = vcu * NWAVES + wave, NGW = G * NWAVES;
#if PROBE_PH >= 100 && PROBE_PH < 110
    sp1 = __builtin_amdgcn_s_memrealtime();
#endif
    {
        f32x4 nwv[4];
#pragma unroll
        for (int j = 0; j < 4; ++j) nwv[j] = ((const f32x4*)nw)[lane + 64 * j];
        float big[4], bfg[4];
#pragma unroll
        for (int h = 0; h < 4; ++h) { big[h] = a.in[5][h]; bfg[h] = a.in[6][h]; }
        bf16* XN = (bf16*)(ws + WS_XN); float* IGF = (float*)(ws + WS_IGF);
        const bool hi32 = (lane & 32) != 0, hi16 = (lane & 16) != 0, hi8 = (lane & 8) != 0; const int gsel = lane >> 3;
        f32x4 v[4][4], vn[4][4];
#pragma unroll
        for (int r = 0; r < 4; ++r) { const int m = gw + r * NGW; const int mm = m < T_ ? m : gw;
#pragma unroll
            for (int j = 0; j < 4; ++j) v[r][j] = ((const f32x4*)(x + (size_t)mm * 1024) + lane)[64 * j]; }
        for (int m0 = gw; m0 < T_; m0 += 4 * NGW) {
#pragma unroll
            for (int r = 0; r < 4; ++r) { const int m = m0 + (4 + r) * NGW; const int mm = m < T_ ? m : gw;
#pragma unroll
                for (int j = 0; j < 4; ++j) vn[r][j] = ((const f32x4*)(x + (size_t)mm * 1024) + lane)[64 * j]; }
#pragma unroll
            for (int r = 0; r < 4; ++r) { const int m = m0 + r * NGW;
                if (m < T_) {
                    float s = 0.f;
#pragma unroll
                    for (int j = 0; j < 4; ++j) s += (v[r][j].x * v[r][j].x + v[r][j].y * v[r][j].y) + (v[r][j].z * v[r][j].z + v[r][j].w * v[r][j].w);
                    const float rstd = 1.0f / sqrtf(wave_sum(s) * (1.f / 1024.f) + EPS_);
                    unsigned long long* o8 = (unsigned long long*)(XN + (size_t)m * 1024) + lane;
#pragma unroll
                    for (int j = 0; j < 4; ++j) { const f32x4 y = v[r][j] * rstd * nwv[j]; o8[64 * j] = (unsigned long long)pk2(y.x, y.y) | ((unsigned long long)pk2(y.z, y.w) << 32); }
                    float pg[8];
#pragma unroll
                    for (int g = 0; g < 8; ++g) { float p = 0.f;
#pragma unroll
                        for (int j = 0; j < 4; ++j) { const f32x4 w4 = *(const LAS f32x4*)(WGF + g * 1024 + 256 * j + 4 * lane); p += (v[r][j].x * w4.x + v[r][j].y * w4.y) + (v[r][j].z * w4.z + v[r][j].w * w4.w); }
                        pg[g] = p; }
                    float a4[4], a2[2], a1;
#pragma unroll
                    for (int i = 0; i < 4; ++i) { const float keep = hi32 ? pg[4 + i] : pg[i], send = hi32 ? pg[i] : pg[4 + i]; a4[i] = keep + __shfl_xor(send, 32); }
#pragma unroll
                    for (int i = 0; i < 2; ++i) { const float keep = hi16 ? a4[2 + i] : a4[i], send = hi16 ? a4[i] : a4[2 + i]; a2[i] = keep + __shfl_xor(send, 16); }
                    { const float keep = hi8 ? a2[1] : a2[0], send = hi8 ? a2[0] : a2[1]; a1 = keep + __shfl_xor(send, 8); }
                    a1 += __shfl_xor(a1, 4); a1 += __shfl_xor(a1, 2); a1 += __shfl_xor(a1, 1);
                    if ((lane & 7) == 0) { const float z0 = a1 * rstd;
                        float o;
                        if (gsel < 4) o = z0 + big[gsel & 3]; else { const float z = z0 + bfg[gsel & 3]; o = fminf(z, 0.f) - log1pf(expf(-fabsf(z))); }
                        IGF[(size_t)m * 8 + gsel] = o; }
                }
                asm volatile("" ::: "memory"); __builtin_amdgcn_sched_barrier(0); }
#pragma unroll
            for (int r = 0; r < 4; ++r)
#pragma unroll
                for (int j = 0; j < 4; ++j) v[r][j] = vn[r][j];
        }
    }
#if PROBE_PH >= 100 && PROBE_PH < 110
    asm volatile("s_waitcnt vmcnt(0)" ::: "memory"); __syncthreads(); sp2 = __builtin_amdgcn_s_memrealtime();
#endif
    {
        bf16* Win = (bf16*)(ws + WS_WIN); bf16* Wao = (bf16*)(ws + WS_WAO); bf16* Wmo = (bf16*)(ws + WS_WMO); bf16* Wout = (bf16*)(ws + WS_WOUT);
        constexpr int I_IN = 16 * 136, I_AO = 8 * 32, I_OUT = 16 * 32;
        const int ndef = deferred_items(G);
        const int NITEMS = I_IN + 2 * I_AO + I_OUT + (I_EXP - ndef);
        for (int it = gw; it < NITEMS; it += NGW) {
            int r = it;
            if (r < I_IN) { const int kb = r / 136, nb = r % 136, d0 = nb * 32; int sc0 = d0;
                if (d0 >= 2304) { const int q = d0 - 2304, j = q >> 8, rr = q & 255; sc0 = (rr < 128 ? 2312 : 3336) + 128 * j + (rr & 127); }
                p0_transpose_item(w_in, 4360, sc0, kb * 64, Win, 1024, d0, lane); continue; } r -= I_IN;
            if (r < I_AO) { const int kb = r / 32, nb = r % 32; p0_transpose_item(a.in[9], 1024, nb * 32, kb * 64, Wao, 512, nb * 32, lane); continue; } r -= I_AO;
            if (r < I_AO) { const int kb = r / 32, nb = r % 32; p0_transpose_item(a.in[10], 1024, nb * 32, kb * 64, Wmo, 512, nb * 32, lane); continue; } r -= I_AO;
            if (r < I_OUT) { const int kb = r / 32, nb = r % 32; p0_transpose_item(a.in[11], 1024, nb * 32, kb * 64, Wout, 1024, nb * 32, lane); continue; } r -= I_OUT;
            expert_copy_item(a, ndef + r, lane);
        }
        bf16* WR = (bf16*)(ws + WS_WR);
        for (int i = (vcu * 512 + tid); i < 48 * 1024; i += G * 512) { const int n = i >> 10, k = i & 1023; float v = 0.f;
            if (n < 4) v = a.in[13][k * 4 + n]; else if (n < 36) v = a.in[15][k * 32 + (n - 4)];
            WR[i] = (bf16)(pk2(v, 0.f) & 0xffffu); }
    }
#if PROBE_PH >= 100 && PROBE_PH < 110
    asm volatile("s_waitcnt vmcnt(0)" ::: "memory"); __syncthreads(); sp3 = __builtin_amdgcn_s_memrealtime();
    if (blockIdx.x == 0 && tid == 0) { const unsigned long long d = (PROBE_PH == 100 ? sp2 - sp1 : PROBE_PH == 101 ? sp3 - sp2 : sp1 - sp0) * PROBE_AMP; const unsigned long long te = __builtin_amdgcn_s_memrealtime(); while (__builtin_amdgcn_s_memrealtime() - te < d) __builtin_amdgcn_s_sleep(8); }
#endif
}

__device__ __forceinline__ void attn_unit(const Args& a, LAS unsigned char* lds, int b, int blk, int kvh, int tid, int lane, int wave) {
    bf16* ATT = (bf16*)(a.ws + WS_ATT);
    LAS short* Ks = (LAS short*)lds;
    LAS short* VT = (LAS short*)(lds + 36864);
    const long t0 = (long)b * SEQ_ + blk * 128;
#pragma unroll
    for (int i = 0; i < 4; ++i) { const int p = tid + 512 * i, row = p >> 3, ch = p & 7;
        u32x4 kv = (u32x4){0u, 0u, 0u, 0u}, vv = (u32x4){0u, 0u, 0u, 0u};
        if (blk > 0 || row >= 128) { const bf16* src = ATT + (t0 - 128 + row) * 768; kv = *(const u32x4*)(src + 512 + kvh * 64 + ch * 8); vv = *(const u32x4*)(src + 640 + kvh * 64 + ch * 8); }
        *(LAS u32x4*)(Ks + row * 72 + ch * 8) = kv;
        LAS short* vt = VT + (ch * 8) * 264 + row;
        vt[0 * 264] = (short)(vv.x & 0xffff); vt[1 * 264] = (short)(vv.x >> 16); vt[2 * 264] = (short)(vv.y & 0xffff); vt[3 * 264] = (short)(vv.y >> 16);
        vt[4 * 264] = (short)(vv.z & 0xffff); vt[5 * 264] = (short)(vv.z >> 16); vt[6 * 264] = (short)(vv.w & 0xffff); vt[7 * 264] = (short)(vv.w >> 16); }
    __syncthreads();
    const int q = lane & 31, h = lane >> 5;
#pragma unroll 1
    for (int gi = 0; gi < 2; ++gi) {
        const int g16 = wave * 2 + gi, g = g16 >> 2, r = g16 & 3, hq = kvh * 4 + g;
        const int i = 32 * r + q;
        bf16* qrow = ATT + (t0 + i) * 768 + hq * 64;
        bf16x8 qf[4];
#pragma unroll
        for (int s = 0; s < 4; ++s) qf[s] = *(const bf16x8*)(qrow + 16 * s + 8 * h);
        const float sink2 = a.in[7][hq] * LOG2E;
        f32x16 S[5];
#pragma unroll
        for (int tt = 0; tt < 5; ++tt) { const int jt = r + tt; f32x16 c = {};
#pragma unroll
            for (int s = 0; s < 4; ++s) { const bf16x8 kf = *(const LAS bf16x8*)(Ks + (32 * jt + q) * 72 + 16 * s + 8 * h); c = __builtin_amdgcn_mfma_f32_32x32x16_bf16(kf, qf[s], c, 0, 0, 0); }
            S[tt] = c; }
        float mx = sink2;
#pragma unroll
        for (int tt = 0; tt < 5; ++tt) { const bool tv = (blk > 0) || (r + tt >= 4);
#pragma unroll
            for (int rg = 0; rg < 16; ++rg) { const int kr = (rg & 3) + 8 * (rg >> 2) + 4 * h;
                const bool ok = tv && (tt == 0 ? (kr > q) : (tt == 4 ? (kr <= q) : true));
                const float sv = ok ? S[tt][rg] : -INFINITY; S[tt][rg] = sv; mx = fmaxf(mx, sv); } }
        mx = fmaxf(mx, __shfl_xor(mx, 32));
        float l = 0.f;
#pragma unroll
        for (int tt = 0; tt < 5; ++tt)
#pragma unroll
            for (int rg = 0; rg < 16; ++rg) { const float p = __builtin_amdgcn_exp2f(S[tt][rg] - mx); S[tt][rg] = p; l += p; }
        l += __shfl_xor(l, 32);
        l += __builtin_amdgcn_exp2f(sink2 - mx);
        const float il = 1.0f / l;
        f32x16 O[2]; O[0] = (f32x16){}; O[1] = (f32x16){};
#pragma unroll
        for (int tt = 0; tt < 5; ++tt) { const int jt = r + tt;
#pragma unroll
            for (int ks = 0; ks < 2; ++ks) {
                u32x4 pw; pw.x = pk2(S[tt][8 * ks + 0], S[tt][8 * ks + 1]); pw.y = pk2(S[tt][8 * ks + 2], S[tt][8 * ks + 3]); pw.z = pk2(S[tt][8 * ks + 4], S[tt][8 * ks + 5]); pw.w = pk2(S[tt][8 * ks + 6], S[tt][8 * ks + 7]);
                const bf16x8 pf = __builtin_bit_cast(bf16x8, pw);
#pragma unroll
                for (int dt = 0; dt < 2; ++dt) { const LAS short* vp = VT + (32 * dt + q) * 264 + 32 * jt + 16 * ks + 4 * h;
                    const s16x4 lo = *(const LAS s16x4*)vp, hi = *(const LAS s16x4*)(vp + 8);
                    const bf16x8 vf = (bf16x8){lo[0], lo[1], lo[2], lo[3], hi[0], hi[1], hi[2], hi[3]};
                    O[dt] = __builtin_amdgcn_mfma_f32_32x32x16_bf16(vf, pf, O[dt], 0, 0, 0); } } }
#pragma unroll
        for (int dt = 0; dt < 2; ++dt)
#pragma unroll
            for (int g4 = 0; g4 < 4; ++g4) { u32x2 w; w.x = pk2(O[dt][4 * g4 + 0] * il, O[dt][4 * g4 + 1] * il); w.y = pk2(O[dt][4 * g4 + 2] * il, O[dt][4 * g4 + 3] * il);
                *(u32x2*)(qrow + 32 * dt + 8 * g4 + 4 * h) = w; }
    }
    __syncthreads();
}

__device__ __forceinline__ void conv8(const bf16* MQK, const float* cw, const float* cb, long trow, int s_in_seq, int cidx, float (&y)[8]) {
    const f32x4 b0 = *(const f32x4*)(cb + cidx), b1 = *(const f32x4*)(cb + cidx + 4);
    y[0] = b0.x; y[1] = b0.y; y[2] = b0.z; y[3] = b0.w; y[4] = b1.x; y[5] = b1.y; y[6] = b1.z; y[7] = b1.w;
#pragma unroll
    for (int j = 0; j < 4; ++j) { const int d = j - 3;
        if (s_in_seq + d >= 0) {
            const u32x4 u = *(const u32x4*)(MQK + (trow + d) * 512 + cidx);
            const f32x4 w0 = *(const f32x4*)(cw + j * 512 + cidx), w1 = *(const f32x4*)(cw + j * 512 + cidx + 4);
            y[0] += w0.x * bflo(u.x); y[1] += w0.y * bfhi(u.x); y[2] += w0.z * bflo(u.y); y[3] += w0.w * bfhi(u.y);
            y[4] += w1.x * bflo(u.z); y[5] += w1.y * bfhi(u.z); y[6] += w1.z * bflo(u.w); y[7] += w1.w * bfhi(u.w);
        } }
#pragma unroll
    for (int e = 0; e < 8; ++e) y[e] = siluf_(y[e]);
}

__device__ __forceinline__ void mprep_unit(const Args& a, LAS unsigned char* lds, int unit, int tid, int lane, int wave) {
    const int hh = unit & 3, c = (unit >> 2) & 63, b = unit >> 8;
    const long t0 = (long)b * SEQ_ + c * 64;
    const bf16* MQK = (const bf16*)(a.ws + WS_MQK); const bf16* MV = (const bf16*)(a.ws + WS_MV);
    const float* IGF = (const float*)(a.ws + WS_IGF); float* CHS = (float*)(a.ws + WS_CHS) + (size_t)unit * 256;
    bf16* UT = (bf16*)(a.ws + WS_XN) + (size_t)unit * 8192;
    LAS short* KwT = (LAS short*)lds;
    LAS short* VT = (LAS short*)(lds + 9216);
    LAS float* wsv = (LAS float*)(lds + 27648);
    if (wave == 0) {
        const float lf = IGF[(t0 + lane) * 8 + 4 + hh], ig = IGF[(t0 + lane) * 8 + hh];
        float bc = lf;
#pragma unroll
        for (int o = 1; o < 64; o <<= 1) { const float t = __shfl_up(bc, o); if (lane >= o) bc += t; }
        const float bl = __shfl(bc, 63);
        const float g = bl - bc + ig; const float loc = wave_max(g);
        wsv[lane] = __expf(g - loc);
        if (lane == 0) { CHS[64] = bl; CHS[65] = loc; }
        const float ee = ig - bc; float cm = ee;
#pragma unroll
        for (int o = 1; o < 64; o <<= 1) { const float t = __shfl_up(cm, o); if (lane >= o) cm = fmaxf(cm, t); }
        float* IGFw = (float*)(a.ws + WS_IGF);
        IGFw[(t0 + lane) * 8 + hh] = ee; IGFw[(t0 + lane) * 8 + 4 + hh] = bc; CHS[192 + lane] = cm;
    }
    __syncthreads();
    {   const int s = tid >> 3, ch = tid & 7;
        float y[8]; conv8(MQK, a.in[3], a.in[4], t0 + s, c * 64 + s, 256 + hh * 64 + ch * 8, y);
        const float wsc = wsv[s] * 0.125f;
#pragma unroll
        for (int e = 0; e < 8; ++e) KwT[(ch * 8 + e) * 72 + s] = (short)(pk2(y[e] * wsc, 0.f) & 0xffffu);
        const bf16* vsrc = MV + (t0 + s) * 512 + hh * 128 + ch * 16;
        const u32x4 v0 = *(const u32x4*)vsrc, v1 = *(const u32x4*)(vsrc + 8);
        LAS short* vt = VT + (ch * 16) * 72 + s;
        vt[0 * 72] = (short)(v0.x & 0xffff); vt[1 * 72] = (short)(v0.x >> 16); vt[2 * 72] = (short)(v0.y & 0xffff); vt[3 * 72] = (short)(v0.y >> 16);
        vt[4 * 72] = (short)(v0.z & 0xffff); vt[5 * 72] = (short)(v0.z >> 16); vt[6 * 72] = (short)(v0.w & 0xffff); vt[7 * 72] = (short)(v0.w >> 16);
        vt[8 * 72] = (short)(v1.x & 0xffff); vt[9 * 72] = (short)(v1.x >> 16); vt[10 * 72] = (short)(v1.y & 0xffff); vt[11 * 72] = (short)(v1.y >> 16);
        vt[12 * 72] = (short)(v1.z & 0xffff); vt[13 * 72] = (short)(v1.z >> 16); vt[14 * 72] = (short)(v1.w & 0xffff); vt[15 * 72] = (short)(v1.w >> 16);
    }
    __syncthreads();
    if (tid < 64) { float n = 0.f;
#pragma unroll 8
        for (int s = 0; s < 64; ++s) n += bf2f(KwT[tid * 72 + s]);
        CHS[tid] = n; }
    {   const int dkt = wave & 1, dvt = wave >> 1, q = lane & 31, h = lane >> 5;
        f32x16 acc = {};
#pragma unroll
        for (int ks = 0; ks < 4; ++ks) { const bf16x8 af = *(const LAS bf16x8*)(KwT + (32 * dkt + q) * 72 + 16 * ks + 8 * h); const bf16x8 bfr = *(const LAS bf16x8*)(VT + (32 * dvt + q) * 72 + 16 * ks + 8 * h);
            acc = __builtin_amdgcn_mfma_f32_32x32x16_bf16(af, bfr, acc, 0, 0, 0); }
        bf16* up = UT + (32 * dvt + q) * 64 + 32 * dkt + 4 * h;
#pragma unroll
        for (int g4 = 0; g4 < 4; ++g4) { u32x2 w; w.x = pk2(acc[4 * g4 + 0], acc[4 * g4 + 1]); w.y = pk2(acc[4 * g4 + 2], acc[4 * g4 + 3]); *(u32x2*)(up + 8 * g4) = w; }
    }
    __syncthreads();
}

__device__ __forceinline__ void phase3(const Args& a, int G, int tid) {
    unsigned* UT32 = (unsigned*)(a.ws + WS_XN); float* CHS = (float*)(a.ws + WS_CHS);
    for (int item = blockIdx.x * 512 + tid; item < 32 * 4096; item += G * 512) {
        const int bh = item >> 12, ep = item & 4095, b = bh >> 2, hh = bh & 3;
        float c0 = 0.f, c1 = 0.f, nst = 0.f, m = 0.f;
#pragma unroll 1
        for (int cb = 0; cb < 64; cb += 8) {
            unsigned u[8]; float bs[8], lc[8], nl[8];
#pragma unroll
            for (int k = 0; k < 8; ++k) { const int unit = ((b * 64 + cb + k) << 2) + hh; u[k] = UT32[(size_t)unit * 4096 + ep]; bs[k] = CHS[(size_t)unit * 256 + 64]; lc[k] = CHS[(size_t)unit * 256 + 65];
                nl[k] = (ep < 64) ? CHS[(size_t)unit * 256 + ep] : 0.f; }
#pragma unroll
            for (int k = 0; k < 8; ++k) { const int unit = ((b * 64 + cb + k) << 2) + hh;
                UT32[(size_t)unit * 4096 + ep] = pk2(c0, c1);
                if (ep < 64) CHS[(size_t)unit * 256 + 128 + ep] = nst;
                if (ep == 0) CHS[(size_t)unit * 256 + 66] = m;
                const float mn = fmaxf(bs[k] + m, lc[k]); const float wc = __expf(bs[k] + m - mn), sc = __expf(lc[k] - mn);
                c0 = wc * c0 + sc * bflo(u[k]); c1 = wc * c1 + sc * bfhi(u[k]); nst = wc * nst + sc * nl[k]; m = mn; }
        }
    }
}

struct MoutLoad { u32x4 q[4], k[4]; u32x4 v0, v1, c0, c1; u32x2 mo[4]; float es, bt, cmt, mp, np; };
__device__ __forceinline__ void mout_load(const Args& a, int unit, int tid, int lane, int wave, MoutLoad& L) {
    const int hh = unit & 3, c = (unit >> 2) & 63, b = unit >> 8;
    const long t0 = (long)b * SEQ_ + c * 64;
    const bf16* MQK = (const bf16*)(a.ws + WS_MQK); const bf16* MV = (const bf16*)(a.ws + WS_MV); const bf16* MO = (const bf16*)(a.ws + WS_MO);
    const float* IGF = (const float*)(a.ws + WS_IGF); const float* CHS = (const float*)(a.ws + WS_CHS) + (size_t)unit * 256;
    const bf16* UT = (const bf16*)(a.ws + WS_XN) + (size_t)unit * 8192;
    const int s = tid >> 3, ch = tid & 7;
#pragma unroll
    for (int j = 0; j < 4; ++j) { const int d = j - 3; const bool ok = (c * 64 + s + d) >= 0; const bf16* src = MQK + (t0 + s + (ok ? d : 0)) * 512 + hh * 64 + ch * 8;
        L.q[j] = *(const u32x4*)src; L.k[j] = *(const u32x4*)(src + 256); }
    const bf16* vsrc = MV + (t0 + s) * 512 + hh * 128 + ch * 16; L.v0 = *(const u32x4*)vsrc; L.v1 = *(const u32x4*)(vsrc + 8);
    L.c0 = *(const u32x4*)(UT + (tid >> 3) * 64 + (tid & 7) * 8); L.c1 = *(const u32x4*)(UT + ((tid + 512) >> 3) * 64 + (tid & 7) * 8);
    const int tt = wave >> 2, dvt = wave & 3, q = lane & 31, h = lane >> 5, t = 32 * tt + q;
    const bf16* op = MO + (t0 + t) * 512 + hh * 128 + 32 * dvt + 4 * h;
#pragma unroll
    for (int g4 = 0; g4 < 4; ++g4) L.mo[g4] = *(const u32x2*)(op + 8 * g4);
    L.es = IGF[(t0 + lane) * 8 + hh]; L.bt = IGF[(t0 + t) * 8 + 4 + hh]; L.cmt = CHS[192 + t]; L.mp = CHS[66]; L.np = CHS[128 + lane];
}
__device__ __forceinline__ void conv_acc8(const u32x4 (&u)[4], const LAS float* cwt, const LAS float* cbt, int c8, int nvalid  , float (&y)[8]) {
    const f32x4 b0 = *(const LAS f32x4*)(cbt + c8), b1 = *(const LAS f32x4*)(cbt + c8 + 4);
    y[0] = b0.x; y[1] = b0.y; y[2] = b0.z; y[3] = b0.w; y[4] = b1.x; y[5] = b1.y; y[6] = b1.z; y[7] = b1.w;
#pragma unroll
    for (int j = 0; j < 4; ++j) { const float msk = (j >= 4 - nvalid) ? 1.f : 0.f; const f32x4 w0 = *(const LAS f32x4*)(cwt + j * 128 + c8) * msk, w1 = *(const LAS f32x4*)(cwt + j * 128 + c8 + 4) * msk;
        y[0] += w0.x * bflo(u[j].x); y[1] += w0.y * bfhi(u[j].x); y[2] += w0.z * bflo(u[j].y); y[3] += w0.w * bfhi(u[j].y);
        y[4] += w1.x * bflo(u[j].z); y[5] += w1.y * bfhi(u[j].z); y[6] += w1.z * bflo(u[j].w); y[7] += w1.w * bfhi(u[j].w); }
#pragma unroll
    for (int e = 0; e < 8; ++e) y[e] = siluf_(y[e]);
}
__device__ __forceinline__ void phase4(const Args& a, LAS unsigned char* lds, int vcu, int G, int tid, int lane, int wave) {
    LAS short* QS = (LAS short*)lds;
    LAS short* KS = (LAS short*)(lds + 18432);
    LAS short* VT = (LAS short*)(lds + 27648);
    LAS short* CT = (LAS short*)(lds + 46080);
    LAS float* bsv = (LAS float*)(lds + 64768);
    LAS float* npv = (LAS float*)(lds + 65536); LAS float* red = (LAS float*)(lds + 65792);
    LAS float* cwt = (LAS float*)(lds + 67584);
    LAS float* cbt = (LAS float*)(lds + 69632);
    bf16* MO = (bf16*)(a.ws + WS_MO);
    const int tt = wave >> 2, dvt = wave & 3, q = lane & 31, h = lane >> 5, t = 32 * tt + q;
    int u = vcu; if (u >= 2048) return;
    int hh_tab = -1; f32x4 nwr[4];
#if PROBE_PH >= 140 && PROBE_PH < 150
    unsigned long long acc_t0 = 0, acc_t1 = 0, acc_t2 = 0, tA, tB, tC, tD; const unsigned long long tE = __builtin_amdgcn_s_memrealtime();
#endif
    MoutLoad pre; mout_load(a, u, tid, lane, wave, pre);
    for (; u < 2048; u += G) {
#if PROBE_PH >= 140 && PROBE_PH < 150
        tA = __builtin_amdgcn_s_memrealtime();
#endif
        const int hh = u & 3, c = (u >> 2) & 63, b = u >> 8; const long t0 = (long)b * SEQ_ + c * 64;
        if (hh != hh_tab) {
            __syncthreads();
            { const int j = tid >> 7, cc = tid & 127; cwt[tid] = a.in[3][j * 512 + (cc < 64 ? hh * 64 + cc : 256 + hh * 64 + (cc - 64))]; }
            if (tid < 128) cbt[tid] = a.in[4][tid < 64 ? hh * 64 + tid : 256 + hh * 64 + (tid - 64)];
#pragma unroll
            for (int g4 = 0; g4 < 4; ++g4) nwr[g4] = *(const f32x4*)(a.in[8] + hh * 128 + 32 * dvt + 4 * h + 8 * g4);
            hh_tab = hh; __syncthreads();
        }
        const MoutLoad cur = pre;
        if (u + G < 2048) mout_load(a, u + G, tid, lane, wave, pre);
        if (wave == 0) { bsv[lane] = __expf(cur.es); npv[lane] = cur.np; }
        {   const int s = tid >> 3, ch = tid & 7;
            const int nvalid = min(4, c * 64 + s + 1);
            float y[8];
            conv_acc8(cur.q, cwt, cbt, ch * 8, nvalid, y);
            u32x4 w; w.x = pk2(y[0], y[1]); w.y = pk2(y[2], y[3]); w.z = pk2(y[4], y[5]); w.w = pk2(y[6], y[7]);
            *(LAS u32x4*)(QS + s * 72 + ch * 8) = w;
            conv_acc8(cur.k, cwt, cbt, 64 + ch * 8, nvalid, y);
            w.x = pk2(y[0] * 0.125f, y[1] * 0.125f); w.y = pk2(y[2] * 0.125f, y[3] * 0.125f); w.z = pk2(y[4] * 0.125f, y[5] * 0.125f); w.w = pk2(y[6] * 0.125f, y[7] * 0.125f);
            *(LAS u32x4*)(KS + s * 72 + ch * 8) = w;
            const u32x4 v0 = cur.v0, v1 = cur.v1;
            LAS short* vt = VT + (ch * 16) * 72 + s;
            vt[0 * 72] = (short)(v0.x & 0xffff); vt[1 * 72] = (short)(v0.x >> 16); vt[2 * 72] = (short)(v0.y & 0xffff); vt[3 * 72] = (short)(v0.y >> 16);
            vt[4 * 72] = (short)(v0.z & 0xffff); vt[5 * 72] = (short)(v0.z >> 16); vt[6 * 72] = (short)(v0.w & 0xffff); vt[7 * 72] = (short)(v0.w >> 16);
            vt[8 * 72] = (short)(v1.x & 0xffff); vt[9 * 72] = (short)(v1.x >> 16); vt[10 * 72] = (short)(v1.y & 0xffff); vt[11 * 72] = (short)(v1.y >> 16);
            vt[12 * 72] = (short)(v1.z & 0xffff); vt[13 * 72] = (short)(v1.z >> 16); vt[14 * 72] = (short)(v1.w & 0xffff); vt[15 * 72] = (short)(v1.w >> 16);
            *(LAS u32x4*)(CT + (tid >> 3) * 72 + (tid & 7) * 8) = cur.c0; *(LAS u32x4*)(CT + ((tid + 512) >> 3) * 72 + (tid & 7) * 8) = cur.c1;
        }
        const float Mt = fmaxf(cur.mp, cur.cmt);
        const float a_t = __expf(-Mt), wa_t = __expf(cur.mp - Mt), emt_t = __expf(-cur.bt - Mt);
        __syncthreads();
#if PROBE_PH >= 140 && PROBE_PH < 150
        tB = __builtin_amdgcn_s_memrealtime();
#endif
        float hb[16];
        {
            bf16x8 qf[4];
#pragma unroll
            for (int ks = 0; ks < 4; ++ks) qf[ks] = *(const LAS bf16x8*)(QS + t * 72 + 16 * ks + 8 * h);
            f32x16 O = {}; float dn = 0.f;
#pragma unroll
            for (int ks = 0; ks < 4; ++ks) { const bf16x8 cf = *(const LAS bf16x8*)(CT + (32 * dvt + q) * 72 + 16 * ks + 8 * h);
                O = __builtin_amdgcn_mfma_f32_32x32x16_bf16(cf, qf[ks], O, 0, 0, 0);
#pragma unroll
                for (int j = 0; j < 8; ++j) dn += bf2f(qf[ks][j]) * npv[16 * ks + 8 * h + j]; }
#pragma unroll
            for (int rg = 0; rg < 16; ++rg) O[rg] *= wa_t;
            float dsum = dn * wa_t;
#pragma unroll
            for (int st = 0; st < 2; ++st) {
                if (st <= tt) {
                    f32x16 Sx = {};
#pragma unroll
                    for (int ks = 0; ks < 4; ++ks) { const bf16x8 kf = *(const LAS bf16x8*)(KS + (32 * st + q) * 72 + 16 * ks + 8 * h); Sx = __builtin_amdgcn_mfma_f32_32x32x16_bf16(kf, qf[ks], Sx, 0, 0, 0); }
                    const bool diag = (st == tt);
#pragma unroll
                    for (int rg = 0; rg < 16; ++rg) { const int kr = (rg & 3) + 8 * (rg >> 2) + 4 * h;
                        float p = Sx[rg] * (a_t * bsv[32 * st + kr]); p = (diag && kr > q) ? 0.f : p; Sx[rg] = p; dsum += p; }
#pragma unroll
                    for (int ks = 0; ks < 2; ++ks) {
                        u32x4 pw; pw.x = pk2(Sx[8 * ks + 0], Sx[8 * ks + 1]); pw.y = pk2(Sx[8 * ks + 2], Sx[8 * ks + 3]); pw.z = pk2(Sx[8 * ks + 4], Sx[8 * ks + 5]); pw.w = pk2(Sx[8 * ks + 6], Sx[8 * ks + 7]);
                        const bf16x8 pf = __builtin_bit_cast(bf16x8, pw);
                        const LAS short* vp = VT + (32 * dvt + q) * 72 + 32 * st + 16 * ks + 4 * h;
                        const s16x4 lo = *(const LAS s16x4*)vp, hi = *(const LAS s16x4*)(vp + 8);
                        const bf16x8 vf = (bf16x8){lo[0], lo[1], lo[2], lo[3], hi[0], hi[1], hi[2], hi[3]};
                        O = __builtin_amdgcn_mfma_f32_32x32x16_bf16(vf, pf, O, 0, 0, 0); }
                } }
            float den = dsum; den += __shfl_xor(den, 32);
            const float inv = __builtin_amdgcn_rcpf(fmaxf(fabsf(den), emt_t));
            float ssq = 0.f;
#pragma unroll
            for (int rg = 0; rg < 16; ++rg) { hb[rg] = O[rg] * inv; ssq += hb[rg] * hb[rg]; }
            ssq += __shfl_xor(ssq, 32);
            if (h == 0) red[(tt * 4 + dvt) * 32 + q] = ssq;
        }
        __syncthreads();
#if PROBE_PH >= 140 && PROBE_PH < 150
        tC = __builtin_amdgcn_s_memrealtime();
#endif
        {   const float tot = (red[(tt * 4 + 0) * 32 + q] + red[(tt * 4 + 1) * 32 + q]) + (red[(tt * 4 + 2) * 32 + q] + red[(tt * 4 + 3) * 32 + q]);
            const float rn = 1.0f / sqrtf(tot * (1.f / 128.f) + EPS_);
            bf16* op = MO + (t0 + t) * 512 + hh * 128 + 32 * dvt + 4 * h;
#pragma unroll
            for (int g4 = 0; g4 < 4; ++g4) { const f32x4 w4 = nwr[g4]; const u32x2 mo = cur.mo[g4];
                u32x2 w; w.x = pk2(hb[4 * g4 + 0] * rn * w4.x * bflo(mo.x), hb[4 * g4 + 1] * rn * w4.y * bfhi(mo.x)); w.y = pk2(hb[4 * g4 + 2] * rn * w4.z * bflo(mo.y), hb[4 * g4 + 3] * rn * w4.w * bfhi(mo.y));
                st8(op + 8 * g4, w); }
        }
#if PROBE_PH >= 140 && PROBE_PH < 150
        tD = __builtin_amdgcn_s_memrealtime(); acc_t0 += tB - tA; acc_t1 += tC - tB; acc_t2 += tD - tC;
#endif
    }
    __syncthreads();
#if PROBE_PH >= 140 && PROBE_PH < 150
    const unsigned long long tF = __builtin_amdgcn_s_memrealtime();
    if (blockIdx.x == (PROBE_PH == 145 ? 129 : 0) && tid == 0) { const unsigned long long d = (PROBE_PH == 140 ? acc_t0 : PROBE_PH == 141 ? acc_t1 : PROBE_PH == 142 ? acc_t2 : tF - tE) * PROBE_AMP; const unsigned long long te = __builtin_amdgcn_s_memrealtime(); while (__builtin_amdgcn_s_memrealtime() - te < d) __builtin_amdgcn_s_sleep(8); }
#endif
}

__device__ __forceinline__ void phase7(const Args& a, LAS unsigned char* lds, int vcu, int G, int tid, int lane, int wave) {
    const float* x1 = a.out; const float* nw = a.in[12];
    bf16* H2 = (bf16*)(a.ws + WS_XN); float* RSTD2 = (float*)(a.ws + WS_RSTD2); const bf16* WRg = (const bf16*)(a.ws + WS_WR);
    int* LIST = (int*)(a.ws + WS_LIST); float* SW = (float*)(a.ws + WS_SW); i32x4* TOKI = (i32x4*)(a.ws + WS_TOKI);
    unsigned* gcnt = (unsigned*)(a.ws + WS_CTL) + CW_GCNT;
    LAS short* WR = (LAS short*)lds;
    LAS float* lg = (LAS float*)(lds + 99072);
    LAS float* rsl = (LAS float*)(lds + 99072 + 24576);
    LAS int* hist = (LAS int*)(lds + 99072 + 24576 + 512);
    LAS int* basev = hist + 32;
    for (int p = tid; p < 48 * 128; p += 512) { const int n = p >> 7, cc = p & 127; *(LAS u32x4*)(WR + n * 1032 + cc * 8) = *(const u32x4*)(WRg + n * 1024 + cc * 8); }
    __syncthreads();
    const int r = lane & 15, g = lane >> 4;
    for (int it = vcu; it < T_ / 128; it += G) {
        if (tid < 32) hist[tid] = 0;
        __syncthreads();
        const int row = it * 128 + wave * 16 + r;
        f32x4 acc[3]; acc[0] = (f32x4){0.f, 0.f, 0.f, 0.f}; acc[1] = acc[0]; acc[2] = acc[0];
        float ssq = 0.f;
        const float* xr = x1 + (size_t)row * 1024 + 8 * g; bf16* hr = H2 + (size_t)row * 1024 + 8 * g;
#pragma unroll 4
        for (int s = 0; s < 32; ++s) {
            const f32x4 xa = *(const f32x4*)(xr + 32 * s), xb = *(const f32x4*)(xr + 32 * s + 4);
            const f32x4 wa = *(const f32x4*)(nw + 32 * s + 8 * g), wb = *(const f32x4*)(nw + 32 * s + 8 * g + 4);
            ssq += (xa.x * xa.x + xa.y * xa.y) + (xa.z * xa.z + xa.w * xa.w) + (xb.x * xb.x + xb.y * xb.y) + (xb.z * xb.z + xb.w * xb.w);
            u32x4 w; w.x = pk2(xa.x * wa.x, xa.y * wa.y); w.y = pk2(xa.z * wa.z, xa.w * wa.w); w.z = pk2(xb.x * wb.x, xb.y * wb.y); w.w = pk2(xb.z * wb.z, xb.w * wb.w);
            *(u32x4*)(hr + 32 * s) = w;
            const bf16x8 af = __builtin_bit_cast(bf16x8, w);
#pragma unroll
            for (int nt = 0; nt < 3; ++nt) { const bf16x8 bfr = *(const LAS bf16x8*)(WR + (16 * nt + r) * 1032 + 32 * s + 8 * g); acc[nt] = __builtin_amdgcn_mfma_f32_16x16x32_bf16(af, bfr, acc[nt], 0, 0, 0); }
        }
        ssq += __shfl_xor(ssq, 16); ssq += __shfl_xor(ssq, 32);
        const float rstd = 1.0f / sqrtf(ssq * (1.f / 1024.f) + EPS_);
        if (g == 0) { RSTD2[row] = rstd; rsl[wave * 16 + r] = rstd; }
#pragma unroll
        for (int nt = 0; nt < 3; ++nt)
#pragma unroll
            for (int rg = 0; rg < 4; ++rg) lg[(wave * 16 + 4 * g + rg) * 48 + 16 * nt + r] = acc[nt][rg];
        LDS_WAIT(); asm volatile("" ::: "memory");
        int e1 = 0, e2 = 0, lr1 = 0, lr2 = 0; float w1 = 0.f, w2 = 0.f;
        if (lane < 16) {
            const LAS float* lp = lg + (wave * 16 + lane) * 48; const float rs = rsl[wave * 16 + lane];
            float gl[4]; int gi = 0; float gm;
#pragma unroll
            for (int k = 0; k < 4; ++k) gl[k] = lp[k] * rs + a.in[14][k];
            gm = gl[0];
#pragma unroll
            for (int k = 1; k < 4; ++k) if (gl[k] > gm) { gm = gl[k]; gi = k; }
            float gs = 0.f;
#pragma unroll
            for (int k = 0; k < 4; ++k) gs += expf(gl[k] - gm);
            const float gp = 1.0f / gs;
            float v1 = -INFINITY, v2 = -INFINITY; int j1 = 0, j2 = 0;
#pragma unroll
            for (int j = 0; j < 8; ++j) { const float el = lp[4 + 8 * gi + j] * rs + a.in[16][8 * gi + j];
                if (el > v1) { v2 = v1; j2 = j1; v1 = el; j1 = j; } else if (el > v2) { v2 = el; j2 = j; } }
            const float ex = expf(v2 - v1); w1 = gp / (1.0f + ex); w2 = gp * ex / (1.0f + ex);
            e1 = 8 * gi + j1; e2 = 8 * gi + j2;
            lr1 = atomicAdd((int*)(hist + e1), 1); lr2 = atomicAdd((int*)(hist + e2), 1);
        }
        __syncthreads();
        if (tid < 32) { const int n = hist[tid]; basev[tid] = n > 0 ? (int)atomicAdd(gcnt + tid, (unsigned)n) : 0; }
        __syncthreads();
        if (lane < 16) { const int tok = it * 128 + wave * 16 + lane; const int r1 = basev[e1] + lr1, r2 = basev[e2] + lr2;
            LIST[(size_t)e1 * T_ + r1] = tok; LIST[(size_t)e2 * T_ + r2] = tok; SW[(size_t)e1 * T_ + r1] = w1; SW[(size_t)e2 * T_ + r2] = w2;
            TOKI[tok] = (i32x4){e1, r1, e2, r2}; }
        __syncthreads();
    }
}

__device__ __forceinline__ void moe_tables(const Args& a, LAS unsigned char* lds, int tid) {
    LAS int* cum = (LAS int*)(lds + TAB_OFF); LAS int* cnt = cum + 64;
    const unsigned* gcnt = (const unsigned*)(a.ws + WS_CTL) + CW_GCNT;
    if (tid == 0) { int c = 0; for (int e = 0; e < NEXP; ++e) { const int n = (int)__hip_atomic_load(gcnt + e, __ATOMIC_RELAXED, __HIP_MEMORY_SCOPE_AGENT); cnt[e] = n; cum[e] = c; c += (n + 255) >> 8; } cum[NEXP] = c; }
    __syncthreads();
}

__device__ __forceinline__ void phase10(const Args& a, LAS unsigned char* lds, int vcu, int G, int lane, int wave) {
    const LAS int* cum = (const LAS int*)(lds + TAB_OFF);
    float* out = a.out; const bf16* YS = (const bf16*)(a.ws + WS_YS); const i32x4* TOKI = (const i32x4*)(a.ws + WS_TOKI); const float* nw = a.in[20];
    f32x4 nwv[4];
#pragma unroll
    for (int j = 0; j < 4; ++j) nwv[j] = ((const f32x4*)nw)[lane + 64 * j];
    const int gw = vcu * NWAVES + wave, NGW = G * NWAVES;
    for (int m = gw; m < T_; m += NGW) {
        const i32x4 ti = TOKI[m];
        const size_t s1 = (size_t)cum[ti.x] * 256 + ti.y, s2 = (size_t)cum[ti.z] * 256 + ti.w;
        f32x4* xr = (f32x4*)(out + (size_t)m * 1024) + lane;
        const u32x2* y1 = (const u32x2*)(YS + s1 * 1024) + lane; const u32x2* y2 = (const u32x2*)(YS + s2 * 1024) + lane;
        f32x4 v[4]; float s = 0.f;
#pragma unroll
        for (int j = 0; j < 4; ++j) { v[j] = xr[64 * j]; const u32x2 p1 = y1[64 * j], p2 = y2[64 * j];
            v[j].x += bflo(p1.x) + bflo(p2.x); v[j].y += bfhi(p1.x) + bfhi(p2.x); v[j].z += bflo(p1.y) + bflo(p2.y); v[j].w += bfhi(p1.y) + bfhi(p2.y);
            s += (v[j].x * v[j].x + v[j].y * v[j].y) + (v[j].z * v[j].z + v[j].w * v[j].w); }
        const float rstd = 1.0f / sqrtf(wave_sum(s) * (1.f / 1024.f) + EPS_);
#pragma unroll
        for (int j = 0; j < 4; ++j) xr[64 * j] = v[j] * rstd * nwv[j];
    }
}

__global__ void __launch_bounds__(NWAVES * 64, 2) mega_fwd(Args args) {
    extern __shared__ __attribute__((aligned(16))) unsigned char lds_raw[];
    LAS unsigned char* lds = (LAS unsigned char*)lds_raw;
    const int tid = threadIdx.x, lane = tid & 63, wave = __builtin_amdgcn_readfirstlane(tid >> 6);
    const int G = gridDim.x, bx = blockIdx.x;
    const int vcu = (G % 8 == 0) ? (bx % 8) * (G / 8) + bx / 8 : bx;
    unsigned char* ws = args.ws;
    unsigned* ctl = (unsigned*)(ws + WS_CTL);
    for (int u = tid; u < (LDS_BYTES - LDSCTL_OFF) / 4; u += NWAVES * 64) ((LAS unsigned*)(lds + LDSCTL_OFF))[u] = 0u;
    __syncthreads();
    const int lo = args.ph_lo, hi = args.ph_hi;
    const bool multi = (hi - lo) > 1;
    XcdBarrier bar; bar.bar = ctl + CW_BAR; bar.x = 0; bar.st = (volatile LAS unsigned*)(lds + MISC_OFF) + 8;
    if (multi) bar = xcd_barrier_post(ctl + CW_BAR, (volatile LAS unsigned*)(lds + MISC_OFF) + 8);
#define IN(k) (((PH_MASK >> (k)) & 1) && lo <= (k) && (k) < hi)
#if PROBE_PH >= 0 && PROBE_PH < 100
    unsigned long long tp0 = 0, tp1 = 0;
#define SEAM(k) do { if (IN(k) && IN((k) + 1)) xcd_barrier(bar); if ((k) == PROBE_PH) tp1 = __builtin_amdgcn_s_memrealtime(); if ((k) + 1 == PROBE_PH) tp0 = __builtin_amdgcn_s_memrealtime(); } while (0)
    if (PROBE_PH == 0) tp0 = __builtin_amdgcn_s_memrealtime();
#elif PROBE_PH == 301
#define SEAM(k) do { if (IN(k) && IN((k) + 1)) { xcd_barrier(bar); xcd_barrier(bar); } } while (0)
#elif PROBE_PH == 300
    unsigned long long tbar = 0;
#define SEAM(k) do { if (IN(k) && IN((k) + 1)) { const unsigned long long _t = __builtin_amdgcn_s_memrealtime(); xcd_barrier(bar); tbar += __builtin_amdgcn_s_memrealtime() - _t; } } while (0)
#else
#define SEAM(k) do { if (IN(k) && IN((k) + 1)) xcd_barrier(bar); } while (0)
#endif

    if (IN(0)) { phase0(args, lds, vcu, G, tid, lane, wave); SEAM(0); }

    if (IN(1)) {
        DenseSched S{(const char*)(ws + WS_XN), (const char*)(ws + WS_WIN), 1024, 1024, T_ / 256, NIN / 256, G, bx};
        EpiProj E{(bf16*)(ws + WS_ATT), (bf16*)(ws + WS_MQK), (bf16*)(ws + WS_MV), (bf16*)(ws + WS_MO), (bf16*)(ws + WS_GATES)};
        g8::gemm_phase<EpiProj, DenseSched, true>(lds, 1024, 1024, S, E);
        {
            const int nunits = (T_ / 256) * (NIN / 256), rem = nunits % G, ndef = deferred_items(G);
            if (ndef > 0 && bx >= rem) { const int nw = (G - rem) * NWAVES; for (int it = (bx - rem) * NWAVES + wave; it < ndef; it += nw) expert_copy_item(args, it, lane); }
        }
        SEAM(1);
    }
    if (IN(2)) {
        for (int u = vcu; u < NB_ * 32 * 2; u += G) attn_unit(args, lds, u >> 6, (u >> 1) & 31, u & 1, tid, lane, wave);
        for (int u = vcu; u < 2048; u += G) mprep_unit(args, lds, u, tid, lane, wave);
        SEAM(2);
    }
    if (IN(3)) { phase3(args, G, tid); SEAM(3); }
    if (IN(4)) { phase4(args, lds, vcu, G, tid, lane, wave); SEAM(4); }
    if (IN(5)) {
        MixSched S{(const char*)(ws + WS_ATT), (const char*)(ws + WS_MO), (const char*)(ws + WS_WAO), (const char*)(ws + WS_WMO), 768, 512, T_ / 256, 4, G, bx};
        EpiMix E{(bf16*)(ws + WS_GATES)};
        g8::gemm_phase<EpiMix, MixSched, true>(lds, 512, 512, S, E);
        SEAM(5);
    }
    if (IN(6)) {
        DenseSched S{(const char*)(ws + WS_GATES), (const char*)(ws + WS_WOUT), 2048, 1024, T_ / 256, 4, G, bx};
        EpiOut E{args.in[0], args.out};
        g8::gemm_phase<EpiOut, DenseSched, true>(lds, 1024, 1024, S, E);
        SEAM(6);
    }
    if (IN(7)) { phase7(args, lds, vcu, G, tid, lane, wave); SEAM(7); }
    if (IN(8) || IN(9) || IN(10)) moe_tables(args, lds, tid);
    if (IN(8)) {
        const LAS int* cum = (const LAS int*)(lds + TAB_OFF); const LAS int* cnt = cum + 64;
        MoeSched S{cum, cnt, (const char*)(ws + WS_XN), (const char*)(ws + WS_WGU), (const int*)(ws + WS_LIST), G, vcu, true, 1024, 1024};
        EpiG1 E{(bf16*)(ws + WS_HID), (const float*)(ws + WS_RSTD2), (const int*)(ws + WS_LIST), cnt};
        g8::gemm_phase<EpiG1, MoeSched, true>(lds, 1024, 1024, S, E);
        SEAM(8);
    }
    if (IN(9)) {
        const LAS int* cum = (const LAS int*)(lds + TAB_OFF); const LAS int* cnt = cum + 64;
        MoeSched S{cum, cnt, (const char*)(ws + WS_HID), (const char*)(ws + WS_WDN), (const int*)(ws + WS_LIST), G, vcu, false, 512, 1024};
        EpiG2 E{(bf16*)(ws + WS_YS), (const float*)(ws + WS_SW), cnt};
        g8::gemm_phase<EpiG2, MoeSched, true>(lds, 512, 512, S, E);
        SEAM(9);
    }
    if (IN(10)) phase10(args, lds, vcu, G, lane, wave);
#if PROBE_PH == 300
    if (bx == 0 && tid == 0) { const unsigned long long d = tbar * PROBE_AMP; const unsigned long long te = __builtin_amdgcn_s_memrealtime(); while (__builtin_amdgcn_s_memrealtime() - te < d) __builtin_amdgcn_s_sleep(8); }
#endif
#if PROBE_PH >= 0 && PROBE_PH < 100
    if (PROBE_PH == 10) { asm volatile("s_waitcnt vmcnt(0)" ::: "memory"); __syncthreads(); tp1 = __builtin_amdgcn_s_memrealtime(); }
    if (bx == 0 && tid == 0) { const unsigned long long d = (tp1 - tp0) * PROBE_AMP; const unsigned long long te = __builtin_amdgcn_s_memrealtime(); while (__builtin_amdgcn_s_memrealtime() - te < d) __builtin_amdgcn_s_sleep(8); }
#endif
#undef IN
#undef SEAM
}

extern "C" void kernel_launch(void* const* d_in, const int* in_sizes, int n_in, void* d_out, int out_size, void* d_ws, size_t ws_size, hipStream_t stream) {
    static int grid = 0;
    if (grid == 0) {
        if (n_in != 21 || in_sizes[0] != T_ * D_ || out_size != T_ * D_ || ws_size < WS_END) { fprintf(stderr, "kernel_launch: unexpected shapes / workspace (n_in %d, ws %zu, need %zu)\n", n_in, ws_size, (size_t)WS_END); grid = -1; return; }
        int dev = 0, cus = 0, per_cu = 0;
        if (hipGetDevice(&dev) != hipSuccess || hipDeviceGetAttribute(&cus, hipDeviceAttributeMultiprocessorCount, dev) != hipSuccess) { grid = -1; return; }
        if (hipFuncSetAttribute((const void*)mega_fwd, hipFuncAttributeMaxDynamicSharedMemorySize, LDS_BYTES) != hipSuccess) { fprintf(stderr, "kernel_launch: hipFuncSetAttribute failed\n"); grid = -1; return; }
        if (hipOccupancyMaxActiveBlocksPerMultiprocessor(&per_cu, (const void*)mega_fwd, NWAVES * 64, LDS_BYTES) != hipSuccess || per_cu < 1) { fprintf(stderr, "kernel_launch: occupancy query reports %d blocks per CU\n", per_cu); (void)hipGetLastError(); grid = -1; return; }
        grid = cus;
    }
    if (grid < 0) return;
    (void)hipMemsetAsync((char*)d_ws + WS_CTL, 0, CTL_ZERO_BYTES, stream);
    Args a{};
    for (int i = 0; i < 21; ++i) a.in[i] = (const float*)d_in[i];
    a.out = (float*)d_out; a.ws = (unsigned char*)d_ws;
#if MK_FUSED
    a.ph_lo = 0; a.ph_hi = NPH;
    void* kargs[] = {&a};
    hipError_t e = hipLaunchCooperativeKernel((const void*)mega_fwd, dim3(grid), dim3(NWAVES * 64), kargs, LDS_BYTES, stream);
    if (e != hipSuccess) fprintf(stderr, "kernel_launch: cooperative launch failed: %s (grid %d)\n", hipGetErrorString(e), grid);
#else
    for (int p = 0; p < NPH; ++p) { a.ph_lo = p; a.ph_hi = p + 1; hipLaunchKernelGGL(mega_fwd, dim3(grid), dim3(NWAVES * 64), LDS_BYTES, stream, a); }
#endif
}
```
